# Optimizing an MI355X kernel written in HIP

```python
import math
import jax, jax.numpy as jnp
from jax import lax
import numpy as np

D_MODEL = 1024
BATCH = 2
SEQ = 16384
DEPTH = 2

LRU_WIDTH = 256
LRU_BLOCKS = 4
LRU_BLOCK = LRU_WIDTH // LRU_BLOCKS
CONV_WIDTH = 4
LRU_C = 8.0
GLA_HEADS = 6
GLA_DK = 64
GLA_DV = 64
GLA_GATE_RANK = 16
GLA_GATE_TAU = 16.0
GLA_CHUNK = 64
DSA_HEADS = 6
DSA_HEAD_DIM = 64
IDX_HEADS = 4
IDX_DIM = 32
IDX_TOPK_MAX = 256
Q_BLOCK = 128
REL_BUCKETS = 32
REL_MAX_DIST = 128
D_FF = -(-8 * D_MODEL // (3 * 256)) * 256
DN_ALPHA = (2.0 * DEPTH) ** 0.25
DN_BETA = (8.0 * DEPTH) ** -0.25
LN_EPS = 1e-5

GLA_WIDTH = GLA_HEADS * GLA_DV
DSA_WIDTH = DSA_HEADS * DSA_HEAD_DIM
MIX_WIDTH = LRU_WIDTH + GLA_WIDTH + DSA_WIDTH
IN_SIZES = (
    LRU_WIDTH, LRU_WIDTH,
    GLA_HEADS * GLA_DK, GLA_HEADS * GLA_DK, GLA_WIDTH, GLA_WIDTH, GLA_GATE_RANK,
    DSA_WIDTH, DSA_WIDTH, DSA_WIDTH,
    IDX_HEADS * IDX_DIM, IDX_DIM, IDX_HEADS,
)
IN_COLS = sum(IN_SIZES)
IN_OFFSETS = [int(o) for o in np.cumsum(IN_SIZES)[:-1]]

kernel_name = "hymba_style_lru_gla_dsa_deepnorm"


def layer_norm(x, g, b):
    xf = x.astype(jnp.float32)
    mu = jnp.mean(xf, axis=-1, keepdims=True)
    var = jnp.mean(jnp.square(xf - mu), axis=-1, keepdims=True)
    return ((xf - mu) * lax.rsqrt(var + LN_EPS) * g + b).astype(x.dtype)


def t5_bucket(dist):
    n = jnp.maximum(dist, 0)
    max_exact = REL_BUCKETS // 2
    nf = jnp.maximum(n, 1).astype(jnp.float32)
    large = max_exact + (jnp.log(nf / max_exact) / math.log(REL_MAX_DIST / max_exact)
                         * (REL_BUCKETS - max_exact)).astype(jnp.int32)
    large = jnp.minimum(large, REL_BUCKETS - 1)
    return jnp.where(n < max_exact, n, large)


def rg_lru_group(xb, gb, conv_w, conv_b, w_a, b_a, w_x, b_x, lam):
    B, S, C = xb.shape
    xc = lax.conv_general_dilated(xb, conv_w[:, None, :], window_strides=(1,),
                                  padding=[(CONV_WIDTH - 1, 0)],
                                  dimension_numbers=('NWC', 'WIO', 'NWC'),
                                  feature_group_count=C) + conv_b
    xr = xc.reshape(B, S, LRU_BLOCKS, LRU_BLOCK)
    r = jax.nn.sigmoid(jnp.einsum('bsnk,nkj->bsnj', xr, w_a).reshape(B, S, C) + b_a)
    i = jax.nn.sigmoid(jnp.einsum('bsnk,nkj->bsnj', xr, w_x).reshape(B, S, C) + b_x)
    log_a = -LRU_C * r.astype(jnp.float32) * jax.nn.softplus(-lam.astype(jnp.float32))
    a = jnp.exp(log_a)
    u = jnp.sqrt(-jnp.expm1(2.0 * log_a)) * (i * xc).astype(jnp.float32)

    def combine(left, right):
        a1, b1 = left
        a2, b2 = right
        return a1 * a2, a2 * b1 + b2

    _, h = lax.associative_scan(combine, (a, u), axis=1)
    return h.astype(xb.dtype) * jax.nn.gelu(gb)


def gla_group(q, k, v, g, g_lr, w_gate2, b_gate, norm_g):
    B, S, _ = q.shape
    N, C = S // GLA_CHUNK, GLA_CHUNK
    f32 = jnp.float32
    qf = q.astype(f32).reshape(B, N, C, GLA_HEADS, GLA_DK) * (GLA_DK ** -0.5)
    kf = k.astype(f32).reshape(B, N, C, GLA_HEADS, GLA_DK)
    vf = v.astype(f32).reshape(B, N, C, GLA_HEADS, GLA_DV)
    log_alpha = jax.nn.log_sigmoid((g_lr @ w_gate2 + b_gate).astype(f32)) / GLA_GATE_TAU
    bcum = jnp.cumsum(log_alpha.reshape(B, N, C, GLA_HEADS, GLA_DK), axis=2)
    b_last = bcum[:, :, -1:]
    q_dec = qf * jnp.exp(bcum)
    k_inv = kf * jnp.exp(-bcum)
    k_end = kf * jnp.exp(b_last - bcum)
    causal = jnp.tril(jnp.ones((C, C), dtype=bool))
    att = jnp.einsum('bnchd,bnshd->bnhcs', q_dec, k_inv)
    att = jnp.where(causal, att, 0.0)
    o_intra = jnp.einsum('bnhcs,bnshv->bnchv', att, vf)
    u = jnp.einsum('bnchd,bnchv->bnhdv', k_end, vf)
    decay = jnp.exp(b_last[:, :, 0])

    def step(state, inp):
        dec, un = inp
        return dec[..., None] * state + un, state

    s0 = jnp.zeros((B, GLA_HEADS, GLA_DK, GLA_DV), f32)
    _, s_start = lax.scan(step, s0, (decay.transpose(1, 0, 2, 3), u.transpose(1, 0, 2, 3, 4)))
    s_start = s_start.transpose(1, 0, 2, 3, 4)
    o_inter = jnp.einsum('bnchd,bnhdv->bnchv', q_dec, s_start)
    o = (o_intra + o_inter).reshape(B, S, GLA_HEADS, GLA_DV)
    o = o * lax.rsqrt(jnp.mean(jnp.square(o), axis=-1, keepdims=True) + 1e-6)
    o = o.reshape(B, S, GLA_WIDTH) * norm_g
    return (o * jax.nn.silu(g.astype(f32))).astype(q.dtype)


def dsa_group(q, k, v, q_idx, k_idx, w_idx, rel_bias):
    B, S, W = q.shape
    top_k = min(IDX_TOPK_MAX, S // 4)
    nblk = S // Q_BLOCK
    qb_all = q.reshape(B, nblk, Q_BLOCK, DSA_HEADS, DSA_HEAD_DIM).transpose(1, 0, 2, 3, 4)
    qi_all = q_idx.reshape(B, nblk, Q_BLOCK, IDX_HEADS, IDX_DIM).transpose(1, 0, 2, 3, 4)
    wi_all = w_idx.reshape(B, nblk, Q_BLOCK, IDX_HEADS).transpose(1, 0, 2, 3)
    k_idx_f = k_idx.astype(jnp.float32)
    key_pos = jnp.arange(S, dtype=jnp.int32)
    starts = jnp.arange(nblk, dtype=jnp.int32) * Q_BLOCK

    def block(inp):
        qb, qib, wb, start = inp
        t = start + jnp.arange(Q_BLOCK, dtype=jnp.int32)
        s_h = jax.nn.relu(jnp.einsum('btid,bsd->btis', qib.astype(jnp.float32), k_idx_f)) * (IDX_DIM ** -0.5)
        score = jnp.einsum('btis,bti->bts', s_h, wb.astype(jnp.float32) * (IDX_HEADS ** -0.5))
        score = jnp.where(key_pos[None, None, :] <= t[None, :, None], score, -jnp.inf)
        _, sel = lax.top_k(score, top_k)
        k_sel = jax.vmap(lambda kk, ss: kk[ss])(k, sel).reshape(B, Q_BLOCK, top_k, DSA_HEADS, DSA_HEAD_DIM)
        v_sel = jax.vmap(lambda vv, ss: vv[ss])(v, sel).reshape(B, Q_BLOCK, top_k, DSA_HEADS, DSA_HEAD_DIM)
        dist = t[None, :, None] - sel
        bias = rel_bias[t5_bucket(dist)]
        logits = jnp.einsum('bthd,btkhd->bthk', qb, k_sel).astype(jnp.float32) * (DSA_HEAD_DIM ** -0.5)
        logits = logits + bias.transpose(0, 1, 3, 2).astype(jnp.float32)
        logits = jnp.where((dist >= 0)[:, :, None, :], logits, -jnp.inf)
        p = jax.nn.softmax(logits, axis=-1).astype(v.dtype)
        o = jnp.einsum('bthk,btkhd->bthd', p, v_sel)
        return o.reshape(B, Q_BLOCK, W)

    out = lax.map(block, (qb_all, qi_all, wi_all, starts))
    return out.transpose(1, 0, 2, 3).reshape(B, S, W)


def setup_inputs(seed: int = 0) -> dict:
    key = jax.random.key(seed)
    ks = jax.random.split(key, 24)
    f32 = jnp.float32

    def nrm(k, shape, scale):
        return jax.random.normal(k, shape, f32) * scale

    u = jax.random.uniform(ks[8], (DEPTH, LRU_WIDTH), f32, 0.9, 0.999)
    a = u ** (1.0 / LRU_C)
    lru_lambda = jnp.log(a) - jnp.log1p(-a)
    return {
        "x": nrm(ks[0], (BATCH, SEQ, D_MODEL), 1.0),
        "w_in": nrm(ks[1], (DEPTH, D_MODEL, IN_COLS), D_MODEL ** -0.5),
        "conv_w": nrm(ks[2], (DEPTH, CONV_WIDTH, LRU_WIDTH), CONV_WIDTH ** -0.5),
        "conv_b": nrm(ks[3], (DEPTH, LRU_WIDTH), 0.01),
        "lru_wa": nrm(ks[4], (DEPTH, LRU_BLOCKS, LRU_BLOCK, LRU_BLOCK), LRU_BLOCK ** -0.5),
        "lru_ba": nrm(ks[5], (DEPTH, LRU_WIDTH), 0.01),
        "lru_wx": nrm(ks[6], (DEPTH, LRU_BLOCKS, LRU_BLOCK, LRU_BLOCK), LRU_BLOCK ** -0.5),
        "lru_bx": nrm(ks[7], (DEPTH, LRU_WIDTH), 0.01),
        "lru_lambda": lru_lambda,
        "gla_w_gate2": nrm(ks[9], (DEPTH, GLA_GATE_RANK, GLA_HEADS * GLA_DK), GLA_GATE_RANK ** -0.5),
        "gla_b_gate": nrm(ks[10], (DEPTH, GLA_HEADS * GLA_DK), 0.01),
        "gla_norm_g": 1.0 + nrm(ks[11], (DEPTH, GLA_WIDTH), 0.01),
        "rel_bias": nrm(ks[12], (REL_BUCKETS, DSA_HEADS), 0.5),
        "w_out": nrm(ks[13], (DEPTH, MIX_WIDTH, D_MODEL), MIX_WIDTH ** -0.5 * DN_BETA),
        "ln1_g": 1.0 + nrm(ks[14], (DEPTH, D_MODEL), 0.01),
        "ln1_b": nrm(ks[15], (DEPTH, D_MODEL), 0.01),
        "w_ffn_gate": nrm(ks[16], (DEPTH, D_MODEL, D_FF), D_MODEL ** -0.5),
        "w_ffn_up": nrm(ks[17], (DEPTH, D_MODEL, D_FF), D_MODEL ** -0.5),
        "w_ffn_down": nrm(ks[18], (DEPTH, D_FF, D_MODEL), D_FF ** -0.5 * DN_BETA),
        "ln2_g": 1.0 + nrm(ks[19], (DEPTH, D_MODEL), 0.01),
        "ln2_b": nrm(ks[20], (DEPTH, D_MODEL), 0.01),
    }


def reference(x, w_in, conv_w, conv_b, lru_wa, lru_ba, lru_wx, lru_bx, lru_lambda,
              gla_w_gate2, gla_b_gate, gla_norm_g, rel_bias, w_out, ln1_g, ln1_b,
              w_ffn_gate, w_ffn_up, w_ffn_down, ln2_g, ln2_b):
    for l in range(DEPTH):
        proj = x @ w_in[l]
        (lru_x, lru_g, gq, gk, gv, gg, g_lr, dq, dk, dv, iq, ik, iw) = jnp.split(proj, IN_OFFSETS, axis=-1)
        y_lru = rg_lru_group(lru_x, lru_g, conv_w[l], conv_b[l], lru_wa[l], lru_ba[l],
                             lru_wx[l], lru_bx[l], lru_lambda[l])
        y_gla = gla_group(gq, gk, gv, gg, g_lr, gla_w_gate2[l], gla_b_gate[l], gla_norm_g[l])
        y_dsa = dsa_group(dq, dk, dv, iq, ik, iw, rel_bias)
        mix = jnp.concatenate([y_lru, y_gla, y_dsa], axis=-1) @ w_out[l]
        x = layer_norm(DN_ALPHA * x + mix, ln1_g[l], ln1_b[l])
        h = jax.nn.silu(x @ w_ffn_gate[l]) * (x @ w_ffn_up[l])
        x = layer_norm(DN_ALPHA * x + h @ w_ffn_down[l], ln2_g[l], ln2_b[l])
    return x
```

```cpp
#define MK_N_LAUNCHES 19
#include <hip/hip_runtime.h>
#include <cstdio>
#include <cstdint>
#include <cmath>
namespace pg8 {
#define PG8_LAS __attribute__((address_space(3)))
typedef unsigned short bf16_t;
typedef short bf16x8 __attribute__((ext_vector_type(8)));
typedef float f32x4 __attribute__((ext_vector_type(4)));
typedef unsigned u32x4 __attribute__((ext_vector_type(4)));
constexpr int BM = 256, BK = 64, HALF = 128, HTB = HALF * BK * 2  , STAGE_BYTES = 8 * HTB, NXCD = 8, WGM = 8;

__host__ __device__ __forceinline__ int lds_byte(int r, int c) { const int st = (r >> 4) * 2 + (c >> 5), rr = r & 15, cc = c & 31, ob = rr * 64 + cc * 2; return st * 1024 + (ob ^ (((ob >> 9) & 1) << 5)); }
__host__ __device__ __forceinline__ void stage_rc(int b, int& R, int& C) { const int st = b / 1024, sb = b % 1024, swz = sb ^ (((sb >> 9) & 1) << 5); R = (st >> 1) * 16 + swz / 64; C = (st & 1) * 32 + (swz % 64) / 2; }
__host__ __device__ __forceinline__ int perm32(int rho) { const int n = rho >> 4, i = rho & 15; return 8 * (i >> 2) + 4 * n + (i & 3); }

struct Unit { int pm, pn; };
struct Gemm { const bf16_t* A; const bf16_t* Bt; int M, N, K; };

struct StaticOrder {
    int nM, nN, nwg, G, c;
    __host__ __device__ void init(int M, int N, int G_, int c_) { nM = M / BM; nN = N / BM; nwg = nM * nN; G = G_; c = c_; }
    __host__ __device__ bool next(int i, Unit& u) const {
        const long L = (long)i * G + c; if (L >= nwg) return false;
        int wgid = (int)L; { const int q = nwg / NXCD, r = nwg % NXCD, xcd = wgid % NXCD, off = wgid / NXCD; wgid = (xcd < r ? xcd * (q + 1) : r * (q + 1) + (xcd - r) * q) + off; }
        const int nig = WGM * nN, gid = wgid / nig, fm = gid * WGM, gsz = (nM - fm) < WGM ? (nM - fm) : WGM;
        u.pm = fm + ((wgid % nig) % gsz); u.pn = (wgid % nig) / gsz; return true;
    }
    __device__ __forceinline__ void a_ready(const Unit&) const {}
    __device__ __forceinline__ void done(const Unit&) const {}
};

__device__ __forceinline__ unsigned cvt_pk_bf16(float lo, float hi) { unsigned r; asm volatile("v_cvt_pk_bf16_f32 %0, %1, %2" : "=v"(r) : "v"(lo), "v"(hi)); return r; }
typedef float f32x2 __attribute__((ext_vector_type(2)));
constexpr int PROJ_LD = 3328, AUX_LD = 256, DFF = 2816, DM = 1024;
struct EpiInProj {
    static constexpr bool PERM = true, AFTER_DRAIN = false;
    bf16_t* proj; float* aux;
    __device__ __forceinline__ void operator()(const f32x4 (&acc)[2][2][4][2], const Unit& u, int wr, int wc, int fr, int fq) const {
        const int row0 = u.pm * BM + wr * 64 + fr;
        if (u.pn < 13) {
            const int col0 = u.pn * BM + wc * 32 + 8 * fq;
#pragma unroll
            for (int ai = 0; ai < 2; ++ai)
#pragma unroll
                for (int m = 0; m < 4; ++m) { bf16_t* rowp = proj + (size_t)(row0 + ai * HALF + m * 16) * PROJ_LD + col0;
#pragma unroll
                    for (int bj = 0; bj < 2; ++bj) { const f32x4 v0 = acc[ai][bj][m][0], v1 = acc[ai][bj][m][1];
                        u32x4 w; w.x = cvt_pk_bf16(v0[0], v0[1]); w.y = cvt_pk_bf16(v0[2], v0[3]); w.z = cvt_pk_bf16(v1[0], v1[1]); w.w = cvt_pk_bf16(v1[2], v1[3]);
                        *(u32x4*)(rowp + bj * HALF) = w; } }
        } else {
            const int col0 = wc * 32 + 8 * fq;
#pragma unroll
            for (int ai = 0; ai < 2; ++ai)
#pragma unroll
                for (int m = 0; m < 4; ++m) { float* rowp = aux + (size_t)(row0 + ai * HALF + m * 16) * AUX_LD + col0;
#pragma unroll
                    for (int bj = 0; bj < 2; ++bj) { *(f32x4*)(rowp + bj * HALF) = acc[ai][bj][m][0]; *(f32x4*)(rowp + bj * HALF + 4) = acc[ai][bj][m][1]; } }
        }
    }
};
struct EpiFfnUp {
    static constexpr bool PERM = true, AFTER_DRAIN = false;
    bf16_t* H;
    __device__ __forceinline__ void operator()(const f32x4 (&acc)[2][2][4][2], const Unit& u, int wr, int wc, int fr, int fq) const {
        const int row0 = u.pm * BM + wr * 64 + fr, col0 = u.pn * HALF + wc * 32 + 8 * fq;
#pragma unroll
        for (int ai = 0; ai < 2; ++ai)
#pragma unroll
            for (int m = 0; m < 4; ++m) { bf16_t* rowp = H + (size_t)(row0 + ai * HALF + m * 16) * DFF + col0;
                float o[8];
#pragma unroll
                for (int n = 0; n < 2; ++n)
#pragma unroll
                    for (int j = 0; j < 4; ++j) { const float g = acc[ai][0][m][n][j], up = acc[ai][1][m][n][j];
                        const float sg = g * __builtin_amdgcn_rcpf(1.0f + __builtin_amdgcn_exp2f(-1.44269504089f * g)); o[n * 4 + j] = sg * up; }
                u32x4 w; w.x = cvt_pk_bf16(o[0], o[1]); w.y = cvt_pk_bf16(o[2], o[3]); w.z = cvt_pk_bf16(o[4], o[5]); w.w = cvt_pk_bf16(o[6], o[7]);
                *(u32x4*)rowp = w; }
    }
};
struct EpiRes {
    static constexpr bool PERM = false, AFTER_DRAIN = false;
    const float* base; float* out; float alpha;
    __device__ __forceinline__ void operator()(const f32x4 (&acc)[2][2][4][2], const Unit& u, int wr, int wc, int fr, int fq) const {
        const int row0 = u.pm * BM + wr * 64 + fr, col0 = u.pn * BM + wc * 32 + 4 * fq;
#pragma unroll
        for (int ai = 0; ai < 2; ++ai)
#pragma unroll
            for (int m = 0; m < 4; ++m) { const size_t off = (size_t)(row0 + ai * HALF + m * 16) * DM + col0;
#pragma unroll
                for (int bj = 0; bj < 2; ++bj)
#pragma unroll
                    for (int n = 0; n < 2; ++n) { const f32x4 b = *(const f32x4*)(base + off + bj * HALF + n * 16);
                        *(f32x4*)(out + off + bj * HALF + n * 16) = b * alpha + acc[ai][bj][m][n]; } }
    }
};
template <class Epi, class Sched, bool ALIGN_EPI = false, bool SP2 = false>
__device__ __forceinline__ void gemm_phase(PG8_LAS unsigned char* lds, const Gemm g, const Sched& S, const Epi& E) {
    int tid_ = threadIdx.x; asm volatile("" : "+v"(tid_));
    const int tid = tid_, wid = __builtin_amdgcn_readfirstlane(tid >> 6), lane = tid & 63, wr = wid >> 2, wc = wid & 3, fr = lane & 15, fq = lane >> 4;
    const int K = g.K, nt = K / BK;
    unsigned voffA[2], voffB[2];
#pragma unroll
    for (int i = 0; i < 2; ++i) { int R, C; stage_rc(tid * 16 + i * 8192, R, C); const int Rb = Epi::PERM ? ((R & ~31) + perm32(R & 31)) : R;
        voffA[i] = (unsigned)(R * K + C) * 2u; voffB[i] = (unsigned)(Rb * K + C) * 2u; }
    const size_t kstep = (size_t)(BK * 2);
    const size_t hstep = (size_t)HALF * K * 2;
    const size_t tstep = 2 * hstep;
    const unsigned ldsw = (unsigned)wid * 1024u;
    const int aoff = lds_byte(wr * 64 + fr, fq * 8), boff = lds_byte(wc * 32 + fr, fq * 8);
#define PG8_SA(b, h) (((b) * 2 + (h)) * HTB)
#define PG8_SB(b, h) ((4 + (b) * 2 + (h)) * HTB)
#define PG8_STAGE(bufoff, gbase, voff) do { _Pragma("unroll") for (int _i = 0; _i < 2; ++_i) \
        __builtin_amdgcn_global_load_lds((const unsigned*)((const char*)(gbase) + (voff)[_i]), (PG8_LAS unsigned*)(lds + (bufoff) + ldsw + _i * 8192), 16, 0, 0); } while (0)
#define PG8_LDA(dst, b, h) do { _Pragma("unroll") for (int m = 0; m < 4; ++m) _Pragma("unroll") for (int k = 0; k < 2; ++k) dst[m][k] = *(const PG8_LAS bf16x8*)(lds + PG8_SA(b, h) + aoff + m * 2048 + k * 1024); } while (0)
#define PG8_LDB(dst, b, h) do { _Pragma("unroll") for (int n = 0; n < 2; ++n) _Pragma("unroll") for (int k = 0; k < 2; ++k) dst[n][k] = *(const PG8_LAS bf16x8*)(lds + PG8_SB(b, h) + boff + n * 2048 + k * 1024); } while (0)
#define PG8_MMA(ai, bj, At, Bt) do { __builtin_amdgcn_s_setprio(1); _Pragma("unroll") for (int m = 0; m < 4; ++m) _Pragma("unroll") for (int n = 0; n < 2; ++n) _Pragma("unroll") for (int k = 0; k < 2; ++k) \
        acc[ai][bj][m][n] = __builtin_amdgcn_mfma_f32_16x16x32_bf16(Bt[n][k], At[m][k], acc[ai][bj][m][n], 0, 0, 0); __builtin_amdgcn_s_setprio(0); } while (0)
#define PG8_WAIT_V(n) asm volatile("s_waitcnt vmcnt(" #n ")" ::: "memory")
#define PG8_WAIT_L(n) asm volatile("s_waitcnt lgkmcnt(" #n ")" ::: "memory")
#define PG8_BAR __builtin_amdgcn_s_barrier()
#define PG8_SCHED __builtin_amdgcn_sched_barrier(0)
    Unit cur, nxt; int ui = 0;
    if (!S.next(0, cur)) return;
    f32x4 acc[2][2][4][2];
#pragma unroll
    for (int a = 0; a < 2; ++a)
#pragma unroll
        for (int b = 0; b < 2; ++b)
#pragma unroll
            for (int m = 0; m < 4; ++m)
#pragma unroll
                for (int n = 0; n < 2; ++n) acc[a][b][m][n] = (f32x4){0.f, 0.f, 0.f, 0.f};
    bf16x8 At[4][2], B0[2][2], B1[2][2];
    const char* cA = (const char*)g.A + (size_t)cur.pm * tstep; const char* cB = (const char*)g.Bt + (size_t)cur.pn * tstep;
    S.a_ready(cur);
    if constexpr (SP2) {
        PG8_STAGE(PG8_SB(0, 0), cB, voffB); PG8_STAGE(PG8_SB(0, 1), cB + hstep, voffB); PG8_STAGE(PG8_SA(0, 0), cA, voffA); PG8_STAGE(PG8_SA(0, 1), cA + hstep, voffA);
        if (wr == 1) PG8_BAR;
        PG8_WAIT_V(2); PG8_BAR;
        PG8_STAGE(PG8_SB(1, 0), cB + kstep, voffB); PG8_STAGE(PG8_SA(1, 0), cA + kstep, voffA); PG8_STAGE(PG8_SB(1, 1), cB + hstep + kstep, voffB);
        PG8_WAIT_V(6); PG8_BAR;
    } else {
        PG8_STAGE(PG8_SB(0, 0), cB, voffB); PG8_STAGE(PG8_SA(0, 0), cA, voffA); PG8_STAGE(PG8_SB(0, 1), cB + hstep, voffB); PG8_STAGE(PG8_SA(0, 1), cA + hstep, voffA);
        if (wr == 1) PG8_BAR;
        PG8_WAIT_V(4); PG8_BAR;
        PG8_STAGE(PG8_SB(1, 0), cB + kstep, voffB); PG8_STAGE(PG8_SA(1, 0), cA + kstep, voffA); PG8_STAGE(PG8_SB(1, 1), cB + hstep + kstep, voffB);
        PG8_WAIT_V(6); PG8_BAR;
    }
    for (;;) {
        const bool has_next = S.next(ui + 1, nxt);
        const char* nA = has_next ? (const char*)g.A + (size_t)nxt.pm * tstep : cA; const char* nB = has_next ? (const char*)g.Bt + (size_t)nxt.pn * tstep : cB;
        for (int t = 0; t < nt; t += 2) {
            const bool last = (t == nt - 2);
            const char* a1 = cA + (size_t)(t + 1) * kstep;
            const char* a2 = last ? nA : cA + (size_t)(t + 2) * kstep; const char* b2 = last ? nB : cB + (size_t)(t + 2) * kstep;
            const char* a3 = a2 + kstep; const char* b3 = b2 + kstep;
            if (last && has_next) S.a_ready(nxt);
            if constexpr (SP2) {
            PG8_LDB(B0, 0, 0); PG8_LDB(B1, 0, 1); PG8_SCHED; PG8_LDA(At, 0, 0); PG8_STAGE(PG8_SA(1, 1), a1 + hstep, voffA);
            PG8_WAIT_V(8); PG8_WAIT_L(0); PG8_BAR; PG8_MMA(0, 0, At, B0); PG8_MMA(0, 1, At, B1); PG8_BAR; PG8_SCHED;
            PG8_LDA(At, 0, 1); PG8_STAGE(PG8_SB(0, 0), b2, voffB); PG8_STAGE(PG8_SB(0, 1), b2 + hstep, voffB); PG8_STAGE(PG8_SA(0, 0), a2, voffA);
            PG8_WAIT_V(8); PG8_WAIT_L(0); PG8_BAR; PG8_MMA(1, 0, At, B0); PG8_MMA(1, 1, At, B1); PG8_BAR; PG8_SCHED;
            PG8_LDB(B0, 1, 0); PG8_LDB(B1, 1, 1); PG8_SCHED; PG8_LDA(At, 1, 0); PG8_STAGE(PG8_SA(0, 1), a2 + hstep, voffA);
            PG8_WAIT_V(8); PG8_WAIT_L(0); PG8_BAR; PG8_MMA(0, 0, At, B0); PG8_MMA(0, 1, At, B1); PG8_BAR; PG8_SCHED;
            PG8_LDA(At, 1, 1); PG8_STAGE(PG8_SB(1, 0), b3, voffB); PG8_STAGE(PG8_SB(1, 1), b3 + hstep, voffB); PG8_STAGE(PG8_SA(1, 0), a3, voffA);
            PG8_WAIT_V(8); PG8_WAIT_L(0); PG8_BAR; PG8_MMA(1, 0, At, B0); PG8_MMA(1, 1, At, B1); PG8_BAR; PG8_SCHED;
            } else {
            PG8_LDB(B0, 0, 0); PG8_SCHED; PG8_LDA(At, 0, 0); PG8_STAGE(PG8_SA(1, 1), a1 + hstep, voffA);
            PG8_WAIT_L(8); PG8_BAR; PG8_WAIT_L(0); PG8_MMA(0, 0, At, B0); PG8_BAR; PG8_SCHED;
            PG8_LDB(B1, 0, 1); PG8_STAGE(PG8_SB(0, 0), b2, voffB);
            PG8_BAR; PG8_WAIT_L(0); PG8_MMA(0, 1, At, B1); PG8_BAR;
            PG8_LDA(At, 0, 1); PG8_STAGE(PG8_SA(0, 0), a2, voffA);
            PG8_BAR; PG8_WAIT_L(0); PG8_MMA(1, 0, At, B0); PG8_BAR; PG8_SCHED;
            PG8_STAGE(PG8_SB(0, 1), b2 + hstep, voffB);
            PG8_WAIT_V(6); PG8_BAR; PG8_MMA(1, 1, At, B1); PG8_BAR;
            PG8_LDB(B0, 1, 0); PG8_SCHED; PG8_LDA(At, 1, 0); PG8_STAGE(PG8_SA(0, 1), a2 + hstep, voffA);
            PG8_WAIT_L(8); PG8_BAR; PG8_WAIT_L(0); PG8_MMA(0, 0, At, B0); PG8_BAR; PG8_SCHED;
            PG8_LDB(B1, 1, 1); PG8_STAGE(PG8_SB(1, 0), b3, voffB);
            PG8_BAR; PG8_WAIT_L(0); PG8_MMA(0, 1, At, B1); PG8_BAR;
            PG8_LDA(At, 1, 1); PG8_STAGE(PG8_SA(1, 0), a3, voffA);
            PG8_BAR; PG8_WAIT_L(0); PG8_MMA(1, 0, At, B0); PG8_BAR; PG8_SCHED;
            PG8_STAGE(PG8_SB(1, 1), b3 + hstep, voffB);
            PG8_WAIT_V(6); PG8_BAR; PG8_MMA(1, 1, At, B1); PG8_BAR;
            }
        }
        if constexpr (ALIGN_EPI) { if (wr == 0) PG8_BAR; }
        if constexpr (!Epi::AFTER_DRAIN) { E(acc, cur, wr, wc, fr, fq); S.done(cur); }
        if (!has_next) break;
#pragma unroll
        for (int a = 0; a < 2; ++a)
#pragma unroll
            for (int b = 0; b < 2; ++b)
#pragma unroll
                for (int m = 0; m < 4; ++m)
#pragma unroll
                    for (int n = 0; n < 2; ++n) acc[a][b][m][n] = (f32x4){0.f, 0.f, 0.f, 0.f};
        cur = nxt; cA = nA; cB = nB; ++ui;
        if constexpr (ALIGN_EPI) { if (wr == 1) PG8_BAR; }
    }
    PG8_WAIT_V(0);
    if constexpr (!ALIGN_EPI) { if (wr == 0) PG8_BAR; }
    PG8_BAR;
    if constexpr (Epi::AFTER_DRAIN) { E.fused(acc, cur, wr, wc, fr, fq, lds, wid, lane); S.done(cur); }
#undef PG8_SA
#undef PG8_SB
#undef PG8_STAGE
#undef PG8_LDA
#undef PG8_LDB
#undef PG8_MMA
#undef PG8_WAIT_V
#undef PG8_WAIT_L
#undef PG8_BAR
#undef PG8_SCHED
}
}

#ifndef MK_N_LAUNCHES
#define MK_N_LAUNCHES 1
#endif
constexpr int NWAVES = 8, NTHR = 512;
constexpr int BATCH = 2, SEQ = 16384, T = BATCH * SEQ, D = 1024, DEPTH = 2, DFF = 2816;
constexpr int NIN = 3584, NGU = 5632, PROJ_LD = 3328, AUX_LD = 256;
constexpr float DN_ALPHA = 1.41421356237309515f, LN_EPS = 1e-5f;
constexpr int PC_LX = 0, PC_LG = 256, PC_GQ = 512, PC_GK = 896, PC_GV = 1280, PC_GG = 1664, PC_DQ = 2048, PC_DK = 2432, PC_DV = 2816;
constexpr int AC_GLR = 0, AC_IQ = 16, AC_IK = 144, AC_IW = 176;
constexpr int YC_LRU = 0, YC_GLA = 256, YC_DSA = 640;
enum { I_X = 0, I_WIN, I_CONVW, I_CONVB, I_WA, I_BA, I_WX, I_BX, I_LAM, I_WG2, I_BG, I_NG, I_RB, I_WOUT, I_LN1G, I_LN1B, I_WFG, I_WFU, I_WFD, I_LN2G, I_LN2B, N_INPUTS };

constexpr size_t MiB = 1u << 20;
constexpr size_t WS_CTL = 0, CTL_ZERO_BYTES = 1 * MiB;
constexpr size_t WS_W = 1 * MiB, W_LAYER = 26 * MiB, WO_IN = 0, WO_OUT = 7 * MiB, WO_GU = 9 * MiB, WO_D = 20 * MiB;
constexpr size_t WS_XB = 54 * MiB, WS_PROJ = 118 * MiB, WS_AUX = 326 * MiB, WS_R2 = 358 * MiB, WS_END = 486 * MiB;
constexpr size_t WS_V1 = WS_PROJ, WS_H = WS_PROJ, WS_Y = WS_R2, WS_GLAU = WS_R2 + 64 * MiB, WS_DEC = WS_R2 + 112 * MiB, WS_LSUM = WS_R2 + 113 * MiB, WS_CARRY = WS_R2 + 117 * MiB, WS_V2 = WS_R2;
static_assert(WO_IN + (size_t)NIN * D * 2 <= WO_OUT && WO_OUT + (size_t)D * D * 2 <= WO_GU && WO_GU + (size_t)NGU * D * 2 <= WO_D && WO_D + (size_t)D * DFF * 2 <= W_LAYER, "weight map");
static_assert(WS_W + 2 * W_LAYER <= WS_XB && WS_XB + (size_t)T * D * 2 <= WS_PROJ && WS_PROJ + (size_t)T * PROJ_LD * 2 <= WS_AUX && WS_AUX + (size_t)T * AUX_LD * 4 <= WS_R2, "ws map");
static_assert((size_t)T * DFF * 2 <= WS_AUX - WS_PROJ && (size_t)T * D * 4 <= WS_AUX - WS_PROJ && WS_CARRY + 2 * MiB <= WS_END && (size_t)T * D * 4 <= WS_END - WS_R2, "ws overlays");
constexpr int CW_BAR = 4096;

constexpr int RING_OFF = 0, RING_BYTES = 131072;
constexpr int LDSCTL_OFF = RING_BYTES, MISC_OFF = LDSCTL_OFF + 320;
constexpr int LDS_BYTES = 147456;

#define GAS __attribute__((address_space(1)))
#define LAS __attribute__((address_space(3)))
typedef unsigned short bf16;
typedef unsigned v4u __attribute__((ext_vector_type(4)));
typedef unsigned v2u __attribute__((ext_vector_type(2)));
typedef float f32x4 __attribute__((ext_vector_type(4)));
typedef GAS unsigned gu32;
#define RLX_AGENT __ATOMIC_RELAXED, __HIP_MEMORY_SCOPE_AGENT
#define LDS_WAIT() asm volatile("s_waitcnt lgkmcnt(0)" ::: "memory")
#define VM_WAIT() asm volatile("s_waitcnt vmcnt(0)" ::: "memory")
__device__ __forceinline__ unsigned f2bf(float f) { unsigned u = __builtin_bit_cast(unsigned, f); return (u + 0x7fffu + ((u >> 16) & 1u)) >> 16; }
__device__ __forceinline__ unsigned pk2(float lo, float hi) { return f2bf(lo) | (f2bf(hi) << 16); }
__device__ __forceinline__ float bf2f(unsigned short h) { return __builtin_bit_cast(float, (unsigned)h << 16); }
__device__ __forceinline__ float bflo(unsigned w) { return __builtin_bit_cast(float, w << 16); }
__device__ __forceinline__ float bfhi(unsigned w) { return __builtin_bit_cast(float, w & 0xffff0000u); }

#define XB_TMO      128
#define XB_XCNT(j)  (256  + 64 * (j))
#define XB_XSUB(j)  (1280 + 64 * (j))
#define XB_XGEN(j)  (2304 + 64 * (j))
#define XB_TOP      3328
#define XB_TOPGEN   3392
#define XCD_BAR_WORDS 3456
#define XB_SPIN_CAP (1u << 18)

__device__ __forceinline__ unsigned xb_ld(unsigned* p)              { return __hip_atomic_load(p, __ATOMIC_RELAXED, __HIP_MEMORY_SCOPE_AGENT); }
__device__ __forceinline__ unsigned xb_add(unsigned* p, unsigned v) { return __hip_atomic_fetch_add(p, v, __ATOMIC_RELAXED, __HIP_MEMORY_SCOPE_AGENT); }
__device__ __forceinline__ unsigned xb_xcc_id() { return (unsigned)__builtin_amdgcn_s_getreg((3 << 11) | 20) & 0xFu; }
#define XB_SPIN(cond, bar) do { unsigned _sp = 0; while (cond) { __builtin_amdgcn_s_sleep(1); \
    if ((++_sp & 255u) == 0u) { if (xb_ld(&(bar)[XB_TMO])) break; if (_sp > XB_SPIN_CAP) { atomicAdd(&(bar)[XB_TMO], 1u); break; } } } } while (0)

struct XcdBarrier {
    unsigned* bar; unsigned x;
    volatile LAS unsigned* st;
};

__device__ __forceinline__ XcdBarrier xcd_barrier_post(unsigned* bar, volatile LAS unsigned* st) {
    XcdBarrier b; b.bar = bar; b.x = xb_xcc_id(); b.st = st;
    if (threadIdx.x == 0) (void)xb_add(&bar[XB_XCNT(b.x)], 1u);
    return b;
}
__device__ __forceinline__ void xcd_barrier_complete(unsigned* bar, unsigned x, unsigned& nloc, unsigned& nx) {
    const unsigned G = gridDim.x * gridDim.y * gridDim.z;
    unsigned sum, cnt, mine, sp = 0u;
    for (;;) {
        sum = 0u; cnt = 0u; mine = 0u;
#pragma unroll
        for (unsigned j = 0; j < 16; ++j) { const unsigned c = xb_ld(&bar[XB_XCNT(j)]); sum += c; cnt += (c > 0u) ? 1u : 0u; mine = (j == x) ? c : mine; }
        if (sum == G) break;
        __builtin_amdgcn_s_sleep(1);
        if ((++sp & 255u) == 0u) { if (xb_ld(&bar[XB_TMO])) break; if (sp > XB_SPIN_CAP) { atomicAdd(&bar[XB_TMO], 1u); break; } }
    }
    nloc = mine > 0u ? mine : 1u; nx = cnt > 0u ? cnt : 1u;
}

__device__ __forceinline__ void xcd_barrier(const XcdBarrier& b) {
    asm volatile("s_waitcnt vmcnt(0)" ::: "memory");
    __syncthreads();
    if (threadIdx.x == 0) {
        unsigned* bar = b.bar;
        __builtin_amdgcn_s_waitcnt(0);
        unsigned nloc = b.st[0], nx = b.st[1];
        if (nloc == 0u) { xcd_barrier_complete(bar, b.x, nloc, nx); b.st[0] = nloc; b.st[1] = nx; }
        const unsigned old = xb_add(&bar[XB_XSUB(b.x)], 1u);
        const unsigned gen = old / nloc;
        if (old + 1u == (gen + 1u) * nloc) {
            __builtin_amdgcn_fence(__ATOMIC_RELEASE, "agent");
            asm volatile("s_waitcnt vmcnt(0)" ::: "memory");
            const unsigned og = xb_add(&bar[XB_TOP], 1u);
            const unsigned tg = og / nx;
            if (og + 1u == (tg + 1u) * nx) xb_add(&bar[XB_TOPGEN], 1u);
            else XB_SPIN(xb_ld(&bar[XB_TOPGEN]) == tg, bar);
            __builtin_amdgcn_fence(__ATOMIC_ACQUIRE, "agent");
            xb_add(&bar[XB_XGEN(b.x)], 1u);
            asm volatile("s_waitcnt vmcnt(0)" ::: "memory");
        } else {
            XB_SPIN(xb_ld(&bar[XB_XGEN(b.x)]) == gen, bar);
            __builtin_amdgcn_fence(__ATOMIC_ACQUIRE, "agent");
            asm volatile("s_waitcnt vmcnt(0)" ::: "memory");
        }
    }
    __syncthreads();
}


struct Args { const float* in[N_INPUTS]; float* out; unsigned char* ws; int ph_lo, ph_hi; };
struct Frame {
    unsigned char* lds;
    int tid, lane, wave, G;
    float* out; unsigned char* ws;
};
__device__ __forceinline__ bf16* w_ptr(const Frame& F, int l, size_t off) { return (bf16*)(F.ws + WS_W + (size_t)l * W_LAYER + off); }

__device__ __forceinline__ float wave_sum(float v) {
#pragma unroll
    for (int o = 1; o < 64; o <<= 1) v += __shfl_xor(v, o);
    return v;
}

__device__ __forceinline__ void transpose_item(const float* W, int K, int N, bf16* Wt, float* scr, int kb, int rb, int lane, int sc) {
    const int k0 = 64 * kb, r0 = 32 * rb, rl = lane & 31;
#pragma unroll 8
    for (int i = 0; i < 32; ++i) { const int kk = 2 * i + (lane >> 5); scr[kk * 33 + rl] = sc >= 0 ? W[(size_t)(k0 + kk) * N + sc] : 0.f; }
    LDS_WAIT(); asm volatile("" ::: "memory");
    const int c = lane & 7;
#pragma unroll
    for (int j = 0; j < 4; ++j) { const int n = (lane >> 3) + 8 * j; const float* s = scr + (8 * c) * 33 + n;
        v4u o; o.x = pk2(s[0 * 33], s[1 * 33]); o.y = pk2(s[2 * 33], s[3 * 33]); o.z = pk2(s[4 * 33], s[5 * 33]); o.w = pk2(s[6 * 33], s[7 * 33]);
        *(v4u*)(Wt + (size_t)(r0 + n) * K + k0 + 8 * c) = o; }
    LDS_WAIT(); asm volatile("" ::: "memory");
}
__device__ __forceinline__ int win_src(int r) {
    if (r < 2048) return r;
    if (r < 3200) return r + 16;
    if (r < 3328) return -1;
    if (r < 3344) return 2048 + (r - 3328);
    if (r < 3508) return 3216 + (r - 3344);
    return -1;
}
__device__ __forceinline__ void p0_prologue(Frame& F, const Args& A) {
    float* scr = (float*)(F.lds + RING_OFF + F.wave * 16384);
    const int gw = blockIdx.x * NWAVES + F.wave, NGW = F.G * NWAVES;
    constexpr int I_IN = 16 * (NIN / 32), I_OUT = 16 * (D / 32), I_GU = 16 * (NGU / 32), I_D = (DFF / 64) * (D / 32), I_L = I_IN + I_OUT + I_GU + I_D;
    for (int it = gw; it < DEPTH * I_L; it += NGW) {
        const int l = it / I_L; int r = it % I_L;
        if (r < I_IN) { const int kb = r / (NIN / 32), rb = r % (NIN / 32); transpose_item(A.in[I_WIN] + (size_t)l * D * 3380, D, 3380, w_ptr(F, l, WO_IN), scr, kb, rb, F.lane, win_src(rb * 32 + (F.lane & 31))); continue; } r -= I_IN;
        if (r < I_OUT) { const int kb = r / (D / 32), rb = r % (D / 32); transpose_item(A.in[I_WOUT] + (size_t)l * D * D, D, D, w_ptr(F, l, WO_OUT), scr, kb, rb, F.lane, rb * 32 + (F.lane & 31)); continue; } r -= I_OUT;
        if (r < I_GU) { const int kb = r / (NGU / 32), rb = r % (NGU / 32); const int row = rb * 32 + (F.lane & 31), tile = row >> 8, w = row & 255; const bool up = w >= 128;
            transpose_item(A.in[up ? I_WFU : I_WFG] + (size_t)l * D * DFF, D, DFF, w_ptr(F, l, WO_GU), scr, kb, rb, F.lane, tile * 128 + (w & 127)); continue; } r -= I_GU;
        { const int kb = r / (D / 32), rb = r % (D / 32); transpose_item(A.in[I_WFD] + (size_t)l * DFF * D, DFF, D, w_ptr(F, l, WO_D), scr, kb, rb, F.lane, rb * 32 + (F.lane & 31)); }
    }
    const float* x = A.in[I_X]; bf16* xb = (bf16*)(F.ws + WS_XB);
    for (int m = gw; m < T; m += NGW) {
        const f32x4* xr = (const f32x4*)(x + (size_t)m * D) + F.lane; unsigned long long* o8 = (unsigned long long*)(xb + (size_t)m * D) + F.lane;
#pragma unroll
        for (int j = 0; j < 4; ++j) { const f32x4 v = xr[64 * j]; o8[64 * j] = (unsigned long long)pk2(v.x, v.y) | ((unsigned long long)pk2(v.z, v.w) << 32); }
    }
}

__device__ __forceinline__ void ln_phase(Frame& F, const float* V, const float* g, const float* b, float* xf, bf16* xb) {
    const int gw = blockIdx.x * NWAVES + F.wave, NGW = F.G * NWAVES;
    f32x4 gv[4], bv[4];
#pragma unroll
    for (int j = 0; j < 4; ++j) { gv[j] = ((const f32x4*)g)[F.lane + 64 * j]; bv[j] = ((const f32x4*)b)[F.lane + 64 * j]; }
    for (int m = gw; m < T; m += NGW) {
        const f32x4* xr = (const f32x4*)(V + (size_t)m * D) + F.lane;
        f32x4 v[4]; float s = 0.f;
#pragma unroll
        for (int j = 0; j < 4; ++j) { v[j] = xr[64 * j]; s += (v[j].x + v[j].y) + (v[j].z + v[j].w); }
        const float mean = wave_sum(s) * (1.f / D); float s2 = 0.f;
#pragma unroll
        for (int j = 0; j < 4; ++j) { v[j] = v[j] - mean; s2 += (v[j].x * v[j].x + v[j].y * v[j].y) + (v[j].z * v[j].z + v[j].w * v[j].w); }
        const float rstd = 1.f / sqrtf(wave_sum(s2) * (1.f / D) + LN_EPS);
        f32x4* of = (f32x4*)(xf + (size_t)m * D) + F.lane; unsigned long long* o8 = (unsigned long long*)(xb + (size_t)m * D) + F.lane;
#pragma unroll
        for (int j = 0; j < 4; ++j) { const f32x4 o = v[j] * rstd * gv[j] + bv[j]; of[64 * j] = o; o8[64 * j] = (unsigned long long)pk2(o.x, o.y) | ((unsigned long long)pk2(o.z, o.w) << 32); }
    }
}

__device__ __forceinline__ float sigmoidf_(float x) { return 1.f / (1.f + expf(-x)); }
__device__ __forceinline__ float gelu_tanh(float x) { const float u = 0.7978845608028654f * (x + 0.044715f * x * x * x); return 0.5f * x * (1.f + tanhf(u)); }
__device__ __forceinline__ void lru_item(Frame& F, const Args& A, int l, int it, bool fin) {
    float* XC = (float*)(F.lds + RING_OFF);
    const bf16* proj = (const bf16*)(F.ws + WS_PROJ);
    const int b = it >> 9, t0 = (it & 511) * 32, c = F.tid & 255, half = F.tid >> 8, ts = t0 + half * 16, ck = ts >> 4;
    const float* cw = A.in[I_CONVW] + (size_t)l * 4 * 256; const float cb = A.in[I_CONVB][l * 256 + c];
    const float w0 = cw[c], w1 = cw[256 + c], w2 = cw[512 + c], w3 = cw[768 + c];
    __syncthreads();
    {
        float xm3 = 0.f, xm2 = 0.f, xm1 = 0.f;
        if (ts >= 3) { xm3 = bf2f(proj[(size_t)(b * SEQ + ts - 3) * PROJ_LD + PC_LX + c]); xm2 = bf2f(proj[(size_t)(b * SEQ + ts - 2) * PROJ_LD + PC_LX + c]); xm1 = bf2f(proj[(size_t)(b * SEQ + ts - 1) * PROJ_LD + PC_LX + c]); }
#pragma unroll 4
        for (int i = 0; i < 16; ++i) { const float x0 = bf2f(proj[(size_t)(b * SEQ + ts + i) * PROJ_LD + PC_LX + c]);
            XC[(half * 16 + i) * 256 + c] = cb + w0 * xm3 + w1 * xm2 + w2 * xm1 + w3 * x0; xm3 = xm2; xm2 = xm1; xm1 = x0; }
    }
    __syncthreads();
    const int n = c >> 6, j = c & 63;
    const float* wa = A.in[I_WA] + (size_t)l * 4 * 64 * 64 + (size_t)n * 64 * 64 + j; const float* wx = A.in[I_WX] + (size_t)l * 4 * 64 * 64 + (size_t)n * 64 * 64 + j;
    const float ba = A.in[I_BA][l * 256 + c], bx = A.in[I_BX][l * 256 + c], lam = A.in[I_LAM][l * 256 + c];
    const float sp8 = -8.f * log1pf(expf(-lam));
    float h = 0.f, P = 1.f;
    if (fin) h = ((const float*)(F.ws + WS_CARRY))[(size_t)(b * 256 + c) * 1024 + ck];
    float rp[16], ip[16];
#pragma unroll
    for (int i = 0; i < 16; ++i) { rp[i] = ba; ip[i] = bx; }
    for (int k = 0; k < 64; ++k) { const float a_ = wa[k * 64], x_ = wx[k * 64];
#pragma unroll
        for (int i = 0; i < 16; ++i) { const float xv = XC[(half * 16 + i) * 256 + n * 64 + k]; rp[i] += xv * a_; ip[i] += xv * x_; } }
    bf16* Y = (bf16*)(F.ws + WS_Y);
#pragma unroll
    for (int i = 0; i < 16; ++i) {
        const float xc = XC[(half * 16 + i) * 256 + c];
        const float r = sigmoidf_(rp[i]), ig = sigmoidf_(ip[i]);
        const float la = sp8 * r, a = expf(la), u = sqrtf(-expm1f(2.f * la)) * (ig * xc);
        h = a * h + u; P *= a;
        if (fin) { const size_t tok = (size_t)(b * SEQ + ts + i); const float g = bf2f(proj[tok * PROJ_LD + PC_LG + c]); Y[tok * D + YC_LRU + c] = (bf16)f2bf(h * gelu_tanh(g)); }
    }
    if (!fin) { float2* S = (float2*)(F.ws + WS_LSUM); S[(size_t)(b * 256 + c) * 1024 + ck] = make_float2(P, h); }
}
__device__ __forceinline__ void lru_scan_row(Frame& F, int row) {
    const float2* S = (const float2*)(F.ws + WS_LSUM) + (size_t)row * 1024 + F.lane * 16; float* C = (float*)(F.ws + WS_CARRY) + (size_t)row * 1024 + F.lane * 16;
    float2 e[16];
#pragma unroll
    for (int i = 0; i < 16; ++i) e[i] = S[i];
    float P = 1.f, h = 0.f;
#pragma unroll
    for (int i = 0; i < 16; ++i) { h = e[i].x * h + e[i].y; P *= e[i].x; }
#pragma unroll
    for (int o = 1; o < 64; o <<= 1) { const float Pp = __shfl_up(P, o), hp = __shfl_up(h, o); if (F.lane >= o) { h = P * hp + h; P = Pp * P; } }
    float hc = __shfl_up(h, 1); if (F.lane == 0) hc = 0.f;
#pragma unroll
    for (int i = 0; i < 16; ++i) { C[i] = hc; hc = e[i].x * hc + e[i].y; }
}

__device__ __forceinline__ void gla_item(Frame& F, const Args& A, int l, int it, bool fin) {
    constexpr int LP = 65;
    float* bc = (float*)(F.lds + RING_OFF); float* qd = bc + 64 * LP; float* ki = qd + 64 * LP; float* ke = ki + 64 * LP; float* vv = ke + 64 * LP; float* att = vv + 64 * LP;
    float* glr = att + 64 * LP; float* w2 = glr + 1024; float* bg = w2 + 1024;
    const int b = it / 1536, r_ = it % 1536, n = r_ / 6, h = r_ % 6; const size_t tok0 = (size_t)b * SEQ + (size_t)n * 64;
    const bf16* proj = (const bf16*)(F.ws + WS_PROJ); const float* aux = (const float*)(F.ws + WS_AUX);
    float* U = (float*)(F.ws + WS_GLAU) + (size_t)it * 4096; float* DEC = (float*)(F.ws + WS_DEC) + (size_t)it * 64;
    const int tid = F.tid;
    __syncthreads();
    for (int i = tid; i < 1024; i += NTHR) { const int c = i >> 4, r = i & 15; glr[i] = aux[(tok0 + c) * AUX_LD + AC_GLR + r]; }
    for (int i = tid; i < 1024; i += NTHR) { const int r = i >> 6, d = i & 63; w2[i] = A.in[I_WG2][(size_t)l * 16 * 384 + r * 384 + h * 64 + d]; }
    if (tid < 64) bg[tid] = A.in[I_BG][l * 384 + h * 64 + tid];
    __syncthreads();
    for (int e = tid; e < 4096; e += NTHR) { const int c = e >> 6, d = e & 63; float z = bg[d];
#pragma unroll
        for (int r = 0; r < 16; ++r) z += glr[c * 16 + r] * w2[r * 64 + d];
        bc[c * LP + d] = (fminf(z, 0.f) - log1pf(expf(-fabsf(z)))) * (1.f / 16.f); }
    __syncthreads();
    if (tid < 64) { float s = 0.f; for (int c = 0; c < 64; ++c) { s += bc[c * LP + tid]; bc[c * LP + tid] = s; } }
    __syncthreads();
    for (int e = tid; e < 4096; e += NTHR) { const int c = e >> 6, d = e & 63; const float b_ = bc[c * LP + d], bl = bc[63 * LP + d];
        const bf16* row = proj + (tok0 + c) * PROJ_LD + h * 64 + d;
        const float q = bf2f(row[PC_GQ]), k = bf2f(row[PC_GK]), v = bf2f(row[PC_GV]);
        qd[c * LP + d] = q * 0.125f * expf(b_); ki[c * LP + d] = k * expf(-b_); ke[c * LP + d] = k * expf(bl - b_); vv[c * LP + d] = v; }
    __syncthreads();
    if (!fin) {
        const int d = tid >> 3, dv0 = (tid & 7) * 8; float acc[8];
#pragma unroll
        for (int j = 0; j < 8; ++j) acc[j] = 0.f;
        for (int c = 0; c < 64; ++c) { const float kd = ke[c * LP + d];
#pragma unroll
            for (int j = 0; j < 8; ++j) acc[j] += kd * vv[c * LP + dv0 + j]; }
#pragma unroll
        for (int j = 0; j < 8; ++j) U[d * 64 + dv0 + j] = acc[j];
        if (tid < 64) DEC[tid] = expf(bc[63 * LP + tid]);
    } else {
        const int c = tid >> 3, s0 = (tid & 7) * 8, dv0 = s0; float a[8];
#pragma unroll
        for (int j = 0; j < 8; ++j) a[j] = 0.f;
        for (int d = 0; d < 64; ++d) { const float qv = qd[c * LP + d];
#pragma unroll
            for (int j = 0; j < 8; ++j) a[j] += qv * ki[(s0 + j) * LP + d]; }
#pragma unroll
        for (int j = 0; j < 8; ++j) att[c * LP + s0 + j] = (s0 + j <= c) ? a[j] : 0.f;
        for (int e = tid; e < 4096; e += NTHR) ke[(e >> 6) * LP + (e & 63)] = U[e];
        __syncthreads();
        float o[8];
#pragma unroll
        for (int j = 0; j < 8; ++j) o[j] = 0.f;
        for (int s = 0; s < 64; ++s) { const float av = att[c * LP + s];
#pragma unroll
            for (int j = 0; j < 8; ++j) o[j] += av * vv[s * LP + dv0 + j]; }
        for (int d = 0; d < 64; ++d) { const float qv = qd[c * LP + d];
#pragma unroll
            for (int j = 0; j < 8; ++j) o[j] += qv * ke[d * LP + dv0 + j]; }
        float ss = 0.f;
#pragma unroll
        for (int j = 0; j < 8; ++j) ss += o[j] * o[j];
        ss += __shfl_xor(ss, 1); ss += __shfl_xor(ss, 2); ss += __shfl_xor(ss, 4);
        const float rs = 1.f / sqrtf(ss * (1.f / 64.f) + 1e-6f);
        const bf16* grow = proj + (tok0 + c) * PROJ_LD + PC_GG + h * 64 + dv0; const float* ng = A.in[I_NG] + l * 384 + h * 64 + dv0;
        float y[8];
#pragma unroll
        for (int j = 0; j < 8; ++j) { const float g = bf2f(grow[j]); y[j] = o[j] * rs * ng[j] * (g / (1.f + expf(-g))); }
        v4u w; w.x = pk2(y[0], y[1]); w.y = pk2(y[2], y[3]); w.z = pk2(y[4], y[5]); w.w = pk2(y[6], y[7]);
        *(v4u*)((bf16*)(F.ws + WS_Y) + (tok0 + c) * D + YC_GLA + h * 64 + dv0) = w;
    }
}
__device__ __forceinline__ void gla_scan(Frame& F, int e) {
    const int bh = e >> 12, idx = e & 4095, d = idx >> 6, b = bh / 6, h = bh % 6;
    float* U = (float*)(F.ws + WS_GLAU); const float* DEC = (const float*)(F.ws + WS_DEC);
    float S = 0.f;
    for (int n0 = 0; n0 < 256; n0 += 8) {
        float u[8], dc[8];
#pragma unroll
        for (int i = 0; i < 8; ++i) { const size_t it = (size_t)b * 1536 + (size_t)(n0 + i) * 6 + h; u[i] = U[it * 4096 + idx]; dc[i] = DEC[it * 64 + d]; }
#pragma unroll
        for (int i = 0; i < 8; ++i) { const size_t it = (size_t)b * 1536 + (size_t)(n0 + i) * 6 + h; U[it * 4096 + idx] = S; S = dc[i] * S + u[i]; }
    }
}

__device__ __forceinline__ unsigned f2ord(float f) { const unsigned u = __builtin_bit_cast(unsigned, f); return u ^ ((u >> 31) ? 0xffffffffu : 0x80000000u); }
__device__ __forceinline__ float ord2f(unsigned v) { const unsigned u = (v & 0x80000000u) ? (v ^ 0x80000000u) : ~v; return __builtin_bit_cast(float, u); }
__device__ __forceinline__ int popc64(unsigned long long m) { return __builtin_popcountll(m); }
__device__ __forceinline__ int t5_bucket(int n) { if (n < 16) return n; const int v = 16 + (int)(__log2f((float)n * (1.f / 16.f)) * (16.f / 3.f)); return v < 31 ? v : 31; }
__device__ __forceinline__ unsigned dsa_compact(v2u* buf, int n, int lane) {
    unsigned o[8], id[8];
#pragma unroll
    for (int j = 0; j < 8; ++j) { const int e = j * 64 + lane; if (e < n) { const v2u x = buf[e]; o[j] = x.x; id[j] = x.y; } else { o[j] = 0u; id[j] = 0u; } }
    unsigned v = 0u;
    for (int bit = 31; bit >= 0; --bit) { const unsigned cand = v | (1u << bit); int c = 0;
#pragma unroll
        for (int j = 0; j < 8; ++j) c += popc64(__ballot(o[j] >= cand));
        if (c >= 256) v = cand; }
    int ngt = 0;
#pragma unroll
    for (int j = 0; j < 8; ++j) ngt += popc64(__ballot(o[j] > v));
    const int need = 256 - ngt; int outp = 0, tie_seen = 0;
    const unsigned long long lt = (1ull << lane) - 1ull;
#pragma unroll
    for (int j = 0; j < 8; ++j) {
        const bool isgt = o[j] > v, iseq = o[j] == v;
        const unsigned long long eqm = __ballot(iseq);
        const bool keep = isgt || (iseq && (tie_seen + popc64(eqm & lt)) < need);
        const unsigned long long km = __ballot(keep);
        if (keep) { v2u x; x.x = o[j]; x.y = id[j]; buf[outp + popc64(km & lt)] = x; }
        outp += popc64(km); tie_seen += popc64(eqm);
    }
    return v;
}
__device__ __forceinline__ void dsa_query(Frame& F, const Args& A, int l, int qg) {
    const int lane = F.lane, b = qg >> 14, t = qg & (SEQ - 1);
    float* qs = (float*)(F.lds + RING_OFF + F.wave * 5120); v2u* buf = (v2u*)(F.lds + RING_OFF + F.wave * 5120 + 512 + 512);
    const float* aux = (const float*)(F.ws + WS_AUX); const bf16* proj = (const bf16*)(F.ws + WS_PROJ);
    const float* arow = aux + (size_t)qg * AUX_LD;
    qs[lane] = arow[AC_IQ + lane]; qs[64 + lane] = arow[AC_IQ + 64 + lane];
    float wv[4];
#pragma unroll
    for (int i = 0; i < 4; ++i) wv[i] = arow[AC_IW + i] * 0.5f;
    LDS_WAIT(); asm volatile("" ::: "memory");
    int cnt = 0; float thr = -INFINITY;
    const int ntile = (t >> 6) + 1;
    const unsigned long long lt = (1ull << lane) - 1ull;
    for (int tile = 0; tile < ntile; ++tile) {
        const int s = tile * 64 + lane; const bool valid = s <= t; const int sc = valid ? s : t;
        const f32x4* kp = (const f32x4*)(aux + ((size_t)b * SEQ + sc) * AUX_LD + AC_IK);
        f32x4 k[8];
#pragma unroll
        for (int j = 0; j < 8; ++j) k[j] = kp[j];
        float score = 0.f;
#pragma unroll
        for (int i = 0; i < 4; ++i) { float d = 0.f;
#pragma unroll
            for (int j = 0; j < 8; ++j) { const f32x4 q4 = *(const f32x4*)(qs + i * 32 + j * 4); d += q4.x * k[j].x; d += q4.y * k[j].y; d += q4.z * k[j].z; d += q4.w * k[j].w; }
            score += fmaxf(d, 0.f) * 0.17677669529663687f * wv[i]; }
        score += 0.f;
        const bool pass = valid && (score > thr);
        const unsigned long long pm = __ballot(pass);
        if (pass) { v2u x; x.x = f2ord(score); x.y = (unsigned)s; buf[cnt + popc64(pm & lt)] = x; }
        cnt += popc64(pm);
        if (cnt > 512 - 64) { LDS_WAIT(); asm volatile("" ::: "memory"); thr = ord2f(dsa_compact(buf, cnt, lane)); cnt = 256; LDS_WAIT(); asm volatile("" ::: "memory"); }
    }
    LDS_WAIT(); asm volatile("" ::: "memory");
    if (cnt > 256) { dsa_compact(buf, cnt, lane); cnt = 256; LDS_WAIT(); asm volatile("" ::: "memory"); }
    const int hh = lane >> 3, h = hh < 6 ? hh : 5, dp = lane & 7;
    float q8[8];
    { const v4u qw = *(const v4u*)(proj + (size_t)qg * PROJ_LD + PC_DQ + h * 64 + dp * 8);
      q8[0] = bflo(qw.x) * 0.125f; q8[1] = bfhi(qw.x) * 0.125f; q8[2] = bflo(qw.y) * 0.125f; q8[3] = bfhi(qw.y) * 0.125f; q8[4] = bflo(qw.z) * 0.125f; q8[5] = bfhi(qw.z) * 0.125f; q8[6] = bflo(qw.w) * 0.125f; q8[7] = bfhi(qw.w) * 0.125f; }
    const float* rb = A.in[I_RB];
    float m = -INFINITY, lsum = 0.f, o[8];
#pragma unroll
    for (int i = 0; i < 8; ++i) o[i] = 0.f;
    const bf16* kvbase = proj + (size_t)b * SEQ * PROJ_LD + PC_DK + h * 64 + dp * 8;
    for (int j = 0; j < cnt; ++j) {
        const int s = (int)buf[j].y;
        const bf16* kr = kvbase + (size_t)s * PROJ_LD;
        const v4u kw = *(const v4u*)kr, vw = *(const v4u*)(kr + 384);
        float dot = q8[0] * bflo(kw.x) + q8[1] * bfhi(kw.x) + q8[2] * bflo(kw.y) + q8[3] * bfhi(kw.y) + q8[4] * bflo(kw.z) + q8[5] * bfhi(kw.z) + q8[6] * bflo(kw.w) + q8[7] * bfhi(kw.w);
        dot += __shfl_xor(dot, 1); dot += __shfl_xor(dot, 2); dot += __shfl_xor(dot, 4);
        const float logit = dot + rb[t5_bucket(t - s) * 6 + h];
        const float mn = fmaxf(m, logit), sc = expf(m - mn), p = expf(logit - mn);
        lsum = lsum * sc + p; m = mn;
        o[0] = o[0] * sc + p * bflo(vw.x); o[1] = o[1] * sc + p * bfhi(vw.x); o[2] = o[2] * sc + p * bflo(vw.y); o[3] = o[3] * sc + p * bfhi(vw.y);
        o[4] = o[4] * sc + p * bflo(vw.z); o[5] = o[5] * sc + p * bfhi(vw.z); o[6] = o[6] * sc + p * bflo(vw.w); o[7] = o[7] * sc + p * bfhi(vw.w);
    }
    const float inv = 1.f / lsum;
    if (hh < 6) { v4u w; w.x = pk2(o[0] * inv, o[1] * inv); w.y = pk2(o[2] * inv, o[3] * inv); w.z = pk2(o[4] * inv, o[5] * inv); w.w = pk2(o[6] * inv, o[7] * inv);
        *(v4u*)((bf16*)(F.ws + WS_Y) + (size_t)qg * D + YC_DSA + h * 64 + dp * 8) = w; }
}

constexpr int PH_PER_LAYER = 9, N_PHASES = 1 + DEPTH * PH_PER_LAYER;
__global__ void __launch_bounds__(NTHR, 2) fwd(const Args A) {
    extern __shared__ __attribute__((aligned(16))) unsigned char lds[];
    Frame F;
    F.lds = lds; F.tid = threadIdx.x; F.lane = F.tid & 63; F.wave = __builtin_amdgcn_readfirstlane(F.tid >> 6); F.G = gridDim.x;
    F.out = A.out; F.ws = A.ws;
    LAS unsigned char* lds3 = (LAS unsigned char*)lds;
    for (int u = F.tid; u < (LDS_BYTES - LDSCTL_OFF) / 4; u += NTHR) ((LAS unsigned*)(lds3 + LDSCTL_OFF))[u] = 0u;
    __syncthreads();
    const int lo = A.ph_lo, hi = A.ph_hi;
    XcdBarrier bar; bar.bar = (unsigned*)(F.ws + WS_CTL) + CW_BAR; bar.x = 0; bar.st = nullptr;
    if (hi - lo > 1) bar = xcd_barrier_post((unsigned*)(F.ws + WS_CTL) + CW_BAR, (volatile LAS unsigned*)(lds3 + MISC_OFF) + 8);
#define IN(k) (lo <= (k) && (k) < hi)
#define LAUNDER() do { int tid_ = threadIdx.x; asm volatile("" : "+v"(tid_)); F.tid = tid_; F.lane = tid_ & 63; } while (0)
#define SEAM(k) do { if (IN(k) && IN((k) + 1)) xcd_barrier(bar); } while (0)
    const int gw = blockIdx.x * NWAVES + F.wave, NGW = F.G * NWAVES;
    bf16* XB = (bf16*)(F.ws + WS_XB); bf16* PROJ = (bf16*)(F.ws + WS_PROJ); float* AUX = (float*)(F.ws + WS_AUX); bf16* Y = (bf16*)(F.ws + WS_Y); bf16* H = (bf16*)(F.ws + WS_H);
    float* V1 = (float*)(F.ws + WS_V1); float* V2 = (float*)(F.ws + WS_V2);

    if (IN(0)) { LAUNDER(); p0_prologue(F, A); } SEAM(0);

    for (int l = 0; l < DEPTH; ++l) {
        const int pb = 1 + l * PH_PER_LAYER;
        if (IN(pb + 0)) { LAUNDER();
            pg8::Gemm g{XB, w_ptr(F, l, WO_IN), T, NIN, D}; pg8::StaticOrder S; S.init(T, NIN, F.G, (int)blockIdx.x);
            pg8::EpiInProj E{PROJ, AUX};
            pg8::gemm_phase<pg8::EpiInProj, pg8::StaticOrder, true, true>(lds3 + RING_OFF, g, S, E);
        } SEAM(pb + 0);
        if (IN(pb + 1)) { LAUNDER();
            for (int it = blockIdx.x; it < T / 8; it += F.G) dsa_query(F, A, l, (T / 8 - 1 - it) * 8 + F.wave);
            for (int it = blockIdx.x; it < 1024; it += F.G) lru_item(F, A, l, it, false);
            for (int it = blockIdx.x; it < 3072; it += F.G) gla_item(F, A, l, it, false);
        } SEAM(pb + 1);
        if (IN(pb + 2)) { LAUNDER();
            if (blockIdx.x < 96) gla_scan(F, blockIdx.x * NTHR + F.tid);
            for (int row = gw; row < 512; row += NGW) lru_scan_row(F, row);
        } SEAM(pb + 2);
        if (IN(pb + 3)) { LAUNDER();
            for (int it = blockIdx.x; it < 1024; it += F.G) lru_item(F, A, l, it, true);
            for (int it = blockIdx.x; it < 3072; it += F.G) gla_item(F, A, l, it, true);
            __syncthreads();
        } SEAM(pb + 3);
        if (IN(pb + 4)) { LAUNDER();
            pg8::Gemm g{Y, w_ptr(F, l, WO_OUT), T, D, D}; pg8::StaticOrder S; S.init(T, D, F.G, (int)blockIdx.x);
            pg8::EpiRes E{l == 0 ? A.in[I_X] : F.out, V1, DN_ALPHA};
            pg8::gemm_phase<pg8::EpiRes, pg8::StaticOrder, true, true>(lds3 + RING_OFF, g, S, E);
        } SEAM(pb + 4);
        if (IN(pb + 5)) { LAUNDER(); ln_phase(F, V1, A.in[I_LN1G] + l * D, A.in[I_LN1B] + l * D, F.out, XB); } SEAM(pb + 5);
        if (IN(pb + 6)) { LAUNDER();
            pg8::Gemm g{XB, w_ptr(F, l, WO_GU), T, NGU, D}; pg8::StaticOrder S; S.init(T, NGU, F.G, (int)blockIdx.x);
            pg8::EpiFfnUp E{H};
            pg8::gemm_phase<pg8::EpiFfnUp, pg8::StaticOrder, true, true>(lds3 + RING_OFF, g, S, E);
        } SEAM(pb + 6);
        if (IN(pb + 7)) { LAUNDER();
            pg8::Gemm g{H, w_ptr(F, l, WO_D), T, D, DFF}; pg8::StaticOrder S; S.init(T, D, F.G, (int)blockIdx.x);
            pg8::EpiRes E{F.out, V2, DN_ALPHA};
            pg8::gemm_phase<pg8::EpiRes, pg8::StaticOrder, true, true>(lds3 + RING_OFF, g, S, E);
        } SEAM(pb + 7);
        if (IN(pb + 8)) { LAUNDER(); ln_phase(F, V2, A.in[I_LN2G] + l * D, A.in[I_LN2B] + l * D, F.out, XB); } SEAM(pb + 8);
    }
#undef IN
#undef SEAM
}

extern "C" void kernel_launch(void* const* d_in, const int* in_sizes, int n_in, void* d_out, int out_size, void* d_ws, size_t ws_size, hipStream_t stream) {
    static int grid = 0;
    if (grid == 0) {
        if (n_in != N_INPUTS || in_sizes[0] != T * D || out_size != T * D || ws_size < WS_END) { fprintf(stderr, "kernel_launch: unexpected shapes (n_in %d, in0 %d, out %d, ws %zu, need %zu)\n", n_in, n_in > 0 ? in_sizes[0] : -1, out_size, ws_size, (size_t)WS_END); grid = -1; return; }
        int dev = 0, cus = 0, per_cu = 0;
        if (hipGetDevice(&dev) != hipSuccess || hipDeviceGetAttribute(&cus, hipDeviceAttributeMultiprocessorCount, dev) != hipSuccess) { grid = -1; return; }
        if (hipFuncSetAttribute((const void*)fwd, hipFuncAttributeMaxDynamicSharedMemorySize, LDS_BYTES) != hipSuccess) { fprintf(stderr, "kernel_launch: hipFuncSetAttribute failed\n"); grid = -1; return; }
        if (hipOccupancyMaxActiveBlocksPerMultiprocessor(&per_cu, (const void*)fwd, NTHR, LDS_BYTES) != hipSuccess || per_cu < 1) fprintf(stderr, "kernel_launch: occupancy query reports %d per CU\n", per_cu);
        (void)hipGetLastError();
        grid = cus;
        if (grid != 256) fprintf(stderr, "kernel_launch: %d CUs (expected 256)\n", grid);
    }
    if (grid < 0) return;
    (void)hipMemsetAsync((char*)d_ws + WS_CTL, 0, CTL_ZERO_BYTES, stream);
    Args a{};
    for (int i = 0; i < N_INPUTS; ++i) a.in[i] = (const float*)d_in[i];
    a.out = (float*)d_out; a.ws = (unsigned char*)d_ws;
#if MK_N_LAUNCHES == 1
    a.ph_lo = 0; a.ph_hi = N_PHASES;
    hipLaunchKernelGGL(fwd, dim3(grid), dim3(NTHR), LDS_BYTES, stream, a);
#else
    for (int ph = 0; ph < N_PHASES; ++ph) { a.ph_lo = ph; a.ph_hi = ph + 1; hipLaunchKernelGGL(fwd, dim3(grid), dim3(NTHR), LDS_BYTES, stream, a); }
#endif
}
```

```cpp
#define MK_N_LAUNCHES 1
#include <hip/hip_runtime.h>
#include <cstdio>
#include <cstdint>
#include <cmath>
namespace pg8 {
#define PG8_LAS __attribute__((address_space(3)))
typedef unsigned short bf16_t;
typedef short bf16x8 __attribute__((ext_vector_type(8)));
typedef float f32x4 __attribute__((ext_vector_type(4)));
typedef unsigned u32x4 __attribute__((ext_vector_type(4)));
constexpr int BM = 256, BK = 64, HALF = 128, HTB = HALF * BK * 2  , STAGE_BYTES = 8 * HTB, NXCD = 8, WGM = 8;

__host__ __device__ __forceinline__ int lds_byte(int r, int c) { const int st = (r >> 4) * 2 + (c >> 5), rr = r & 15, cc = c & 31, ob = rr * 64 + cc * 2; return st * 1024 + (ob ^ (((ob >> 9) & 1) << 5)); }
__host__ __device__ __forceinline__ void stage_rc(int b, int& R, int& C) { const int st = b / 1024, sb = b % 1024, swz = sb ^ (((sb >> 9) & 1) << 5); R = (st >> 1) * 16 + swz / 64; C = (st & 1) * 32 + (swz % 64) / 2; }
__host__ __device__ __forceinline__ int perm32(int rho) { const int n = rho >> 4, i = rho & 15; return 8 * (i >> 2) + 4 * n + (i & 3); }

struct Unit { int pm, pn; };
struct Gemm { const bf16_t* A; const bf16_t* Bt; int M, N, K; };

struct StaticOrder {
    int nM, nN, nwg, G, c;
    __host__ __device__ void init(int M, int N, int G_, int c_) { nM = M / BM; nN = N / BM; nwg = nM * nN; G = G_; c = c_; }
    __host__ __device__ bool next(int i, Unit& u) const {
        const long L = (long)i * G + c; if (L >= nwg) return false;
        int wgid = (int)L; { const int q = nwg / NXCD, r = nwg % NXCD, xcd = wgid % NXCD, off = wgid / NXCD; wgid = (xcd < r ? xcd * (q + 1) : r * (q + 1) + (xcd - r) * q) + off; }
        const int nig = WGM * nN, gid = wgid / nig, fm = gid * WGM, gsz = (nM - fm) < WGM ? (nM - fm) : WGM;
        u.pm = fm + ((wgid % nig) % gsz); u.pn = (wgid % nig) / gsz; return true;
    }
    __device__ __forceinline__ void a_ready(const Unit&) const {}
    __device__ __forceinline__ void done(const Unit&) const {}
};

__device__ __forceinline__ unsigned cvt_pk_bf16(float lo, float hi) { unsigned r; asm volatile("v_cvt_pk_bf16_f32 %0, %1, %2" : "=v"(r) : "v"(lo), "v"(hi)); return r; }
typedef float f32x2 __attribute__((ext_vector_type(2)));
constexpr int PROJ_LD = 3328, AUX_LD = 256, DFF = 2816, DM = 1024;
struct EpiInProj {
    static constexpr bool PERM = true, AFTER_DRAIN = false;
    bf16_t* proj; float* aux;
    __device__ __forceinline__ void operator()(const f32x4 (&acc)[2][2][4][2], const Unit& u, int wr, int wc, int fr, int fq) const {
        const int row0 = u.pm * BM + wr * 64 + fr;
        if (u.pn < 13) {
            const int col0 = u.pn * BM + wc * 32 + 8 * fq;
#pragma unroll
            for (int ai = 0; ai < 2; ++ai)
#pragma unroll
                for (int m = 0; m < 4; ++m) { bf16_t* rowp = proj + (size_t)(row0 + ai * HALF + m * 16) * PROJ_LD + col0;
#pragma unroll
                    for (int bj = 0; bj < 2; ++bj) { const f32x4 v0 = acc[ai][bj][m][0], v1 = acc[ai][bj][m][1];
                        u32x4 w; w.x = cvt_pk_bf16(v0[0], v0[1]); w.y = cvt_pk_bf16(v0[2], v0[3]); w.z = cvt_pk_bf16(v1[0], v1[1]); w.w = cvt_pk_bf16(v1[2], v1[3]);
                        *(u32x4*)(rowp + bj * HALF) = w; } }
        } else {
            const int col0 = wc * 32 + 8 * fq;
#pragma unroll
            for (int ai = 0; ai < 2; ++ai)
#pragma unroll
                for (int m = 0; m < 4; ++m) { float* rowp = aux + (size_t)(row0 + ai * HALF + m * 16) * AUX_LD + col0;
#pragma unroll
                    for (int bj = 0; bj < 2; ++bj) { *(f32x4*)(rowp + bj * HALF) = acc[ai][bj][m][0]; *(f32x4*)(rowp + bj * HALF + 4) = acc[ai][bj][m][1]; } }
        }
    }
};
struct EpiFfnUp {
    static constexpr bool PERM = true, AFTER_DRAIN = false;
    bf16_t* H;
    __device__ __forceinline__ void operator()(const f32x4 (&acc)[2][2][4][2], const Unit& u, int wr, int wc, int fr, int fq) const {
        const int row0 = u.pm * BM + wr * 64 + fr, col0 = u.pn * HALF + wc * 32 + 8 * fq;
#pragma unroll
        for (int ai = 0; ai < 2; ++ai)
#pragma unroll
            for (int m = 0; m < 4; ++m) { bf16_t* rowp = H + (size_t)(row0 + ai * HALF + m * 16) * DFF + col0;
                float o[8];
#pragma unroll
                for (int n = 0; n < 2; ++n)
#pragma unroll
                    for (int j = 0; j < 4; ++j) { const float g = acc[ai][0][m][n][j], up = acc[ai][1][m][n][j];
                        const float sg = g * __builtin_amdgcn_rcpf(1.0f + __builtin_amdgcn_exp2f(-1.44269504089f * g)); o[n * 4 + j] = sg * up; }
                u32x4 w; w.x = cvt_pk_bf16(o[0], o[1]); w.y = cvt_pk_bf16(o[2], o[3]); w.z = cvt_pk_bf16(o[4], o[5]); w.w = cvt_pk_bf16(o[6], o[7]);
                *(u32x4*)rowp = w; }
    }
};
struct EpiRes {
    static constexpr bool PERM = false, AFTER_DRAIN = false;
    const float* base; float* out; float alpha;
    __device__ __forceinline__ void operator()(const f32x4 (&acc)[2][2][4][2], const Unit& u, int wr, int wc, int fr, int fq) const {
        const int row0 = u.pm * BM + wr * 64 + fr, col0 = u.pn * BM + wc * 32 + 4 * fq;
#pragma unroll
        for (int ai = 0; ai < 2; ++ai)
#pragma unroll
            for (int m = 0; m < 4; ++m) { const size_t off = (size_t)(row0 + ai * HALF + m * 16) * DM + col0;
#pragma unroll
                for (int bj = 0; bj < 2; ++bj)
#pragma unroll
                    for (int n = 0; n < 2; ++n) { const f32x4 b = *(const f32x4*)(base + off + bj * HALF + n * 16);
                        *(f32x4*)(out + off + bj * HALF + n * 16) = b * alpha + acc[ai][bj][m][n]; } }
    }
};
template <class Epi, class Sched, bool ALIGN_EPI = false, bool SP2 = false>
__device__ __forceinline__ void gemm_phase(PG8_LAS unsigned char* lds, const Gemm g, const Sched& S, const Epi& E) {
    int tid_ = threadIdx.x; asm volatile("" : "+v"(tid_));
    const int tid = tid_, wid = __builtin_amdgcn_readfirstlane(tid >> 6), lane = tid & 63, wr = wid >> 2, wc = wid & 3, fr = lane & 15, fq = lane >> 4;
    const int K = g.K, nt = K / BK;
    unsigned voffA[2], voffB[2];
#pragma unroll
    for (int i = 0; i < 2; ++i) { int R, C; stage_rc(tid * 16 + i * 8192, R, C); const int Rb = Epi::PERM ? ((R & ~31) + perm32(R & 31)) : R;
        voffA[i] = (unsigned)(R * K + C) * 2u; voffB[i] = (unsigned)(Rb * K + C) * 2u; }
    const size_t kstep = (size_t)(BK * 2);
    const size_t hstep = (size_t)HALF * K * 2;
    const size_t tstep = 2 * hstep;
    const unsigned ldsw = (unsigned)wid * 1024u;
    const int aoff = lds_byte(wr * 64 + fr, fq * 8), boff = lds_byte(wc * 32 + fr, fq * 8);
#define PG8_SA(b, h) (((b) * 2 + (h)) * HTB)
#define PG8_SB(b, h) ((4 + (b) * 2 + (h)) * HTB)
#define PG8_STAGE(bufoff, gbase, voff) do { _Pragma("unroll") for (int _i = 0; _i < 2; ++_i) \
        __builtin_amdgcn_global_load_lds((const unsigned*)((const char*)(gbase) + (voff)[_i]), (PG8_LAS unsigned*)(lds + (bufoff) + ldsw + _i * 8192), 16, 0, 0); } while (0)
#define PG8_LDA(dst, b, h) do { _Pragma("unroll") for (int m = 0; m < 4; ++m) _Pragma("unroll") for (int k = 0; k < 2; ++k) dst[m][k] = *(const PG8_LAS bf16x8*)(lds + PG8_SA(b, h) + aoff + m * 2048 + k * 1024); } while (0)
#define PG8_LDB(dst, b, h) do { _Pragma("unroll") for (int n = 0; n < 2; ++n) _Pragma("unroll") for (int k = 0; k < 2; ++k) dst[n][k] = *(const PG8_LAS bf16x8*)(lds + PG8_SB(b, h) + boff + n * 2048 + k * 1024); } while (0)
#define PG8_MMA(ai, bj, At, Bt) do { __builtin_amdgcn_s_setprio(1); _Pragma("unroll") for (int m = 0; m < 4; ++m) _Pragma("unroll") for (int n = 0; n < 2; ++n) _Pragma("unroll") for (int k = 0; k < 2; ++k) \
        acc[ai][bj][m][n] = __builtin_amdgcn_mfma_f32_16x16x32_bf16(Bt[n][k], At[m][k], acc[ai][bj][m][n], 0, 0, 0); __builtin_amdgcn_s_setprio(0); } while (0)
#define PG8_WAIT_V(n) asm volatile("s_waitcnt vmcnt(" #n ")" ::: "memory")
#define PG8_WAIT_L(n) asm volatile("s_waitcnt lgkmcnt(" #n ")" ::: "memory")
#define PG8_BAR __builtin_amdgcn_s_barrier()
#define PG8_SCHED __builtin_amdgcn_sched_barrier(0)
    Unit cur, nxt; int ui = 0;
    if (!S.next(0, cur)) return;
    f32x4 acc[2][2][4][2];
#pragma unroll
    for (int a = 0; a < 2; ++a)
#pragma unroll
        for (int b = 0; b < 2; ++b)
#pragma unroll
            for (int m = 0; m < 4; ++m)
#pragma unroll
                for (int n = 0; n < 2; ++n) acc[a][b][m][n] = (f32x4){0.f, 0.f, 0.f, 0.f};
    bf16x8 At[4][2], B0[2][2], B1[2][2];
    const char* cA = (const char*)g.A + (size_t)cur.pm * tstep; const char* cB = (const char*)g.Bt + (size_t)cur.pn * tstep;
    S.a_ready(cur);
    if constexpr (SP2) {
        PG8_STAGE(PG8_SB(0, 0), cB, voffB); PG8_STAGE(PG8_SB(0, 1), cB + hstep, voffB); PG8_STAGE(PG8_SA(0, 0), cA, voffA); PG8_STAGE(PG8_SA(0, 1), cA + hstep, voffA);
        if (wr == 1) PG8_BAR;
        PG8_WAIT_V(2); PG8_BAR;
        PG8_STAGE(PG8_SB(1, 0), cB + kstep, voffB); PG8_STAGE(PG8_SA(1, 0), cA + kstep, voffA); PG8_STAGE(PG8_SB(1, 1), cB + hstep + kstep, voffB);
        PG8_WAIT_V(6); PG8_BAR;
    } else {
        PG8_STAGE(PG8_SB(0, 0), cB, voffB); PG8_STAGE(PG8_SA(0, 0), cA, voffA); PG8_STAGE(PG8_SB(0, 1), cB + hstep, voffB); PG8_STAGE(PG8_SA(0, 1), cA + hstep, voffA);
        if (wr == 1) PG8_BAR;
        PG8_WAIT_V(4); PG8_BAR;
        PG8_STAGE(PG8_SB(1, 0), cB + kstep, voffB); PG8_STAGE(PG8_SA(1, 0), cA + kstep, voffA); PG8_STAGE(PG8_SB(1, 1), cB + hstep + kstep, voffB);
        PG8_WAIT_V(6); PG8_BAR;
    }
    for (;;) {
        const bool has_next = S.next(ui + 1, nxt);
        const char* nA = has_next ? (const char*)g.A + (size_t)nxt.pm * tstep : cA; const char* nB = has_next ? (const char*)g.Bt + (size_t)nxt.pn * tstep : cB;
        for (int t = 0; t < nt; t += 2) {
            const bool last = (t == nt - 2);
            const char* a1 = cA + (size_t)(t + 1) * kstep;
            const char* a2 = last ? nA : cA + (size_t)(t + 2) * kstep; const char* b2 = last ? nB : cB + (size_t)(t + 2) * kstep;
            const char* a3 = a2 + kstep; const char* b3 = b2 + kstep;
            if (last && has_next) S.a_ready(nxt);
            if constexpr (SP2) {
            PG8_LDB(B0, 0, 0); PG8_LDB(B1, 0, 1); PG8_SCHED; PG8_LDA(At, 0, 0); PG8_STAGE(PG8_SA(1, 1), a1 + hstep, voffA);
            PG8_WAIT_V(8); PG8_WAIT_L(0); PG8_BAR; PG8_MMA(0, 0, At, B0); PG8_MMA(0, 1, At, B1); PG8_BAR; PG8_SCHED;
            PG8_LDA(At, 0, 1); PG8_STAGE(PG8_SB(0, 0), b2, voffB); PG8_STAGE(PG8_SB(0, 1), b2 + hstep, voffB); PG8_STAGE(PG8_SA(0, 0), a2, voffA);
            PG8_WAIT_V(8); PG8_WAIT_L(0); PG8_BAR; PG8_MMA(1, 0, At, B0); PG8_MMA(1, 1, At, B1); PG8_BAR; PG8_SCHED;
            PG8_LDB(B0, 1, 0); PG8_LDB(B1, 1, 1); PG8_SCHED; PG8_LDA(At, 1, 0); PG8_STAGE(PG8_SA(0, 1), a2 + hstep, voffA);
            PG8_WAIT_V(8); PG8_WAIT_L(0); PG8_BAR; PG8_MMA(0, 0, At, B0); PG8_MMA(0, 1, At, B1); PG8_BAR; PG8_SCHED;
            PG8_LDA(At, 1, 1); PG8_STAGE(PG8_SB(1, 0), b3, voffB); PG8_STAGE(PG8_SB(1, 1), b3 + hstep, voffB); PG8_STAGE(PG8_SA(1, 0), a3, voffA);
            PG8_WAIT_V(8); PG8_WAIT_L(0); PG8_BAR; PG8_MMA(1, 0, At, B0); PG8_MMA(1, 1, At, B1); PG8_BAR; PG8_SCHED;
            } else {
            PG8_LDB(B0, 0, 0); PG8_SCHED; PG8_LDA(At, 0, 0); PG8_STAGE(PG8_SA(1, 1), a1 + hstep, voffA);
            PG8_WAIT_L(8); PG8_BAR; PG8_WAIT_L(0); PG8_MMA(0, 0, At, B0); PG8_BAR; PG8_SCHED;
            PG8_LDB(B1, 0, 1); PG8_STAGE(PG8_SB(0, 0), b2, voffB);
            PG8_BAR; PG8_WAIT_L(0); PG8_MMA(0, 1, At, B1); PG8_BAR;
            PG8_LDA(At, 0, 1); PG8_STAGE(PG8_SA(0, 0), a2, voffA);
            PG8_BAR; PG8_WAIT_L(0); PG8_MMA(1, 0, At, B0); PG8_BAR; PG8_SCHED;
            PG8_STAGE(PG8_SB(0, 1), b2 + hstep, voffB);
            PG8_WAIT_V(6); PG8_BAR; PG8_MMA(1, 1, At, B1); PG8_BAR;
            PG8_LDB(B0, 1, 0); PG8_SCHED; PG8_LDA(At, 1, 0); PG8_STAGE(PG8_SA(0, 1), a2 + hstep, voffA);
            PG8_WAIT_L(8); PG8_BAR; PG8_WAIT_L(0); PG8_MMA(0, 0, At, B0); PG8_BAR; PG8_SCHED;
            PG8_LDB(B1, 1, 1); PG8_STAGE(PG8_SB(1, 0), b3, voffB);
            PG8_BAR; PG8_WAIT_L(0); PG8_MMA(0, 1, At, B1); PG8_BAR;
            PG8_LDA(At, 1, 1); PG8_STAGE(PG8_SA(1, 0), a3, voffA);
            PG8_BAR; PG8_WAIT_L(0); PG8_MMA(1, 0, At, B0); PG8_BAR; PG8_SCHED;
            PG8_STAGE(PG8_SB(1, 1), b3 + hstep, voffB);
            PG8_WAIT_V(6); PG8_BAR; PG8_MMA(1, 1, At, B1); PG8_BAR;
            }
        }
        if constexpr (ALIGN_EPI) { if (wr == 0) PG8_BAR; }
        if constexpr (!Epi::AFTER_DRAIN) { E(acc, cur, wr, wc, fr, fq); S.done(cur); }
        if (!has_next) break;
#pragma unroll
        for (int a = 0; a < 2; ++a)
#pragma unroll
            for (int b = 0; b < 2; ++b)
#pragma unroll
                for (int m = 0; m < 4; ++m)
#pragma unroll
                    for (int n = 0; n < 2; ++n) acc[a][b][m][n] = (f32x4){0.f, 0.f, 0.f, 0.f};
        cur = nxt; cA = nA; cB = nB; ++ui;
        if constexpr (ALIGN_EPI) { if (wr == 1) PG8_BAR; }
    }
    PG8_WAIT_V(0);
    if constexpr (!ALIGN_EPI) { if (wr == 0) PG8_BAR; }
    PG8_BAR;
    if constexpr (Epi::AFTER_DRAIN) { E.fused(acc, cur, wr, wc, fr, fq, lds, wid, lane); S.done(cur); }
#undef PG8_SA
#undef PG8_SB
#undef PG8_STAGE
#undef PG8_LDA
#undef PG8_LDB
#undef PG8_MMA
#undef PG8_WAIT_V
#undef PG8_WAIT_L
#undef PG8_BAR
#undef PG8_SCHED
}
}

#ifndef MK_N_LAUNCHES
#define MK_N_LAUNCHES 1
#endif
constexpr int NWAVES = 8, NTHR = 512;
constexpr int BATCH = 2, SEQ = 16384, T = BATCH * SEQ, D = 1024, DEPTH = 2, DFF = 2816;
constexpr int NIN = 3584, NGU = 5632, PROJ_LD = 3328, AUX_LD = 256;
constexpr float DN_ALPHA = 1.41421356237309515f, LN_EPS = 1e-5f;
constexpr int PC_LX = 0, PC_LG = 256, PC_GQ = 512, PC_GK = 896, PC_GV = 1280, PC_GG = 1664, PC_DQ = 2048, PC_DK = 2432, PC_DV = 2816;
constexpr int AC_GLR = 0, AC_IQ = 16, AC_IK = 144, AC_IW = 176;
constexpr int YC_LRU = 0, YC_GLA = 256, YC_DSA = 640;
enum { I_X = 0, I_WIN, I_CONVW, I_CONVB, I_WA, I_BA, I_WX, I_BX, I_LAM, I_WG2, I_BG, I_NG, I_RB, I_WOUT, I_LN1G, I_LN1B, I_WFG, I_WFU, I_WFD, I_LN2G, I_LN2B, N_INPUTS };

constexpr size_t MiB = 1u << 20;
constexpr size_t WS_CTL = 0, CTL_ZERO_BYTES = 1 * MiB;
constexpr size_t WS_W = 1 * MiB, W_LAYER = 26 * MiB, WO_IN = 0, WO_OUT = 7 * MiB, WO_GU = 9 * MiB, WO_D = 20 * MiB;
constexpr size_t WS_XB = 54 * MiB, WS_PROJ = 118 * MiB, WS_AUX = 326 * MiB, WS_R2 = 358 * MiB, WS_END = 486 * MiB;
constexpr size_t WS_V1 = WS_PROJ, WS_H = WS_PROJ, WS_Y = WS_R2, WS_GLAU = WS_R2 + 64 * MiB, WS_DEC = WS_R2 + 112 * MiB, WS_LSUM = WS_R2 + 113 * MiB, WS_CARRY = WS_R2 + 117 * MiB, WS_V2 = WS_R2;
static_assert(WO_IN + (size_t)NIN * D * 2 <= WO_OUT && WO_OUT + (size_t)D * D * 2 <= WO_GU && WO_GU + (size_t)NGU * D * 2 <= WO_D && WO_D + (size_t)D * DFF * 2 <= W_LAYER, "weight map");
static_assert(WS_W + 2 * W_LAYER <= WS_XB && WS_XB + (size_t)T * D * 2 <= WS_PROJ && WS_PROJ + (size_t)T * PROJ_LD * 2 <= WS_AUX && WS_AUX + (size_t)T * AUX_LD * 4 <= WS_R2, "ws map");
static_assert((size_t)T * DFF * 2 <= WS_AUX - WS_PROJ && (size_t)T * D * 4 <= WS_AUX - WS_PROJ && WS_CARRY + 2 * MiB <= WS_END && (size_t)T * D * 4 <= WS_END - WS_R2, "ws overlays");
constexpr int CW_BAR = 4096;

constexpr int RING_OFF = 0, RING_BYTES = 131072;
constexpr int LDSCTL_OFF = RING_BYTES, MISC_OFF = LDSCTL_OFF + 320;
constexpr int LDS_BYTES = 147456;

#define GAS __attribute__((address_space(1)))
#define LAS __attribute__((address_space(3)))
typedef unsigned short bf16;
typedef unsigned v4u __attribute__((ext_vector_type(4)));
typedef unsigned v2u __attribute__((ext_vector_type(2)));
typedef float f32x4 __attribute__((ext_vector_type(4)));
typedef GAS unsigned gu32;
#define RLX_AGENT __ATOMIC_RELAXED, __HIP_MEMORY_SCOPE_AGENT
#define LDS_WAIT() asm volatile("s_waitcnt lgkmcnt(0)" ::: "memory")
#define VM_WAIT() asm volatile("s_waitcnt vmcnt(0)" ::: "memory")
__device__ __forceinline__ unsigned f2bf(float f) { unsigned u = __builtin_bit_cast(unsigned, f); return (u + 0x7fffu + ((u >> 16) & 1u)) >> 16; }
__device__ __forceinline__ unsigned pk2(float lo, float hi) { return f2bf(lo) | (f2bf(hi) << 16); }
__device__ __forceinline__ float bf2f(unsigned short h) { return __builtin_bit_cast(float, (unsigned)h << 16); }
__device__ __forceinline__ float bflo(unsigned w) { return __builtin_bit_cast(float, w << 16); }
__device__ __forceinline__ float bfhi(unsigned w) { return __builtin_bit_cast(float, w & 0xffff0000u); }

#define XB_TMO      128
#define XB_XCNT(j)  (256  + 64 * (j))
#define XB_XSUB(j)  (1280 + 64 * (j))
#define XB_XGEN(j)  (2304 + 64 * (j))
#define XB_TOP      3328
#define XB_TOPGEN   3392
#define XCD_BAR_WORDS 3456
#define XB_SPIN_CAP (1u << 18)

__device__ __forceinline__ unsigned xb_ld(unsigned* p)              { return __hip_atomic_load(p, __ATOMIC_RELAXED, __HIP_MEMORY_SCOPE_AGENT); }
__device__ __forceinline__ unsigned xb_add(unsigned* p, unsigned v) { return __hip_atomic_fetch_add(p, v, __ATOMIC_RELAXED, __HIP_MEMORY_SCOPE_AGENT); }
__device__ __forceinline__ unsigned xb_xcc_id() { return (unsigned)__builtin_amdgcn_s_getreg((3 << 11) | 20) & 0xFu; }
#define XB_SPIN(cond, bar) do { unsigned _sp = 0; while (cond) { __builtin_amdgcn_s_sleep(1); \
    if ((++_sp & 255u) == 0u) { if (xb_ld(&(bar)[XB_TMO])) break; if (_sp > XB_SPIN_CAP) { atomicAdd(&(bar)[XB_TMO], 1u); break; } } } } while (0)

struct XcdBarrier {
    unsigned* bar; unsigned x;
    volatile LAS unsigned* st;
};

__device__ __forceinline__ XcdBarrier xcd_barrier_post(unsigned* bar, volatile LAS unsigned* st) {
    XcdBarrier b; b.bar = bar; b.x = xb_xcc_id(); b.st = st;
    if (threadIdx.x == 0) (void)xb_add(&bar[XB_XCNT(b.x)], 1u);
    return b;
}
__device__ __forceinline__ void xcd_barrier_complete(unsigned* bar, unsigned x, unsigned& nloc, unsigned& nx) {
    const unsigned G = gridDim.x * gridDim.y * gridDim.z;
    unsigned sum, cnt, mine, sp = 0u;
    for (;;) {
        sum = 0u; cnt = 0u; mine = 0u;
#pragma unroll
        for (unsigned j = 0; j < 16; ++j) { const unsigned c = xb_ld(&bar[XB_XCNT(j)]); sum += c; cnt += (c > 0u) ? 1u : 0u; mine = (j == x) ? c : mine; }
        if (sum == G) break;
        __builtin_amdgcn_s_sleep(1);
        if ((++sp & 255u) == 0u) { if (xb_ld(&bar[XB_TMO])) break; if (sp > XB_SPIN_CAP) { atomicAdd(&bar[XB_TMO], 1u); break; } }
    }
    nloc = mine > 0u ? mine : 1u; nx = cnt > 0u ? cnt : 1u;
}

__device__ __forceinline__ void xcd_barrier(const XcdBarrier& b) {
    asm volatile("s_waitcnt vmcnt(0)" ::: "memory");
    __syncthreads();
    if (threadIdx.x == 0) {
        unsigned* bar = b.bar;
        __builtin_amdgcn_s_waitcnt(0);
        unsigned nloc = b.st[0], nx = b.st[1];
        if (nloc == 0u) { xcd_barrier_complete(bar, b.x, nloc, nx); b.st[0] = nloc; b.st[1] = nx; }
        const unsigned old = xb_add(&bar[XB_XSUB(b.x)], 1u);
        const unsigned gen = old / nloc;
        if (old + 1u == (gen + 1u) * nloc) {
            __builtin_amdgcn_fence(__ATOMIC_RELEASE, "agent");
            asm volatile("s_waitcnt vmcnt(0)" ::: "memory");
            const unsigned og = xb_add(&bar[XB_TOP], 1u);
            const unsigned tg = og / nx;
            if (og + 1u == (tg + 1u) * nx) xb_add(&bar[XB_TOPGEN], 1u);
            else XB_SPIN(xb_ld(&bar[XB_TOPGEN]) == tg, bar);
            __builtin_amdgcn_fence(__ATOMIC_ACQUIRE, "agent");
            xb_add(&bar[XB_XGEN(b.x)], 1u);
            asm volatile("s_waitcnt vmcnt(0)" ::: "memory");
        } else {
            XB_SPIN(xb_ld(&bar[XB_XGEN(b.x)]) == gen, bar);
            __builtin_amdgcn_fence(__ATOMIC_ACQUIRE, "agent");
            asm volatile("s_waitcnt vmcnt(0)" ::: "memory");
        }
    }
    __syncthreads();
}


struct Args { const float* in[N_INPUTS]; float* out; unsigned char* ws; int ph_lo, ph_hi; };
struct Frame {
    unsigned char* lds;
    int tid, lane, wave, G;
    float* out; unsigned char* ws;
};
__device__ __forceinline__ bf16* w_ptr(const Frame& F, int l, size_t off) { return (bf16*)(F.ws + WS_W + (size_t)l * W_LAYER + off); }

__device__ __forceinline__ float wave_sum(float v) {
#pragma unroll
    for (int o = 1; o < 64; o <<= 1) v += __shfl_xor(v, o);
    return v;
}

__device__ __forceinline__ void transpose_item(const float* W, int K, int N, bf16* Wt, float* scr, int kb, int rb, int lane, int sc) {
    const int k0 = 64 * kb, r0 = 32 * rb, rl = lane & 31;
#pragma unroll 8
    for (int i = 0; i < 32; ++i) { const int kk = 2 * i + (lane >> 5); scr[kk * 33 + rl] = sc >= 0 ? W[(size_t)(k0 + kk) * N + sc] : 0.f; }
    LDS_WAIT(); asm volatile("" ::: "memory");
    const int c = lane & 7;
#pragma unroll
    for (int j = 0; j < 4; ++j) { const int n = (lane >> 3) + 8 * j; const float* s = scr + (8 * c) * 33 + n;
        v4u o; o.x = pk2(s[0 * 33], s[1 * 33]); o.y = pk2(s[2 * 33], s[3 * 33]); o.z = pk2(s[4 * 33], s[5 * 33]); o.w = pk2(s[6 * 33], s[7 * 33]);
        *(v4u*)(Wt + (size_t)(r0 + n) * K + k0 + 8 * c) = o; }
    LDS_WAIT(); asm volatile("" ::: "memory");
}
__device__ __forceinline__ int win_src(int r) {
    if (r < 2048) return r;
    if (r < 3200) return r + 16;
    if (r < 3328) return -1;
    if (r < 3344) return 2048 + (r - 3328);
    if (r < 3508) return 3216 + (r - 3344);
    return -1;
}
__device__ __forceinline__ void p0_prologue(Frame& F, const Args& A) {
    float* scr = (float*)(F.lds + RING_OFF + F.wave * 16384);
    const int gw = blockIdx.x * NWAVES + F.wave, NGW = F.G * NWAVES;
    constexpr int I_IN = 16 * (NIN / 32), I_OUT = 16 * (D / 32), I_GU = 16 * (NGU / 32), I_D = (DFF / 64) * (D / 32), I_L = I_IN + I_OUT + I_GU + I_D;
    for (int it = gw; it < DEPTH * I_L; it += NGW) {
        const int l = it / I_L; int r = it % I_L;
        if (r < I_IN) { const int kb = r / (NIN / 32), rb = r % (NIN / 32); transpose_item(A.in[I_WIN] + (size_t)l * D * 3380, D, 3380, w_ptr(F, l, WO_IN), scr, kb, rb, F.lane, win_src(rb * 32 + (F.lane & 31))); continue; } r -= I_IN;
        if (r < I_OUT) { const int kb = r / (D / 32), rb = r % (D / 32); transpose_item(A.in[I_WOUT] + (size_t)l * D * D, D, D, w_ptr(F, l, WO_OUT), scr, kb, rb, F.lane, rb * 32 + (F.lane & 31)); continue; } r -= I_OUT;
        if (r < I_GU) { const int kb = r / (NGU / 32), rb = r % (NGU / 32); const int row = rb * 32 + (F.lane & 31), tile = row >> 8, w = row & 255; const bool up = w >= 128;
            transpose_item(A.in[up ? I_WFU : I_WFG] + (size_t)l * D * DFF, D, DFF, w_ptr(F, l, WO_GU), scr, kb, rb, F.lane, tile * 128 + (w & 127)); continue; } r -= I_GU;
        { const int kb = r / (D / 32), rb = r % (D / 32); transpose_item(A.in[I_WFD] + (size_t)l * DFF * D, DFF, D, w_ptr(F, l, WO_D), scr, kb, rb, F.lane, rb * 32 + (F.lane & 31)); }
    }
    const float* x = A.in[I_X]; bf16* xb = (bf16*)(F.ws + WS_XB);
    for (int m = gw; m < T; m += NGW) {
        const f32x4* xr = (const f32x4*)(x + (size_t)m * D) + F.lane; unsigned long long* o8 = (unsigned long long*)(xb + (size_t)m * D) + F.lane;
#pragma unroll
        for (int j = 0; j < 4; ++j) { const f32x4 v = xr[64 * j]; o8[64 * j] = (unsigned long long)pk2(v.x, v.y) | ((unsigned long long)pk2(v.z, v.w) << 32); }
    }
}

__device__ __forceinline__ void ln_phase(Frame& F, const float* V, const float* g, const float* b, float* xf, bf16* xb) {
    const int gw = blockIdx.x * NWAVES + F.wave, NGW = F.G * NWAVES;
    f32x4 gv[4], bv[4];
#pragma unroll
    for (int j = 0; j < 4; ++j) { gv[j] = ((const f32x4*)g)[F.lane + 64 * j]; bv[j] = ((const f32x4*)b)[F.lane + 64 * j]; }
    for (int m = gw; m < T; m += NGW) {
        const f32x4* xr = (const f32x4*)(V + (size_t)m * D) + F.lane;
        f32x4 v[4]; float s = 0.f;
#pragma unroll
        for (int j = 0; j < 4; ++j) { v[j] = xr[64 * j]; s += (v[j].x + v[j].y) + (v[j].z + v[j].w); }
        const float mean = wave_sum(s) * (1.f / D); float s2 = 0.f;
#pragma unroll
        for (int j = 0; j < 4; ++j) { v[j] = v[j] - mean; s2 += (v[j].x * v[j].x + v[j].y * v[j].y) + (v[j].z * v[j].z + v[j].w * v[j].w); }
        const float rstd = 1.f / sqrtf(wave_sum(s2) * (1.f / D) + LN_EPS);
        f32x4* of = (f32x4*)(xf + (size_t)m * D) + F.lane; unsigned long long* o8 = (unsigned long long*)(xb + (size_t)m * D) + F.lane;
#pragma unroll
        for (int j = 0; j < 4; ++j) { const f32x4 o = v[j] * rstd * gv[j] + bv[j]; of[64 * j] = o; o8[64 * j] = (unsigned long long)pk2(o.x, o.y) | ((unsigned long long)pk2(o.z, o.w) << 32); }
    }
}

__device__ __forceinline__ float sigmoidf_(float x) { return 1.f / (1.f + expf(-x)); }
__device__ __forceinline__ float gelu_tanh(float x) { const float u = 0.7978845608028654f * (x + 0.044715f * x * x * x); return 0.5f * x * (1.f + tanhf(u)); }
__device__ __forceinline__ void lru_item(Frame& F, const Args& A, int l, int it, bool fin) {
    float* XC = (float*)(F.lds + RING_OFF);
    const bf16* proj = (const bf16*)(F.ws + WS_PROJ);
    const int b = it >> 9, t0 = (it & 511) * 32, c = F.tid & 255, half = F.tid >> 8, ts = t0 + half * 16, ck = ts >> 4;
    const float* cw = A.in[I_CONVW] + (size_t)l * 4 * 256; const float cb = A.in[I_CONVB][l * 256 + c];
    const float w0 = cw[c], w1 = cw[256 + c], w2 = cw[512 + c], w3 = cw[768 + c];
    __syncthreads();
    {
        float xm3 = 0.f, xm2 = 0.f, xm1 = 0.f;
        if (ts >= 3) { xm3 = bf2f(proj[(size_t)(b * SEQ + ts - 3) * PROJ_LD + PC_LX + c]); xm2 = bf2f(proj[(size_t)(b * SEQ + ts - 2) * PROJ_LD + PC_LX + c]); xm1 = bf2f(proj[(size_t)(b * SEQ + ts - 1) * PROJ_LD + PC_LX + c]); }
#pragma unroll 4
        for (int i = 0; i < 16; ++i) { const float x0 = bf2f(proj[(size_t)(b * SEQ + ts + i) * PROJ_LD + PC_LX + c]);
            XC[(half * 16 + i) * 256 + c] = cb + w0 * xm3 + w1 * xm2 + w2 * xm1 + w3 * x0; xm3 = xm2; xm2 = xm1; xm1 = x0; }
    }
    __syncthreads();
    const int n = c >> 6, j = c & 63;
    const float* wa = A.in[I_WA] + (size_t)l * 4 * 64 * 64 + (size_t)n * 64 * 64 + j; const float* wx = A.in[I_WX] + (size_t)l * 4 * 64 * 64 + (size_t)n * 64 * 64 + j;
    const float ba = A.in[I_BA][l * 256 + c], bx = A.in[I_BX][l * 256 + c], lam = A.in[I_LAM][l * 256 + c];
    const float sp8 = -8.f * log1pf(expf(-lam));
    float h = 0.f, P = 1.f;
    if (fin) h = ((const float*)(F.ws + WS_CARRY))[(size_t)(b * 256 + c) * 1024 + ck];
    float rp[16], ip[16];
#pragma unroll
    for (int i = 0; i < 16; ++i) { rp[i] = ba; ip[i] = bx; }
    for (int k = 0; k < 64; ++k) { const float a_ = wa[k * 64], x_ = wx[k * 64];
#pragma unroll
        for (int i = 0; i < 16; ++i) { const float xv = XC[(half * 16 + i) * 256 + n * 64 + k]; rp[i] += xv * a_; ip[i] += xv * x_; } }
    bf16* Y = (bf16*)(F.ws + WS_Y);
#pragma unroll
    for (int i = 0; i < 16; ++i) {
        const float xc = XC[(half * 16 + i) * 256 + c];
        const float r = sigmoidf_(rp[i]), ig = sigmoidf_(ip[i]);
        const float la = sp8 * r, a = expf(la), u = sqrtf(-expm1f(2.f * la)) * (ig * xc);
        h = a * h + u; P *= a;
        if (fin) { const size_t tok = (size_t)(b * SEQ + ts + i); const float g = bf2f(proj[tok * PROJ_LD + PC_LG + c]); Y[tok * D + YC_LRU + c] = (bf16)f2bf(h * gelu_tanh(g)); }
    }
    if (!fin) { float2* S = (float2*)(F.ws + WS_LSUM); S[(size_t)(b * 256 + c) * 1024 + ck] = make_float2(P, h); }
}
__device__ __forceinline__ void lru_scan_row(Frame& F, int row) {
    const float2* S = (const float2*)(F.ws + WS_LSUM) + (size_t)row * 1024 + F.lane * 16; float* C = (float*)(F.ws + WS_CARRY) + (size_t)row * 1024 + F.lane * 16;
    float2 e[16];
#pragma unroll
    for (int i = 0; i < 16; ++i) e[i] = S[i];
    float P = 1.f, h = 0.f;
#pragma unroll
    for (int i = 0; i < 16; ++i) { h = e[i].x * h + e[i].y; P *= e[i].x; }
#pragma unroll
    for (int o = 1; o < 64; o <<= 1) { const float Pp = __shfl_up(P, o), hp = __shfl_up(h, o); if (F.lane >= o) { h = P * hp + h; P = Pp * P; } }
    float hc = __shfl_up(h, 1); if (F.lane == 0) hc = 0.f;
#pragma unroll
    for (int i = 0; i < 16; ++i) { C[i] = hc; hc = e[i].x * hc + e[i].y; }
}

__device__ __forceinline__ void gla_item(Frame& F, const Args& A, int l, int it, bool fin) {
    constexpr int LP = 65;
    float* bc = (float*)(F.lds + RING_OFF); float* qd = bc + 64 * LP; float* ki = qd + 64 * LP; float* ke = ki + 64 * LP; float* vv = ke + 64 * LP; float* att = vv + 64 * LP;
    float* glr = att + 64 * LP; float* w2 = glr + 1024; float* bg = w2 + 1024;
    const int b = it / 1536, r_ = it % 1536, n = r_ / 6, h = r_ % 6; const size_t tok0 = (size_t)b * SEQ + (size_t)n * 64;
    const bf16* proj = (const bf16*)(F.ws + WS_PROJ); const float* aux = (const float*)(F.ws + WS_AUX);
    float* U = (float*)(F.ws + WS_GLAU) + (size_t)it * 4096; float* DEC = (float*)(F.ws + WS_DEC) + (size_t)it * 64;
    const int tid = F.tid;
    __syncthreads();
    for (int i = tid; i < 1024; i += NTHR) { const int c = i >> 4, r = i & 15; glr[i] = aux[(tok0 + c) * AUX_LD + AC_GLR + r]; }
    for (int i = tid; i < 1024; i += NTHR) { const int r = i >> 6, d = i & 63; w2[i] = A.in[I_WG2][(size_t)l * 16 * 384 + r * 384 + h * 64 + d]; }
    if (tid < 64) bg[tid] = A.in[I_BG][l * 384 + h * 64 + tid];
    __syncthreads();
    for (int e = tid; e < 4096; e += NTHR) { const int c = e >> 6, d = e & 63; float z = bg[d];
#pragma unroll
        for (int r = 0; r < 16; ++r) z += glr[c * 16 + r] * w2[r * 64 + d];
        bc[c * LP + d] = (fminf(z, 0.f) - log1pf(expf(-fabsf(z)))) * (1.f / 16.f); }
    __syncthreads();
    if (tid < 64) { float s = 0.f; for (int c = 0; c < 64; ++c) { s += bc[c * LP + tid]; bc[c * LP + tid] = s; } }
    __syncthreads();
    for (int e = tid; e < 4096; e += NTHR) { const int c = e >> 6, d = e & 63; const float b_ = bc[c * LP + d], bl = bc[63 * LP + d];
        const bf16* row = proj + (tok0 + c) * PROJ_LD + h * 64 + d;
        const float q = bf2f(row[PC_GQ]), k = bf2f(row[PC_GK]), v = bf2f(row[PC_GV]);
        qd[c * LP + d] = q * 0.125f * expf(b_); ki[c * LP + d] = k * expf(-b_); ke[c * LP + d] = k * expf(bl - b_); vv[c * LP + d] = v; }
    __syncthreads();
    if (!fin) {
        const int d = tid >> 3, dv0 = (tid & 7) * 8; float acc[8];
#pragma unroll
        for (int j = 0; j < 8; ++j) acc[j] = 0.f;
        for (int c = 0; c < 64; ++c) { const float kd = ke[c * LP + d];
#pragma unroll
            for (int j = 0; j < 8; ++j) acc[j] += kd * vv[c * LP + dv0 + j]; }
#pragma unroll
        for (int j = 0; j < 8; ++j) U[d * 64 + dv0 + j] = acc[j];
        if (tid < 64) DEC[tid] = expf(bc[63 * LP + tid]);
    } else {
        const int c = tid >> 3, s0 = (tid & 7) * 8, dv0 = s0; float a[8];
#pragma unroll
        for (int j = 0; j < 8; ++j) a[j] = 0.f;
        for (int d = 0; d < 64; ++d) { const float qv = qd[c * LP + d];
#pragma unroll
            for (int j = 0; j < 8; ++j) a[j] += qv * ki[(s0 + j) * LP + d]; }
#pragma unroll
        for (int j = 0; j < 8; ++j) att[c * LP + s0 + j] = (s0 + j <= c) ? a[j] : 0.f;
        for (int e = tid; e < 4096; e += NTHR) ke[(e >> 6) * LP + (e & 63)] = U[e];
        __syncthreads();
        float o[8];
#pragma unroll
        for (int j = 0; j < 8; ++j) o[j] = 0.f;
        for (int s = 0; s < 64; ++s) { const float av = att[c * LP + s];
#pragma unroll
            for (int j = 0; j < 8; ++j) o[j] += av * vv[s * LP + dv0 + j]; }
        for (int d = 0; d < 64; ++d) { const float qv = qd[c * LP + d];
#pragma unroll
            for (int j = 0; j < 8; ++j) o[j] += qv * ke[d * LP + dv0 + j]; }
        float ss = 0.f;
#pragma unroll
        for (int j = 0; j < 8; ++j) ss += o[j] * o[j];
        ss += __shfl_xor(ss, 1); ss += __shfl_xor(ss, 2); ss += __shfl_xor(ss, 4);
        const float rs = 1.f / sqrtf(ss * (1.f / 64.f) + 1e-6f);
        const bf16* grow = proj + (tok0 + c) * PROJ_LD + PC_GG + h * 64 + dv0; const float* ng = A.in[I_NG] + l * 384 + h * 64 + dv0;
        float y[8];
#pragma unroll
        for (int j = 0; j < 8; ++j) { const float g = bf2f(grow[j]); y[j] = o[j] * rs * ng[j] * (g / (1.f + expf(-g))); }
        v4u w; w.x = pk2(y[0], y[1]); w.y = pk2(y[2], y[3]); w.z = pk2(y[4], y[5]); w.w = pk2(y[6], y[7]);
        *(v4u*)((bf16*)(F.ws + WS_Y) + (tok0 + c) * D + YC_GLA + h * 64 + dv0) = w;
    }
}
__device__ __forceinline__ void gla_scan(Frame& F, int e) {
    const int bh = e >> 12, idx = e & 4095, d = idx >> 6, b = bh / 6, h = bh % 6;
    float* U = (float*)(F.ws + WS_GLAU); const float* DEC = (const float*)(F.ws + WS_DEC);
    float S = 0.f;
    for (int n0 = 0; n0 < 256; n0 += 8) {
        float u[8], dc[8];
#pragma unroll
        for (int i = 0; i < 8; ++i) { const size_t it = (size_t)b * 1536 + (size_t)(n0 + i) * 6 + h; u[i] = U[it * 4096 + idx]; dc[i] = DEC[it * 64 + d]; }
#pragma unroll
        for (int i = 0; i < 8; ++i) { const size_t it = (size_t)b * 1536 + (size_t)(n0 + i) * 6 + h; U[it * 4096 + idx] = S; S = dc[i] * S + u[i]; }
    }
}

__device__ __forceinline__ unsigned f2ord(float f) { const unsigned u = __builtin_bit_cast(unsigned, f); return u ^ ((u >> 31) ? 0xffffffffu : 0x80000000u); }
__device__ __forceinline__ float ord2f(unsigned v) { const unsigned u = (v & 0x80000000u) ? (v ^ 0x80000000u) : ~v; return __builtin_bit_cast(float, u); }
__device__ __forceinline__ int popc64(unsigned long long m) { return __builtin_popcountll(m); }
__device__ __forceinline__ int t5_bucket(int n) { if (n < 16) return n; const int v = 16 + (int)(__log2f((float)n * (1.f / 16.f)) * (16.f / 3.f)); return v < 31 ? v : 31; }
__device__ __forceinline__ unsigned dsa_compact(v2u* buf, int n, int lane) {
    unsigned o[8], id[8];
#pragma unroll
    for (int j = 0; j < 8; ++j) { const int e = j * 64 + lane; if (e < n) { const v2u x = buf[e]; o[j] = x.x; id[j] = x.y; } else { o[j] = 0u; id[j] = 0u; } }
    unsigned v = 0u;
    for (int bit = 31; bit >= 0; --bit) { const unsigned cand = v | (1u << bit); int c = 0;
#pragma unroll
        for (int j = 0; j < 8; ++j) c += popc64(__ballot(o[j] >= cand));
        if (c >= 256) v = cand; }
    int ngt = 0;
#pragma unroll
    for (int j = 0; j < 8; ++j) ngt += popc64(__ballot(o[j] > v));
    const int need = 256 - ngt; int outp = 0, tie_seen = 0;
    const unsigned long long lt = (1ull << lane) - 1ull;
#pragma unroll
    for (int j = 0; j < 8; ++j) {
        const bool isgt = o[j] > v, iseq = o[j] == v;
        const unsigned long long eqm = __ballot(iseq);
        const bool keep = isgt || (iseq && (tie_seen + popc64(eqm & lt)) < need);
        const unsigned long long km = __ballot(keep);
        if (keep) { v2u x; x.x = o[j]; x.y = id[j]; buf[outp + popc64(km & lt)] = x; }
        outp += popc64(km); tie_seen += popc64(eqm);
    }
    return v;
}
__device__ __forceinline__ void dsa_query(Frame& F, const Args& A, int l, int qg) {
    const int lane = F.lane, b = qg >> 14, t = qg & (SEQ - 1);
    float* qs = (float*)(F.lds + RING_OFF + F.wave * 5120); v2u* buf = (v2u*)(F.lds + RING_OFF + F.wave * 5120 + 512 + 512);
    const float* aux = (const float*)(F.ws + WS_AUX); const bf16* proj = (const bf16*)(F.ws + WS_PROJ);
    const float* arow = aux + (size_t)qg * AUX_LD;
    qs[lane] = arow[AC_IQ + lane]; qs[64 + lane] = arow[AC_IQ + 64 + lane];
    float wv[4];
#pragma unroll
    for (int i = 0; i < 4; ++i) wv[i] = arow[AC_IW + i] * 0.5f;
    LDS_WAIT(); asm volatile("" ::: "memory");
    int cnt = 0; float thr = -INFINITY;
    const int ntile = (t >> 6) + 1;
    const unsigned long long lt = (1ull << lane) - 1ull;
    for (int tile = 0; tile < ntile; ++tile) {
        const int s = tile * 64 + lane; const bool valid = s <= t; const int sc = valid ? s : t;
        const f32x4* kp = (const f32x4*)(aux + ((size_t)b * SEQ + sc) * AUX_LD + AC_IK);
        f32x4 k[8];
#pragma unroll
        for (int j = 0; j < 8; ++j) k[j] = kp[j];
        float score = 0.f;
#pragma unroll
        for (int i = 0; i < 4; ++i) { float d = 0.f;
#pragma unroll
            for (int j = 0; j < 8; ++j) { const f32x4 q4 = *(const f32x4*)(qs + i * 32 + j * 4); d += q4.x * k[j].x; d += q4.y * k[j].y; d += q4.z * k[j].z; d += q4.w * k[j].w; }
            score += fmaxf(d, 0.f) * 0.17677669529663687f * wv[i]; }
        score += 0.f;
        const bool pass = valid && (score > thr);
        const unsigned long long pm = __ballot(pass);
        if (pass) { v2u x; x.x = f2ord(score); x.y = (unsigned)s; buf[cnt + popc64(pm & lt)] = x; }
        cnt += popc64(pm);
        if (cnt > 512 - 64) { LDS_WAIT(); asm volatile("" ::: "memory"); thr = ord2f(dsa_compact(buf, cnt, lane)); cnt = 256; LDS_WAIT(); asm volatile("" ::: "memory"); }
    }
    LDS_WAIT(); asm volatile("" ::: "memory");
    if (cnt > 256) { dsa_compact(buf, cnt, lane); cnt = 256; LDS_WAIT(); asm volatile("" ::: "memory"); }
    const int hh = lane >> 3, h = hh < 6 ? hh : 5, dp = lane & 7;
    float q8[8];
    { const v4u qw = *(const v4u*)(proj + (size_t)qg * PROJ_LD + PC_DQ + h * 64 + dp * 8);
      q8[0] = bflo(qw.x) * 0.125f; q8[1] = bfhi(qw.x) * 0.125f; q8[2] = bflo(qw.y) * 0.125f; q8[3] = bfhi(qw.y) * 0.125f; q8[4] = bflo(qw.z) * 0.125f; q8[5] = bfhi(qw.z) * 0.125f; q8[6] = bflo(qw.w) * 0.125f; q8[7] = bfhi(qw.w) * 0.125f; }
    const float* rb = A.in[I_RB];
    float m = -INFINITY, lsum = 0.f, o[8];
#pragma unroll
    for (int i = 0; i < 8; ++i) o[i] = 0.f;
    const bf16* kvbase = proj + (size_t)b * SEQ * PROJ_LD + PC_DK + h * 64 + dp * 8;
    for (int j = 0; j < cnt; ++j) {
        const int s = (int)buf[j].y;
        const bf16* kr = kvbase + (size_t)s * PROJ_LD;
        const v4u kw = *(const v4u*)kr, vw = *(const v4u*)(kr + 384);
        float dot = q8[0] * bflo(kw.x) + q8[1] * bfhi(kw.x) + q8[2] * bflo(kw.y) + q8[3] * bfhi(kw.y) + q8[4] * bflo(kw.z) + q8[5] * bfhi(kw.z) + q8[6] * bflo(kw.w) + q8[7] * bfhi(kw.w);
        dot += __shfl_xor(dot, 1); dot += __shfl_xor(dot, 2); dot += __shfl_xor(dot, 4);
        const float logit = dot + rb[t5_bucket(t - s) * 6 + h];
        const float mn = fmaxf(m, logit), sc = expf(m - mn), p = expf(logit - mn);
        lsum = lsum * sc + p; m = mn;
        o[0] = o[0] * sc + p * bflo(vw.x); o[1] = o[1] * sc + p * bfhi(vw.x); o[2] = o[2] * sc + p * bflo(vw.y); o[3] = o[3] * sc + p * bfhi(vw.y);
        o[4] = o[4] * sc + p * bflo(vw.z); o[5] = o[5] * sc + p * bfhi(vw.z); o[6] = o[6] * sc + p * bflo(vw.w); o[7] = o[7] * sc + p * bfhi(vw.w);
    }
    const float inv = 1.f / lsum;
    if (hh < 6) { v4u w; w.x = pk2(o[0] * inv, o[1] * inv); w.y = pk2(o[2] * inv, o[3] * inv); w.z = pk2(o[4] * inv, o[5] * inv); w.w = pk2(o[6] * inv, o[7] * inv);
        *(v4u*)((bf16*)(F.ws + WS_Y) + (size_t)qg * D + YC_DSA + h * 64 + dp * 8) = w; }
}

constexpr int PH_PER_LAYER = 9, N_PHASES = 1 + DEPTH * PH_PER_LAYER;
__global__ void __launch_bounds__(NTHR, 2) fwd(const Args A) {
    extern __shared__ __attribute__((aligned(16))) unsigned char lds[];
    Frame F;
    F.lds = lds; F.tid = threadIdx.x; F.lane = F.tid & 63; F.wave = __builtin_amdgcn_readfirstlane(F.tid >> 6); F.G = gridDim.x;
    F.out = A.out; F.ws = A.ws;
    LAS unsigned char* lds3 = (LAS unsigned char*)lds;
    for (int u = F.tid; u < (LDS_BYTES - LDSCTL_OFF) / 4; u += NTHR) ((LAS unsigned*)(lds3 + LDSCTL_OFF))[u] = 0u;
    __syncthreads();
    const int lo = A.ph_lo, hi = A.ph_hi;
    XcdBarrier bar; bar.bar = (unsigned*)(F.ws + WS_CTL) + CW_BAR; bar.x = 0; bar.st = nullptr;
    if (hi - lo > 1) bar = xcd_barrier_post((unsigned*)(F.ws + WS_CTL) + CW_BAR, (volatile LAS unsigned*)(lds3 + MISC_OFF) + 8);
#define IN(k) (lo <= (k) && (k) < hi)
#define LAUNDER() do { int tid_ = threadIdx.x; asm volatile("" : "+v"(tid_)); F.tid = tid_; F.lane = tid_ & 63; } while (0)
#define SEAM(k) do { if (IN(k) && IN((k) + 1)) xcd_barrier(bar); } while (0)
    const int gw = blockIdx.x * NWAVES + F.wave, NGW = F.G * NWAVES;
    bf16* XB = (bf16*)(F.ws + WS_XB); bf16* PROJ = (bf16*)(F.ws + WS_PROJ); float* AUX = (float*)(F.ws + WS_AUX); bf16* Y = (bf16*)(F.ws + WS_Y); bf16* H = (bf16*)(F.ws + WS_H);
    float* V1 = (float*)(F.ws + WS_V1); float* V2 = (float*)(F.ws + WS_V2);

    if (IN(0)) { LAUNDER(); p0_prologue(F, A); } SEAM(0);

    for (int l = 0; l < DEPTH; ++l) {
        const int pb = 1 + l * PH_PER_LAYER;
        if (IN(pb + 0)) { LAUNDER();
            pg8::Gemm g{XB, w_ptr(F, l, WO_IN), T, NIN, D}; pg8::StaticOrder S; S.init(T, NIN, F.G, (int)blockIdx.x);
            pg8::EpiInProj E{PROJ, AUX};
            pg8::gemm_phase<pg8::EpiInProj, pg8::StaticOrder, true, true>(lds3 + RING_OFF, g, S, E);
        } SEAM(pb + 0);
        if (IN(pb + 1)) { LAUNDER();
            for (int it = blockIdx.x; it < T / 8; it += F.G) dsa_query(F, A, l, (T / 8 - 1 - it) * 8 + F.wave);
            for (int it = blockIdx.x; it < 1024; it += F.G) lru_item(F, A, l, it, false);
            for (int it = blockIdx.x; it < 3072; it += F.G) gla_item(F, A, l, it, false);
        } SEAM(pb + 1);
        if (IN(pb + 2)) { LAUNDER();
            if (blockIdx.x < 96) gla_scan(F, blockIdx.x * NTHR + F.tid);
            for (int row = gw; row < 512; row += NGW) lru_scan_row(F, row);
        } SEAM(pb + 2);
        if (IN(pb + 3)) { LAUNDER();
            for (int it = blockIdx.x; it < 1024; it += F.G) lru_item(F, A, l, it, true);
            for (int it = blockIdx.x; it < 3072; it += F.G) gla_item(F, A, l, it, true);
            __syncthreads();
        } SEAM(pb + 3);
        if (IN(pb + 4)) { LAUNDER();
            pg8::Gemm g{Y, w_ptr(F, l, WO_OUT), T, D, D}; pg8::StaticOrder S; S.init(T, D, F.G, (int)blockIdx.x);
            pg8::EpiRes E{l == 0 ? A.in[I_X] : F.out, V1, DN_ALPHA};
            pg8::gemm_phase<pg8::EpiRes, pg8::StaticOrder, true, true>(lds3 + RING_OFF, g, S, E);
        } SEAM(pb + 4);
        if (IN(pb + 5)) { LAUNDER(); ln_phase(F, V1, A.in[I_LN1G] + l * D, A.in[I_LN1B] + l * D, F.out, XB); } SEAM(pb + 5);
        if (IN(pb + 6)) { LAUNDER();
            pg8::Gemm g{XB, w_ptr(F, l, WO_GU), T, NGU, D}; pg8::StaticOrder S; S.init(T, NGU, F.G, (int)blockIdx.x);
            pg8::EpiFfnUp E{H};
            pg8::gemm_phase<pg8::EpiFfnUp, pg8::StaticOrder, true, true>(lds3 + RING_OFF, g, S, E);
        } SEAM(pb + 6);
        if (IN(pb + 7)) { LAUNDER();
            pg8::Gemm g{H, w_ptr(F, l, WO_D), T, D, DFF}; pg8::StaticOrder S; S.init(T, D, F.G, (int)blockIdx.x);
            pg8::EpiRes E{F.out, V2, DN_ALPHA};
            pg8::gemm_phase<pg8::EpiRes, pg8::StaticOrder, true, true>(lds3 + RING_OFF, g, S, E);
        } SEAM(pb + 7);
        if (IN(pb + 8)) { LAUNDER(); ln_phase(F, V2, A.in[I_LN2G] + l * D, A.in[I_LN2B] + l * D, F.out, XB); } SEAM(pb + 8);
    }
#undef IN
#undef SEAM
}

extern "C" void kernel_launch(void* const* d_in, const int* in_sizes, int n_in, void* d_out, int out_size, void* d_ws, size_t ws_size, hipStream_t stream) {
    static int grid = 0;
    if (grid == 0) {
        if (n_in != N_INPUTS || in_sizes[0] != T * D || out_size != T * D || ws_size < WS_END) { fprintf(stderr, "kernel_launch: unexpected shapes (n_in %d, in0 %d, out %d, ws %zu, need %zu)\n", n_in, n_in > 0 ? in_sizes[0] : -1, out_size, ws_size, (size_t)WS_END); grid = -1; return; }
        int dev = 0, cus = 0, per_cu = 0;
        if (hipGetDevice(&dev) != hipSuccess || hipDeviceGetAttribute(&cus, hipDeviceAttributeMultiprocessorCount, dev) != hipSuccess) { grid = -1; return; }
        if (hipFuncSetAttribute((const void*)fwd, hipFuncAttributeMaxDynamicSharedMemorySize, LDS_BYTES) != hipSuccess) { fprintf(stderr, "kernel_launch: hipFuncSetAttribute failed\n"); grid = -1; return; }
        if (hipOccupancyMaxActiveBlocksPerMultiprocessor(&per_cu, (const void*)fwd, NTHR, LDS_BYTES) != hipSuccess || per_cu < 1) fprintf(stderr, "kernel_launch: occupancy query reports %d per CU\n", per_cu);
        (void)hipGetLastError();
        grid = cus;
        if (grid != 256) fprintf(stderr, "kernel_launch: %d CUs (expected 256)\n", grid);
    }
    if (grid < 0) return;
    (void)hipMemsetAsync((char*)d_ws + WS_CTL, 0, CTL_ZERO_BYTES, stream);
    Args a{};
    for (int i = 0; i < N_INPUTS; ++i) a.in[i] = (const float*)d_in[i];
    a.out = (float*)d_out; a.ws = (unsigned char*)d_ws;
#if MK_N_LAUNCHES == 1
    a.ph_lo = 0; a.ph_hi = N_PHASES;
    hipLaunchKernelGGL(fwd, dim3(grid), dim3(NTHR), LDS_BYTES, stream, a);
#else
    for (int ph = 0; ph < N_PHASES; ++ph) { a.ph_lo = ph; a.ph_hi = ph + 1; hipLaunchKernelGGL(fwd, dim3(grid), dim3(NTHR), LDS_BYTES, stream, a); }
#endif
}
```

```cpp
#define MK_N_LAUNCHES 1
#include <hip/hip_runtime.h>
#include <cstdio>
#include <cstdint>
#include <cmath>
namespace pg8 {
#define PG8_LAS __attribute__((address_space(3)))
typedef unsigned short bf16_t;
typedef short bf16x8 __attribute__((ext_vector_type(8)));
typedef float f32x4 __attribute__((ext_vector_type(4)));
typedef unsigned u32x4 __attribute__((ext_vector_type(4)));
constexpr int BM = 256, BK = 64, HALF = 128, HTB = HALF * BK * 2  , STAGE_BYTES = 8 * HTB, NXCD = 8, WGM = 8;

__host__ __device__ __forceinline__ int lds_byte(int r, int c) { const int st = (r >> 4) * 2 + (c >> 5), rr = r & 15, cc = c & 31, ob = rr * 64 + cc * 2; return st * 1024 + (ob ^ (((ob >> 9) & 1) << 5)); }
__host__ __device__ __forceinline__ void stage_rc(int b, int& R, int& C) { const int st = b / 1024, sb = b % 1024, swz = sb ^ (((sb >> 9) & 1) << 5); R = (st >> 1) * 16 + swz / 64; C = (st & 1) * 32 + (swz % 64) / 2; }
__host__ __device__ __forceinline__ int perm32(int rho) { const int n = rho >> 4, i = rho & 15; return 8 * (i >> 2) + 4 * n + (i & 3); }

struct Unit { int pm, pn; };
struct Gemm { const bf16_t* A; const bf16_t* Bt; int M, N, K; };

struct StaticOrder {
    int nM, nN, nwg, G, c;
    __host__ __device__ void init(int M, int N, int G_, int c_) { nM = M / BM; nN = N / BM; nwg = nM * nN; G = G_; c = c_; }
    __host__ __device__ bool next(int i, Unit& u) const {
        const long L = (long)i * G + c; if (L >= nwg) return false;
        int wgid = (int)L; { const int q = nwg / NXCD, r = nwg % NXCD, xcd = wgid % NXCD, off = wgid / NXCD; wgid = (xcd < r ? xcd * (q + 1) : r * (q + 1) + (xcd - r) * q) + off; }
        const int nig = WGM * nN, gid = wgid / nig, fm = gid * WGM, gsz = (nM - fm) < WGM ? (nM - fm) : WGM;
        u.pm = fm + ((wgid % nig) % gsz); u.pn = (wgid % nig) / gsz; return true;
    }
    __device__ __forceinline__ void a_ready(const Unit&) const {}
    __device__ __forceinline__ void done(const Unit&) const {}
};

__device__ __forceinline__ unsigned cvt_pk_bf16(float lo, float hi) { unsigned r; asm volatile("v_cvt_pk_bf16_f32 %0, %1, %2" : "=v"(r) : "v"(lo), "v"(hi)); return r; }
typedef float f32x2 __attribute__((ext_vector_type(2)));
constexpr int PROJ_LD = 3328, AUX_LD = 256, DFF = 2816, DM = 1024;
typedef _Float16 h16x8 __attribute__((ext_vector_type(8)));
struct EpiInProj {
    static constexpr bool PERM = true, AFTER_DRAIN = false;
    bf16_t* proj; float* aux; _Float16* ki;
    __device__ __forceinline__ void operator()(const f32x4 (&acc)[2][2][4][2], const Unit& u, int wr, int wc, int fr, int fq) const {
        const int row0 = u.pm * BM + wr * 64 + fr;
        if (u.pn < 13) {
            const int col0 = u.pn * BM + wc * 32 + 8 * fq;
#pragma unroll
            for (int ai = 0; ai < 2; ++ai)
#pragma unroll
                for (int m = 0; m < 4; ++m) { bf16_t* rowp = proj + (size_t)(row0 + ai * HALF + m * 16) * PROJ_LD + col0;
#pragma unroll
                    for (int bj = 0; bj < 2; ++bj) { const f32x4 v0 = acc[ai][bj][m][0], v1 = acc[ai][bj][m][1];
                        u32x4 w; w.x = cvt_pk_bf16(v0[0], v0[1]); w.y = cvt_pk_bf16(v0[2], v0[3]); w.z = cvt_pk_bf16(v1[0], v1[1]); w.w = cvt_pk_bf16(v1[2], v1[3]);
                        *(u32x4*)(rowp + bj * HALF) = w; } }
        } else {
            const int col0 = wc * 32 + 8 * fq;
#pragma unroll
            for (int ai = 0; ai < 2; ++ai)
#pragma unroll
                for (int m = 0; m < 4; ++m) { float* rowp = aux + (size_t)(row0 + ai * HALF + m * 16) * AUX_LD + col0;
#pragma unroll
                    for (int bj = 0; bj < 2; ++bj) { *(f32x4*)(rowp + bj * HALF) = acc[ai][bj][m][0]; *(f32x4*)(rowp + bj * HALF + 4) = acc[ai][bj][m][1];
                        const int cg = col0 + bj * HALF;
                        if (cg >= 144 && cg < 176) { const f32x4 v0 = acc[ai][bj][m][0], v1 = acc[ai][bj][m][1]; h16x8 hv;
                            hv[0] = (_Float16)v0[0]; hv[1] = (_Float16)v0[1]; hv[2] = (_Float16)v0[2]; hv[3] = (_Float16)v0[3]; hv[4] = (_Float16)v1[0]; hv[5] = (_Float16)v1[1]; hv[6] = (_Float16)v1[2]; hv[7] = (_Float16)v1[3];
                            *(h16x8*)(ki + (size_t)(row0 + ai * HALF + m * 16) * 32 + (cg - 144)) = hv; } } }
        }
    }
};
struct EpiFfnUp {
    static constexpr bool PERM = true, AFTER_DRAIN = false;
    bf16_t* H;
    __device__ __forceinline__ void operator()(const f32x4 (&acc)[2][2][4][2], const Unit& u, int wr, int wc, int fr, int fq) const {
        const int row0 = u.pm * BM + wr * 64 + fr, col0 = u.pn * HALF + wc * 32 + 8 * fq;
#pragma unroll
        for (int ai = 0; ai < 2; ++ai)
#pragma unroll
            for (int m = 0; m < 4; ++m) { bf16_t* rowp = H + (size_t)(row0 + ai * HALF + m * 16) * DFF + col0;
                float o[8];
#pragma unroll
                for (int n = 0; n < 2; ++n)
#pragma unroll
                    for (int j = 0; j < 4; ++j) { const float g = acc[ai][0][m][n][j], up = acc[ai][1][m][n][j];
                        const float sg = g * __builtin_amdgcn_rcpf(1.0f + __builtin_amdgcn_exp2f(-1.44269504089f * g)); o[n * 4 + j] = sg * up; }
                u32x4 w; w.x = cvt_pk_bf16(o[0], o[1]); w.y = cvt_pk_bf16(o[2], o[3]); w.z = cvt_pk_bf16(o[4], o[5]); w.w = cvt_pk_bf16(o[6], o[7]);
                *(u32x4*)rowp = w; }
    }
};
struct EpiRes {
    static constexpr bool PERM = false, AFTER_DRAIN = false;
    const float* base; float* out; float alpha;
    __device__ __forceinline__ void operator()(const f32x4 (&acc)[2][2][4][2], const Unit& u, int wr, int wc, int fr, int fq) const {
        const int row0 = u.pm * BM + wr * 64 + fr, col0 = u.pn * BM + wc * 32 + 4 * fq;
#pragma unroll
        for (int ai = 0; ai < 2; ++ai)
#pragma unroll
            for (int m = 0; m < 4; ++m) { const size_t off = (size_t)(row0 + ai * HALF + m * 16) * DM + col0;
#pragma unroll
                for (int bj = 0; bj < 2; ++bj)
#pragma unroll
                    for (int n = 0; n < 2; ++n) { const f32x4 b = *(const f32x4*)(base + off + bj * HALF + n * 16);
                        *(f32x4*)(out + off + bj * HALF + n * 16) = b * alpha + acc[ai][bj][m][n]; } }
    }
};
template <class Epi, class Sched, bool ALIGN_EPI = false, bool SP2 = false>
__device__ __forceinline__ void gemm_phase(PG8_LAS unsigned char* lds, const Gemm g, const Sched& S, const Epi& E) {
    int tid_ = threadIdx.x; asm volatile("" : "+v"(tid_));
    const int tid = tid_, wid = __builtin_amdgcn_readfirstlane(tid >> 6), lane = tid & 63, wr = wid >> 2, wc = wid & 3, fr = lane & 15, fq = lane >> 4;
    const int K = g.K, nt = K / BK;
    unsigned voffA[2], voffB[2];
#pragma unroll
    for (int i = 0; i < 2; ++i) { int R, C; stage_rc(tid * 16 + i * 8192, R, C); const int Rb = Epi::PERM ? ((R & ~31) + perm32(R & 31)) : R;
        voffA[i] = (unsigned)(R * K + C) * 2u; voffB[i] = (unsigned)(Rb * K + C) * 2u; }
    const size_t kstep = (size_t)(BK * 2);
    const size_t hstep = (size_t)HALF * K * 2;
    const size_t tstep = 2 * hstep;
    const unsigned ldsw = (unsigned)wid * 1024u;
    const int aoff = lds_byte(wr * 64 + fr, fq * 8), boff = lds_byte(wc * 32 + fr, fq * 8);
#define PG8_SA(b, h) (((b) * 2 + (h)) * HTB)
#define PG8_SB(b, h) ((4 + (b) * 2 + (h)) * HTB)
#define PG8_STAGE(bufoff, gbase, voff) do { _Pragma("unroll") for (int _i = 0; _i < 2; ++_i) \
        __builtin_amdgcn_global_load_lds((const unsigned*)((const char*)(gbase) + (voff)[_i]), (PG8_LAS unsigned*)(lds + (bufoff) + ldsw + _i * 8192), 16, 0, 0); } while (0)
#define PG8_LDA(dst, b, h) do { _Pragma("unroll") for (int m = 0; m < 4; ++m) _Pragma("unroll") for (int k = 0; k < 2; ++k) dst[m][k] = *(const PG8_LAS bf16x8*)(lds + PG8_SA(b, h) + aoff + m * 2048 + k * 1024); } while (0)
#define PG8_LDB(dst, b, h) do { _Pragma("unroll") for (int n = 0; n < 2; ++n) _Pragma("unroll") for (int k = 0; k < 2; ++k) dst[n][k] = *(const PG8_LAS bf16x8*)(lds + PG8_SB(b, h) + boff + n * 2048 + k * 1024); } while (0)
#define PG8_MMA(ai, bj, At, Bt) do { __builtin_amdgcn_s_setprio(1); _Pragma("unroll") for (int m = 0; m < 4; ++m) _Pragma("unroll") for (int n = 0; n < 2; ++n) _Pragma("unroll") for (int k = 0; k < 2; ++k) \
        acc[ai][bj][m][n] = __builtin_amdgcn_mfma_f32_16x16x32_bf16(Bt[n][k], At[m][k], acc[ai][bj][m][n], 0, 0, 0); __builtin_amdgcn_s_setprio(0); } while (0)
#define PG8_WAIT_V(n) asm volatile("s_waitcnt vmcnt(" #n ")" ::: "memory")
#define PG8_WAIT_L(n) asm volatile("s_waitcnt lgkmcnt(" #n ")" ::: "memory")
#define PG8_BAR __builtin_amdgcn_s_barrier()
#define PG8_SCHED __builtin_amdgcn_sched_barrier(0)
    Unit cur, nxt; int ui = 0;
    if (!S.next(0, cur)) return;
    f32x4 acc[2][2][4][2];
#pragma unroll
    for (int a = 0; a < 2; ++a)
#pragma unroll
        for (int b = 0; b < 2; ++b)
#pragma unroll
            for (int m = 0; m < 4; ++m)
#pragma unroll
                for (int n = 0; n < 2; ++n) acc[a][b][m][n] = (f32x4){0.f, 0.f, 0.f, 0.f};
    bf16x8 At[4][2], B0[2][2], B1[2][2];
    const char* cA = (const char*)g.A + (size_t)cur.pm * tstep; const char* cB = (const char*)g.Bt + (size_t)cur.pn * tstep;
    S.a_ready(cur);
    if constexpr (SP2) {
        PG8_STAGE(PG8_SB(0, 0), cB, voffB); PG8_STAGE(PG8_SB(0, 1), cB + hstep, voffB); PG8_STAGE(PG8_SA(0, 0), cA, voffA); PG8_STAGE(PG8_SA(0, 1), cA + hstep, voffA);
        if (wr == 1) PG8_BAR;
        PG8_WAIT_V(2); PG8_BAR;
        PG8_STAGE(PG8_SB(1, 0), cB + kstep, voffB); PG8_STAGE(PG8_SA(1, 0), cA + kstep, voffA); PG8_STAGE(PG8_SB(1, 1), cB + hstep + kstep, voffB);
        PG8_WAIT_V(6); PG8_BAR;
    } else {
        PG8_STAGE(PG8_SB(0, 0), cB, voffB); PG8_STAGE(PG8_SA(0, 0), cA, voffA); PG8_STAGE(PG8_SB(0, 1), cB + hstep, voffB); PG8_STAGE(PG8_SA(0, 1), cA + hstep, voffA);
        if (wr == 1) PG8_BAR;
        PG8_WAIT_V(4); PG8_BAR;
        PG8_STAGE(PG8_SB(1, 0), cB + kstep, voffB); PG8_STAGE(PG8_SA(1, 0), cA + kstep, voffA); PG8_STAGE(PG8_SB(1, 1), cB + hstep + kstep, voffB);
        PG8_WAIT_V(6); PG8_BAR;
    }
    for (;;) {
        const bool has_next = S.next(ui + 1, nxt);
        const char* nA = has_next ? (const char*)g.A + (size_t)nxt.pm * tstep : cA; const char* nB = has_next ? (const char*)g.Bt + (size_t)nxt.pn * tstep : cB;
        for (int t = 0; t < nt; t += 2) {
            const bool last = (t == nt - 2);
            const char* a1 = cA + (size_t)(t + 1) * kstep;
            const char* a2 = last ? nA : cA + (size_t)(t + 2) * kstep; const char* b2 = last ? nB : cB + (size_t)(t + 2) * kstep;
            const char* a3 = a2 + kstep; const char* b3 = b2 + kstep;
            if (last && has_next) S.a_ready(nxt);
            if constexpr (SP2) {
            PG8_LDB(B0, 0, 0); PG8_LDB(B1, 0, 1); PG8_SCHED; PG8_LDA(At, 0, 0); PG8_STAGE(PG8_SA(1, 1), a1 + hstep, voffA);
            PG8_WAIT_V(8); PG8_WAIT_L(0); PG8_BAR; PG8_MMA(0, 0, At, B0); PG8_MMA(0, 1, At, B1); PG8_BAR; PG8_SCHED;
            PG8_LDA(At, 0, 1); PG8_STAGE(PG8_SB(0, 0), b2, voffB); PG8_STAGE(PG8_SB(0, 1), b2 + hstep, voffB); PG8_STAGE(PG8_SA(0, 0), a2, voffA);
            PG8_WAIT_V(8); PG8_WAIT_L(0); PG8_BAR; PG8_MMA(1, 0, At, B0); PG8_MMA(1, 1, At, B1); PG8_BAR; PG8_SCHED;
            PG8_LDB(B0, 1, 0); PG8_LDB(B1, 1, 1); PG8_SCHED; PG8_LDA(At, 1, 0); PG8_STAGE(PG8_SA(0, 1), a2 + hstep, voffA);
            PG8_WAIT_V(8); PG8_WAIT_L(0); PG8_BAR; PG8_MMA(0, 0, At, B0); PG8_MMA(0, 1, At, B1); PG8_BAR; PG8_SCHED;
            PG8_LDA(At, 1, 1); PG8_STAGE(PG8_SB(1, 0), b3, voffB); PG8_STAGE(PG8_SB(1, 1), b3 + hstep, voffB); PG8_STAGE(PG8_SA(1, 0), a3, voffA);
            PG8_WAIT_V(8); PG8_WAIT_L(0); PG8_BAR; PG8_MMA(1, 0, At, B0); PG8_MMA(1, 1, At, B1); PG8_BAR; PG8_SCHED;
            } else {
            PG8_LDB(B0, 0, 0); PG8_SCHED; PG8_LDA(At, 0, 0); PG8_STAGE(PG8_SA(1, 1), a1 + hstep, voffA);
            PG8_WAIT_L(8); PG8_BAR; PG8_WAIT_L(0); PG8_MMA(0, 0, At, B0); PG8_BAR; PG8_SCHED;
            PG8_LDB(B1, 0, 1); PG8_STAGE(PG8_SB(0, 0), b2, voffB);
            PG8_BAR; PG8_WAIT_L(0); PG8_MMA(0, 1, At, B1); PG8_BAR;
            PG8_LDA(At, 0, 1); PG8_STAGE(PG8_SA(0, 0), a2, voffA);
            PG8_BAR; PG8_WAIT_L(0); PG8_MMA(1, 0, At, B0); PG8_BAR; PG8_SCHED;
            PG8_STAGE(PG8_SB(0, 1), b2 + hstep, voffB);
            PG8_WAIT_V(6); PG8_BAR; PG8_MMA(1, 1, At, B1); PG8_BAR;
            PG8_LDB(B0, 1, 0); PG8_SCHED; PG8_LDA(At, 1, 0); PG8_STAGE(PG8_SA(0, 1), a2 + hstep, voffA);
            PG8_WAIT_L(8); PG8_BAR; PG8_WAIT_L(0); PG8_MMA(0, 0, At, B0); PG8_BAR; PG8_SCHED;
            PG8_LDB(B1, 1, 1); PG8_STAGE(PG8_SB(1, 0), b3, voffB);
            PG8_BAR; PG8_WAIT_L(0); PG8_MMA(0, 1, At, B1); PG8_BAR;
            PG8_LDA(At, 1, 1); PG8_STAGE(PG8_SA(1, 0), a3, voffA);
            PG8_BAR; PG8_WAIT_L(0); PG8_MMA(1, 0, At, B0); PG8_BAR; PG8_SCHED;
            PG8_STAGE(PG8_SB(1, 1), b3 + hstep, voffB);
            PG8_WAIT_V(6); PG8_BAR; PG8_MMA(1, 1, At, B1); PG8_BAR;
            }
        }
        if constexpr (ALIGN_EPI) { if (wr == 0) PG8_BAR; }
        if constexpr (!Epi::AFTER_DRAIN) { E(acc, cur, wr, wc, fr, fq); S.done(cur); }
        if (!has_next) break;
#pragma unroll
        for (int a = 0; a < 2; ++a)
#pragma unroll
            for (int b = 0; b < 2; ++b)
#pragma unroll
                for (int m = 0; m < 4; ++m)
#pragma unroll
                    for (int n = 0; n < 2; ++n) acc[a][b][m][n] = (f32x4){0.f, 0.f, 0.f, 0.f};
        cur = nxt; cA = nA; cB = nB; ++ui;
        if constexpr (ALIGN_EPI) { if (wr == 1) PG8_BAR; }
    }
    PG8_WAIT_V(0);
    if constexpr (!ALIGN_EPI) { if (wr == 0) PG8_BAR; }
    PG8_BAR;
    if constexpr (Epi::AFTER_DRAIN) { E.fused(acc, cur, wr, wc, fr, fq, lds, wid, lane); S.done(cur); }
#undef PG8_SA
#undef PG8_SB
#undef PG8_STAGE
#undef PG8_LDA
#undef PG8_LDB
#undef PG8_MMA
#undef PG8_WAIT_V
#undef PG8_WAIT_L
#undef PG8_BAR
#undef PG8_SCHED
}
}

#ifndef MK_N_LAUNCHES
#define MK_N_LAUNCHES 1
#endif
constexpr int NWAVES = 8, NTHR = 512;
constexpr int BATCH = 2, SEQ = 16384, T = BATCH * SEQ, D = 1024, DEPTH = 2, DFF = 2816;
constexpr int NIN = 3584, NGU = 5632, PROJ_LD = 3328, AUX_LD = 256;
constexpr float DN_ALPHA = 1.41421356237309515f, LN_EPS = 1e-5f;
constexpr int PC_LX = 0, PC_LG = 256, PC_GQ = 512, PC_GK = 896, PC_GV = 1280, PC_GG = 1664, PC_DQ = 2048, PC_DK = 2432, PC_DV = 2816;
constexpr int AC_GLR = 0, AC_IQ = 16, AC_IK = 144, AC_IW = 176;
constexpr int YC_LRU = 0, YC_GLA = 256, YC_DSA = 640;
enum { I_X = 0, I_WIN, I_CONVW, I_CONVB, I_WA, I_BA, I_WX, I_BX, I_LAM, I_WG2, I_BG, I_NG, I_RB, I_WOUT, I_LN1G, I_LN1B, I_WFG, I_WFU, I_WFD, I_LN2G, I_LN2B, N_INPUTS };

constexpr size_t MiB = 1u << 20;
constexpr size_t WS_CTL = 0, CTL_ZERO_BYTES = 1 * MiB;
constexpr size_t WS_W = 1 * MiB, W_LAYER = 26 * MiB, WO_IN = 0, WO_OUT = 7 * MiB, WO_GU = 9 * MiB, WO_D = 20 * MiB;
constexpr size_t WS_XB = 54 * MiB, WS_PROJ = 118 * MiB, WS_AUX = 326 * MiB, WS_R2 = 358 * MiB, WS_SEL = 486 * MiB, WS_KI = 502 * MiB, WS_END = 504 * MiB;
constexpr size_t WS_V1 = WS_PROJ, WS_H = WS_PROJ, WS_Y = WS_R2, WS_GLAU = WS_R2 + 64 * MiB, WS_DEC = WS_R2 + 112 * MiB, WS_LSUM = WS_R2 + 113 * MiB, WS_CARRY = WS_R2 + 117 * MiB, WS_V2 = WS_R2;
static_assert(WO_IN + (size_t)NIN * D * 2 <= WO_OUT && WO_OUT + (size_t)D * D * 2 <= WO_GU && WO_GU + (size_t)NGU * D * 2 <= WO_D && WO_D + (size_t)D * DFF * 2 <= W_LAYER, "weight map");
static_assert(WS_W + 2 * W_LAYER <= WS_XB && WS_XB + (size_t)T * D * 2 <= WS_PROJ && WS_PROJ + (size_t)T * PROJ_LD * 2 <= WS_AUX && WS_AUX + (size_t)T * AUX_LD * 4 <= WS_R2, "ws map");
static_assert((size_t)T * DFF * 2 <= WS_AUX - WS_PROJ && (size_t)T * D * 4 <= WS_AUX - WS_PROJ && WS_CARRY + 2 * MiB <= WS_END && (size_t)T * D * 4 <= WS_END - WS_R2, "ws overlays");
constexpr int CW_BAR = 4096;

constexpr int RING_OFF = 0, RING_BYTES = 131072;
constexpr int LDSCTL_OFF = RING_BYTES, MISC_OFF = LDSCTL_OFF + 320;
constexpr int LDS_BYTES = 147456;
constexpr int LDS_DCNT = LDSCTL_OFF + 1024, LDS_DTHR = LDS_DCNT + 128, LDS_HIST = LDSCTL_OFF + 2048;

#define GAS __attribute__((address_space(1)))
#define LAS __attribute__((address_space(3)))
typedef unsigned short bf16;
typedef unsigned v4u __attribute__((ext_vector_type(4)));
typedef unsigned v2u __attribute__((ext_vector_type(2)));
typedef float f32x4 __attribute__((ext_vector_type(4)));
typedef GAS unsigned gu32;
typedef _Float16 h16x8 __attribute__((ext_vector_type(8)));
typedef float f32x16 __attribute__((ext_vector_type(16)));
#define RLX_AGENT __ATOMIC_RELAXED, __HIP_MEMORY_SCOPE_AGENT
#define LDS_WAIT() asm volatile("s_waitcnt lgkmcnt(0)" ::: "memory")
#define VM_WAIT() asm volatile("s_waitcnt vmcnt(0)" ::: "memory")
__device__ __forceinline__ unsigned f2bf(float f) { unsigned u = __builtin_bit_cast(unsigned, f); return (u + 0x7fffu + ((u >> 16) & 1u)) >> 16; }
__device__ __forceinline__ unsigned pk2(float lo, float hi) { return f2bf(lo) | (f2bf(hi) << 16); }
__device__ __forceinline__ float bf2f(unsigned short h) { return __builtin_bit_cast(float, (unsigned)h << 16); }
__device__ __forceinline__ float bflo(unsigned w) { return __builtin_bit_cast(float, w << 16); }
__device__ __forceinline__ float bfhi(unsigned w) { return __builtin_bit_cast(float, w & 0xffff0000u); }

#define XB_TMO      128
#define XB_XCNT(j)  (256  + 64 * (j))
#define XB_XSUB(j)  (1280 + 64 * (j))
#define XB_XGEN(j)  (2304 + 64 * (j))
#define XB_TOP      3328
#define XB_TOPGEN   3392
#define XCD_BAR_WORDS 3456
#define XB_SPIN_CAP (1u << 18)

__device__ __forceinline__ unsigned xb_ld(unsigned* p)              { return __hip_atomic_load(p, __ATOMIC_RELAXED, __HIP_MEMORY_SCOPE_AGENT); }
__device__ __forceinline__ unsigned xb_add(unsigned* p, unsigned v) { return __hip_atomic_fetch_add(p, v, __ATOMIC_RELAXED, __HIP_MEMORY_SCOPE_AGENT); }
__device__ __forceinline__ unsigned xb_xcc_id() { return (unsigned)__builtin_amdgcn_s_getreg((3 << 11) | 20) & 0xFu; }
#define XB_SPIN(cond, bar) do { unsigned _sp = 0; while (cond) { __builtin_amdgcn_s_sleep(1); \
    if ((++_sp & 255u) == 0u) { if (xb_ld(&(bar)[XB_TMO])) break; if (_sp > XB_SPIN_CAP) { atomicAdd(&(bar)[XB_TMO], 1u); break; } } } } while (0)

struct XcdBarrier {
    unsigned* bar; unsigned x;
    volatile LAS unsigned* st;
};

__device__ __forceinline__ XcdBarrier xcd_barrier_post(unsigned* bar, volatile LAS unsigned* st) {
    XcdBarrier b; b.bar = bar; b.x = xb_xcc_id(); b.st = st;
    if (threadIdx.x == 0) (void)xb_add(&bar[XB_XCNT(b.x)], 1u);
    return b;
}
__device__ __forceinline__ void xcd_barrier_complete(unsigned* bar, unsigned x, unsigned& nloc, unsigned& nx) {
    const unsigned G = gridDim.x * gridDim.y * gridDim.z;
    unsigned sum, cnt, mine, sp = 0u;
    for (;;) {
        sum = 0u; cnt = 0u; mine = 0u;
#pragma unroll
        for (unsigned j = 0; j < 16; ++j) { const unsigned c = xb_ld(&bar[XB_XCNT(j)]); sum += c; cnt += (c > 0u) ? 1u : 0u; mine = (j == x) ? c : mine; }
        if (sum == G) break;
        __builtin_amdgcn_s_sleep(1);
        if ((++sp & 255u) == 0u) { if (xb_ld(&bar[XB_TMO])) break; if (sp > XB_SPIN_CAP) { atomicAdd(&bar[XB_TMO], 1u); break; } }
    }
    nloc = mine > 0u ? mine : 1u; nx = cnt > 0u ? cnt : 1u;
}

__device__ __forceinline__ void xcd_barrier(const XcdBarrier& b) {
    asm volatile("s_waitcnt vmcnt(0)" ::: "memory");
    __syncthreads();
    if (threadIdx.x == 0) {
        unsigned* bar = b.bar;
        __builtin_amdgcn_s_waitcnt(0);
        unsigned nloc = b.st[0], nx = b.st[1];
        if (nloc == 0u) { xcd_barrier_complete(bar, b.x, nloc, nx); b.st[0] = nloc; b.st[1] = nx; }
        const unsigned old = xb_add(&bar[XB_XSUB(b.x)], 1u);
        const unsigned gen = old / nloc;
        if (old + 1u == (gen + 1u) * nloc) {
            __builtin_amdgcn_fence(__ATOMIC_RELEASE, "agent");
            asm volatile("s_waitcnt vmcnt(0)" ::: "memory");
            const unsigned og = xb_add(&bar[XB_TOP], 1u);
            const unsigned tg = og / nx;
            if (og + 1u == (tg + 1u) * nx) xb_add(&bar[XB_TOPGEN], 1u);
            else XB_SPIN(xb_ld(&bar[XB_TOPGEN]) == tg, bar);
            __builtin_amdgcn_fence(__ATOMIC_ACQUIRE, "agent");
            xb_add(&bar[XB_XGEN(b.x)], 1u);
            asm volatile("s_waitcnt vmcnt(0)" ::: "memory");
        } else {
            XB_SPIN(xb_ld(&bar[XB_XGEN(b.x)]) == gen, bar);
            __builtin_amdgcn_fence(__ATOMIC_ACQUIRE, "agent");
            asm volatile("s_waitcnt vmcnt(0)" ::: "memory");
        }
    }
    __syncthreads();
}


struct Args { const float* in[N_INPUTS]; float* out; unsigned char* ws; int ph_lo, ph_hi; };
struct Frame {
    unsigned char* lds;
    int tid, lane, wave, G;
    float* out; unsigned char* ws;
};
__device__ __forceinline__ bf16* w_ptr(const Frame& F, int l, size_t off) { return (bf16*)(F.ws + WS_W + (size_t)l * W_LAYER + off); }

__device__ __forceinline__ float wave_sum(float v) {
#pragma unroll
    for (int o = 1; o < 64; o <<= 1) v += __shfl_xor(v, o);
    return v;
}

__device__ __forceinline__ void transpose_item(const float* W, int K, int N, bf16* Wt, float* scr, int kb, int rb, int lane, int sc) {
    const int k0 = 64 * kb, r0 = 32 * rb, rl = lane & 31;
#pragma unroll 8
    for (int i = 0; i < 32; ++i) { const int kk = 2 * i + (lane >> 5); scr[kk * 33 + rl] = sc >= 0 ? W[(size_t)(k0 + kk) * N + sc] : 0.f; }
    LDS_WAIT(); asm volatile("" ::: "memory");
    const int c = lane & 7;
#pragma unroll
    for (int j = 0; j < 4; ++j) { const int n = (lane >> 3) + 8 * j; const float* s = scr + (8 * c) * 33 + n;
        v4u o; o.x = pk2(s[0 * 33], s[1 * 33]); o.y = pk2(s[2 * 33], s[3 * 33]); o.z = pk2(s[4 * 33], s[5 * 33]); o.w = pk2(s[6 * 33], s[7 * 33]);
        *(v4u*)(Wt + (size_t)(r0 + n) * K + k0 + 8 * c) = o; }
    LDS_WAIT(); asm volatile("" ::: "memory");
}
__device__ __forceinline__ int win_src(int r) {
    if (r < 2048) return r;
    if (r < 3200) return r + 16;
    if (r < 3328) return -1;
    if (r < 3344) return 2048 + (r - 3328);
    if (r < 3508) return 3216 + (r - 3344);
    return -1;
}
__device__ __forceinline__ void p0_prologue(Frame& F, const Args& A) {
    float* scr = (float*)(F.lds + RING_OFF + F.wave * 16384);
    const int gw = blockIdx.x * NWAVES + F.wave, NGW = F.G * NWAVES;
    constexpr int I_IN = 16 * (NIN / 32), I_OUT = 16 * (D / 32), I_GU = 16 * (NGU / 32), I_D = (DFF / 64) * (D / 32), I_L = I_IN + I_OUT + I_GU + I_D;
    for (int it = gw; it < DEPTH * I_L; it += NGW) {
        const int l = it / I_L; int r = it % I_L;
        if (r < I_IN) { const int kb = r / (NIN / 32), rb = r % (NIN / 32); transpose_item(A.in[I_WIN] + (size_t)l * D * 3380, D, 3380, w_ptr(F, l, WO_IN), scr, kb, rb, F.lane, win_src(rb * 32 + (F.lane & 31))); continue; } r -= I_IN;
        if (r < I_OUT) { const int kb = r / (D / 32), rb = r % (D / 32); transpose_item(A.in[I_WOUT] + (size_t)l * D * D, D, D, w_ptr(F, l, WO_OUT), scr, kb, rb, F.lane, rb * 32 + (F.lane & 31)); continue; } r -= I_OUT;
        if (r < I_GU) { const int kb = r / (NGU / 32), rb = r % (NGU / 32); const int row = rb * 32 + (F.lane & 31), tile = row >> 8, w = row & 255; const bool up = w >= 128;
            transpose_item(A.in[up ? I_WFU : I_WFG] + (size_t)l * D * DFF, D, DFF, w_ptr(F, l, WO_GU), scr, kb, rb, F.lane, tile * 128 + (w & 127)); continue; } r -= I_GU;
        { const int kb = r / (D / 32), rb = r % (D / 32); transpose_item(A.in[I_WFD] + (size_t)l * DFF * D, DFF, D, w_ptr(F, l, WO_D), scr, kb, rb, F.lane, rb * 32 + (F.lane & 31)); }
    }
    const float* x = A.in[I_X]; bf16* xb = (bf16*)(F.ws + WS_XB);
    for (int m = gw; m < T; m += NGW) {
        const f32x4* xr = (const f32x4*)(x + (size_t)m * D) + F.lane; unsigned long long* o8 = (unsigned long long*)(xb + (size_t)m * D) + F.lane;
#pragma unroll
        for (int j = 0; j < 4; ++j) { const f32x4 v = xr[64 * j]; o8[64 * j] = (unsigned long long)pk2(v.x, v.y) | ((unsigned long long)pk2(v.z, v.w) << 32); }
    }
}

__device__ __forceinline__ void ln_phase(Frame& F, const float* V, const float* g, const float* b, float* xf, bf16* xb) {
    const int gw = blockIdx.x * NWAVES + F.wave, NGW = F.G * NWAVES;
    f32x4 gv[4], bv[4];
#pragma unroll
    for (int j = 0; j < 4; ++j) { gv[j] = ((const f32x4*)g)[F.lane + 64 * j]; bv[j] = ((const f32x4*)b)[F.lane + 64 * j]; }
    for (int m = gw; m < T; m += NGW) {
        const f32x4* xr = (const f32x4*)(V + (size_t)m * D) + F.lane;
        f32x4 v[4]; float s = 0.f;
#pragma unroll
        for (int j = 0; j < 4; ++j) { v[j] = xr[64 * j]; s += (v[j].x + v[j].y) + (v[j].z + v[j].w); }
        const float mean = wave_sum(s) * (1.f / D); float s2 = 0.f;
#pragma unroll
        for (int j = 0; j < 4; ++j) { v[j] = v[j] - mean; s2 += (v[j].x * v[j].x + v[j].y * v[j].y) + (v[j].z * v[j].z + v[j].w * v[j].w); }
        const float rstd = 1.f / sqrtf(wave_sum(s2) * (1.f / D) + LN_EPS);
        f32x4* of = (f32x4*)(xf + (size_t)m * D) + F.lane; unsigned long long* o8 = (unsigned long long*)(xb + (size_t)m * D) + F.lane;
#pragma unroll
        for (int j = 0; j < 4; ++j) { const f32x4 o = v[j] * rstd * gv[j] + bv[j]; of[64 * j] = o; o8[64 * j] = (unsigned long long)pk2(o.x, o.y) | ((unsigned long long)pk2(o.z, o.w) << 32); }
    }
}

__device__ __forceinline__ float sigmoidf_(float x) { return 1.f / (1.f + expf(-x)); }
__device__ __forceinline__ float gelu_tanh(float x) { const float u = 0.7978845608028654f * (x + 0.044715f * x * x * x); return 0.5f * x * (1.f + tanhf(u)); }
__device__ __forceinline__ void lru_item(Frame& F, const Args& A, int l, int it, bool fin) {
    float* XC = (float*)(F.lds + RING_OFF);
    const bf16* proj = (const bf16*)(F.ws + WS_PROJ);
    const int b = it >> 9, t0 = (it & 511) * 32, c = F.tid & 255, half = F.tid >> 8, ts = t0 + half * 16, ck = ts >> 4;
    const float* cw = A.in[I_CONVW] + (size_t)l * 4 * 256; const float cb = A.in[I_CONVB][l * 256 + c];
    const float w0 = cw[c], w1 = cw[256 + c], w2 = cw[512 + c], w3 = cw[768 + c];
    __syncthreads();
    {
        float xm3 = 0.f, xm2 = 0.f, xm1 = 0.f;
        if (ts >= 3) { xm3 = bf2f(proj[(size_t)(b * SEQ + ts - 3) * PROJ_LD + PC_LX + c]); xm2 = bf2f(proj[(size_t)(b * SEQ + ts - 2) * PROJ_LD + PC_LX + c]); xm1 = bf2f(proj[(size_t)(b * SEQ + ts - 1) * PROJ_LD + PC_LX + c]); }
#pragma unroll 4
        for (int i = 0; i < 16; ++i) { const float x0 = bf2f(proj[(size_t)(b * SEQ + ts + i) * PROJ_LD + PC_LX + c]);
            XC[(half * 16 + i) * 256 + c] = cb + w0 * xm3 + w1 * xm2 + w2 * xm1 + w3 * x0; xm3 = xm2; xm2 = xm1; xm1 = x0; }
    }
    __syncthreads();
    const int n = c >> 6, j = c & 63;
    const float* wa = A.in[I_WA] + (size_t)l * 4 * 64 * 64 + (size_t)n * 64 * 64 + j; const float* wx = A.in[I_WX] + (size_t)l * 4 * 64 * 64 + (size_t)n * 64 * 64 + j;
    const float ba = A.in[I_BA][l * 256 + c], bx = A.in[I_BX][l * 256 + c], lam = A.in[I_LAM][l * 256 + c];
    const float sp8 = -8.f * log1pf(expf(-lam));
    float h = 0.f, P = 1.f;
    if (fin) h = ((const float*)(F.ws + WS_CARRY))[(size_t)(b * 256 + c) * 1024 + ck];
    float rp[16], ip[16];
#pragma unroll
    for (int i = 0; i < 16; ++i) { rp[i] = ba; ip[i] = bx; }
    for (int k = 0; k < 64; ++k) { const float a_ = wa[k * 64], x_ = wx[k * 64];
#pragma unroll
        for (int i = 0; i < 16; ++i) { const float xv = XC[(half * 16 + i) * 256 + n * 64 + k]; rp[i] += xv * a_; ip[i] += xv * x_; } }
    bf16* Y = (bf16*)(F.ws + WS_Y);
#pragma unroll
    for (int i = 0; i < 16; ++i) {
        const float xc = XC[(half * 16 + i) * 256 + c];
        const float r = sigmoidf_(rp[i]), ig = sigmoidf_(ip[i]);
        const float la = sp8 * r, a = expf(la), u = sqrtf(-expm1f(2.f * la)) * (ig * xc);
        h = a * h + u; P *= a;
        if (fin) { const size_t tok = (size_t)(b * SEQ + ts + i); const float g = bf2f(proj[tok * PROJ_LD + PC_LG + c]); Y[tok * D + YC_LRU + c] = (bf16)f2bf(h * gelu_tanh(g)); }
    }
    if (!fin) { float2* S = (float2*)(F.ws + WS_LSUM); S[(size_t)(b * 256 + c) * 1024 + ck] = make_float2(P, h); }
}
__device__ __forceinline__ void lru_scan_row(Frame& F, int row) {
    const float2* S = (const float2*)(F.ws + WS_LSUM) + (size_t)row * 1024 + F.lane * 16; float* C = (float*)(F.ws + WS_CARRY) + (size_t)row * 1024 + F.lane * 16;
    float2 e[16];
#pragma unroll
    for (int i = 0; i < 16; ++i) e[i] = S[i];
    float P = 1.f, h = 0.f;
#pragma unroll
    for (int i = 0; i < 16; ++i) { h = e[i].x * h + e[i].y; P *= e[i].x; }
#pragma unroll
    for (int o = 1; o < 64; o <<= 1) { const float Pp = __shfl_up(P, o), hp = __shfl_up(h, o); if (F.lane >= o) { h = P * hp + h; P = Pp * P; } }
    float hc = __shfl_up(h, 1); if (F.lane == 0) hc = 0.f;
#pragma unroll
    for (int i = 0; i < 16; ++i) { C[i] = hc; hc = e[i].x * hc + e[i].y; }
}

__device__ __forceinline__ void gla_item(Frame& F, const Args& A, int l, int it, bool fin) {
    constexpr int LP = 65;
    float* bc = (float*)(F.lds + RING_OFF); float* qd = bc + 64 * LP; float* ki = qd + 64 * LP; float* ke = ki + 64 * LP; float* vv = ke + 64 * LP; float* att = vv + 64 * LP;
    float* glr = att + 64 * LP; float* w2 = glr + 1024; float* bg = w2 + 1024;
    const int b = it / 1536, r_ = it % 1536, n = r_ / 6, h = r_ % 6; const size_t tok0 = (size_t)b * SEQ + (size_t)n * 64;
    const bf16* proj = (const bf16*)(F.ws + WS_PROJ); const float* aux = (const float*)(F.ws + WS_AUX);
    float* U = (float*)(F.ws + WS_GLAU) + (size_t)it * 4096; float* DEC = (float*)(F.ws + WS_DEC) + (size_t)it * 64;
    const int tid = F.tid;
    __syncthreads();
    for (int i = tid; i < 1024; i += NTHR) { const int c = i >> 4, r = i & 15; glr[i] = aux[(tok0 + c) * AUX_LD + AC_GLR + r]; }
    for (int i = tid; i < 1024; i += NTHR) { const int r = i >> 6, d = i & 63; w2[i] = A.in[I_WG2][(size_t)l * 16 * 384 + r * 384 + h * 64 + d]; }
    if (tid < 64) bg[tid] = A.in[I_BG][l * 384 + h * 64 + tid];
    __syncthreads();
    for (int e = tid; e < 4096; e += NTHR) { const int c = e >> 6, d = e & 63; float z = bg[d];
#pragma unroll
        for (int r = 0; r < 16; ++r) z += glr[c * 16 + r] * w2[r * 64 + d];
        bc[c * LP + d] = (fminf(z, 0.f) - log1pf(expf(-fabsf(z)))) * (1.f / 16.f); }
    __syncthreads();
    if (tid < 64) { float s = 0.f; for (int c = 0; c < 64; ++c) { s += bc[c * LP + tid]; bc[c * LP + tid] = s; } }
    __syncthreads();
    for (int e = tid; e < 4096; e += NTHR) { const int c = e >> 6, d = e & 63; const float b_ = bc[c * LP + d], bl = bc[63 * LP + d];
        const bf16* row = proj + (tok0 + c) * PROJ_LD + h * 64 + d;
        const float q = bf2f(row[PC_GQ]), k = bf2f(row[PC_GK]), v = bf2f(row[PC_GV]);
        qd[c * LP + d] = q * 0.125f * expf(b_); ki[c * LP + d] = k * expf(-b_); ke[c * LP + d] = k * expf(bl - b_); vv[c * LP + d] = v; }
    __syncthreads();
    if (!fin) {
        const int d = tid >> 3, dv0 = (tid & 7) * 8; float acc[8];
#pragma unroll
        for (int j = 0; j < 8; ++j) acc[j] = 0.f;
        for (int c = 0; c < 64; ++c) { const float kd = ke[c * LP + d];
#pragma unroll
            for (int j = 0; j < 8; ++j) acc[j] += kd * vv[c * LP + dv0 + j]; }
#pragma unroll
        for (int j = 0; j < 8; ++j) U[d * 64 + dv0 + j] = acc[j];
        if (tid < 64) DEC[tid] = expf(bc[63 * LP + tid]);
    } else {
        const int c = tid >> 3, s0 = (tid & 7) * 8, dv0 = s0; float a[8];
#pragma unroll
        for (int j = 0; j < 8; ++j) a[j] = 0.f;
        for (int d = 0; d < 64; ++d) { const float qv = qd[c * LP + d];
#pragma unroll
            for (int j = 0; j < 8; ++j) a[j] += qv * ki[(s0 + j) * LP + d]; }
#pragma unroll
        for (int j = 0; j < 8; ++j) att[c * LP + s0 + j] = (s0 + j <= c) ? a[j] : 0.f;
        for (int e = tid; e < 4096; e += NTHR) ke[(e >> 6) * LP + (e & 63)] = U[e];
        __syncthreads();
        float o[8];
#pragma unroll
        for (int j = 0; j < 8; ++j) o[j] = 0.f;
        for (int s = 0; s < 64; ++s) { const float av = att[c * LP + s];
#pragma unroll
            for (int j = 0; j < 8; ++j) o[j] += av * vv[s * LP + dv0 + j]; }
        for (int d = 0; d < 64; ++d) { const float qv = qd[c * LP + d];
#pragma unroll
            for (int j = 0; j < 8; ++j) o[j] += qv * ke[d * LP + dv0 + j]; }
        float ss = 0.f;
#pragma unroll
        for (int j = 0; j < 8; ++j) ss += o[j] * o[j];
        ss += __shfl_xor(ss, 1); ss += __shfl_xor(ss, 2); ss += __shfl_xor(ss, 4);
        const float rs = 1.f / sqrtf(ss * (1.f / 64.f) + 1e-6f);
        const bf16* grow = proj + (tok0 + c) * PROJ_LD + PC_GG + h * 64 + dv0; const float* ng = A.in[I_NG] + l * 384 + h * 64 + dv0;
        float y[8];
#pragma unroll
        for (int j = 0; j < 8; ++j) { const float g = bf2f(grow[j]); y[j] = o[j] * rs * ng[j] * (g / (1.f + expf(-g))); }
        v4u w; w.x = pk2(y[0], y[1]); w.y = pk2(y[2], y[3]); w.z = pk2(y[4], y[5]); w.w = pk2(y[6], y[7]);
        *(v4u*)((bf16*)(F.ws + WS_Y) + (tok0 + c) * D + YC_GLA + h * 64 + dv0) = w;
    }
}
__device__ __forceinline__ void gla_scan(Frame& F, int e) {
    const int bh = e >> 12, idx = e & 4095, d = idx >> 6, b = bh / 6, h = bh % 6;
    float* U = (float*)(F.ws + WS_GLAU); const float* DEC = (const float*)(F.ws + WS_DEC);
    float S = 0.f;
    for (int n0 = 0; n0 < 256; n0 += 8) {
        float u[8], dc[8];
#pragma unroll
        for (int i = 0; i < 8; ++i) { const size_t it = (size_t)b * 1536 + (size_t)(n0 + i) * 6 + h; u[i] = U[it * 4096 + idx]; dc[i] = DEC[it * 64 + d]; }
#pragma unroll
        for (int i = 0; i < 8; ++i) { const size_t it = (size_t)b * 1536 + (size_t)(n0 + i) * 6 + h; U[it * 4096 + idx] = S; S = dc[i] * S + u[i]; }
    }
}

__device__ __forceinline__ unsigned f2ord(float f) { const unsigned u = __builtin_bit_cast(unsigned, f); return u ^ ((u >> 31) ? 0xffffffffu : 0x80000000u); }
__device__ __forceinline__ float ord2f(unsigned v) { const unsigned u = (v & 0x80000000u) ? (v ^ 0x80000000u) : ~v; return __builtin_bit_cast(float, u); }
__device__ __forceinline__ int popc64(unsigned long long m) { return __builtin_popcountll(m); }
__device__ __forceinline__ int t5_bucket(int n) { if (n < 16) return n; const int v = 16 + (int)(__log2f((float)n * (1.f / 16.f)) * (16.f / 3.f)); return v < 31 ? v : 31; }
__device__ __forceinline__ unsigned dsa_compact(v2u* buf, int n, int lane) {
    unsigned o[8], id[8];
#pragma unroll
    for (int j = 0; j < 8; ++j) { const int e = j * 64 + lane; if (e < n) { const v2u x = buf[e]; o[j] = x.x; id[j] = x.y; } else { o[j] = 0u; id[j] = 0u; } }
    unsigned v = 0u;
    for (int bit = 31; bit >= 0; --bit) { const unsigned cand = v | (1u << bit); int c = 0;
#pragma unroll
        for (int j = 0; j < 8; ++j) c += popc64(__ballot(o[j] >= cand));
        if (c >= 256) v = cand; }
    int ngt = 0;
#pragma unroll
    for (int j = 0; j < 8; ++j) ngt += popc64(__ballot(o[j] > v));
    const int need = 256 - ngt; int outp = 0, tie_seen = 0;
    const unsigned long long lt = (1ull << lane) - 1ull;
#pragma unroll
    for (int j = 0; j < 8; ++j) {
        const bool isgt = o[j] > v, iseq = o[j] == v;
        const unsigned long long eqm = __ballot(iseq);
        const bool keep = isgt || (iseq && (tie_seen + popc64(eqm & lt)) < need);
        const unsigned long long km = __ballot(keep);
        if (keep) { v2u x; x.x = o[j]; x.y = id[j]; buf[outp + popc64(km & lt)] = x; }
        outp += popc64(km); tie_seen += popc64(eqm);
    }
    return v;
}
__device__ __forceinline__ void dsa_query(Frame& F, const Args& A, int l, int qg) {
    const int lane = F.lane, b = qg >> 14, t = qg & (SEQ - 1);
    float* qs = (float*)(F.lds + RING_OFF + F.wave * 5120); v2u* buf = (v2u*)(F.lds + RING_OFF + F.wave * 5120 + 512 + 512);
    const float* aux = (const float*)(F.ws + WS_AUX); const bf16* proj = (const bf16*)(F.ws + WS_PROJ);
    const float* arow = aux + (size_t)qg * AUX_LD;
    qs[lane] = arow[AC_IQ + lane]; qs[64 + lane] = arow[AC_IQ + 64 + lane];
    float wv[4];
#pragma unroll
    for (int i = 0; i < 4; ++i) wv[i] = arow[AC_IW + i] * 0.5f;
    LDS_WAIT(); asm volatile("" ::: "memory");
    int cnt = 0; float thr = -INFINITY;
    const int ntile = (t >> 6) + 1;
    const unsigned long long lt = (1ull << lane) - 1ull;
    for (int tile = 0; tile < ntile; ++tile) {
        const int s = tile * 64 + lane; const bool valid = s <= t; const int sc = valid ? s : t;
        const f32x4* kp = (const f32x4*)(aux + ((size_t)b * SEQ + sc) * AUX_LD + AC_IK);
        f32x4 k[8];
#pragma unroll
        for (int j = 0; j < 8; ++j) k[j] = kp[j];
        float score = 0.f;
#pragma unroll
        for (int i = 0; i < 4; ++i) { float d = 0.f;
#pragma unroll
            for (int j = 0; j < 8; ++j) { const f32x4 q4 = *(const f32x4*)(qs + i * 32 + j * 4); d += q4.x * k[j].x; d += q4.y * k[j].y; d += q4.z * k[j].z; d += q4.w * k[j].w; }
            score += fmaxf(d, 0.f) * 0.17677669529663687f * wv[i]; }
        score += 0.f;
        const bool pass = valid && (score > thr);
        const unsigned long long pm = __ballot(pass);
        if (pass) { v2u x; x.x = f2ord(score); x.y = (unsigned)s; buf[cnt + popc64(pm & lt)] = x; }
        cnt += popc64(pm);
        if (cnt > 512 - 64) { LDS_WAIT(); asm volatile("" ::: "memory"); thr = ord2f(dsa_compact(buf, cnt, lane)); cnt = 256; LDS_WAIT(); asm volatile("" ::: "memory"); }
    }
    LDS_WAIT(); asm volatile("" ::: "memory");
    if (cnt > 256) { dsa_compact(buf, cnt, lane); cnt = 256; LDS_WAIT(); asm volatile("" ::: "memory"); }
    const int hh = lane >> 3, h = hh < 6 ? hh : 5, dp = lane & 7;
    float q8[8];
    { const v4u qw = *(const v4u*)(proj + (size_t)qg * PROJ_LD + PC_DQ + h * 64 + dp * 8);
      q8[0] = bflo(qw.x) * 0.125f; q8[1] = bfhi(qw.x) * 0.125f; q8[2] = bflo(qw.y) * 0.125f; q8[3] = bfhi(qw.y) * 0.125f; q8[4] = bflo(qw.z) * 0.125f; q8[5] = bfhi(qw.z) * 0.125f; q8[6] = bflo(qw.w) * 0.125f; q8[7] = bfhi(qw.w) * 0.125f; }
    const float* rb = A.in[I_RB];
    float m = -INFINITY, lsum = 0.f, o[8];
#pragma unroll
    for (int i = 0; i < 8; ++i) o[i] = 0.f;
    const bf16* kvbase = proj + (size_t)b * SEQ * PROJ_LD + PC_DK + h * 64 + dp * 8;
    for (int j0 = 0; j0 < cnt; j0 += 8) {
        v4u kw[8], vw[8]; int ss[8];
#pragma unroll
        for (int u = 0; u < 8; ++u) { const int j = (j0 + u < cnt) ? j0 + u : cnt - 1; ss[u] = (int)buf[j].y; const bf16* kr = kvbase + (size_t)ss[u] * PROJ_LD; kw[u] = *(const v4u*)kr; vw[u] = *(const v4u*)(kr + 384); }
#pragma unroll
        for (int u = 0; u < 8; ++u) if (j0 + u < cnt) {
            float dot = q8[0] * bflo(kw[u].x) + q8[1] * bfhi(kw[u].x) + q8[2] * bflo(kw[u].y) + q8[3] * bfhi(kw[u].y) + q8[4] * bflo(kw[u].z) + q8[5] * bfhi(kw[u].z) + q8[6] * bflo(kw[u].w) + q8[7] * bfhi(kw[u].w);
            dot += __shfl_xor(dot, 1); dot += __shfl_xor(dot, 2); dot += __shfl_xor(dot, 4);
            const float logit = dot + rb[t5_bucket(t - ss[u]) * 6 + h];
            const float mn = fmaxf(m, logit), sc = expf(m - mn), p = expf(logit - mn);
            lsum = lsum * sc + p; m = mn;
            o[0] = o[0] * sc + p * bflo(vw[u].x); o[1] = o[1] * sc + p * bfhi(vw[u].x); o[2] = o[2] * sc + p * bflo(vw[u].y); o[3] = o[3] * sc + p * bfhi(vw[u].y);
            o[4] = o[4] * sc + p * bflo(vw[u].z); o[5] = o[5] * sc + p * bfhi(vw[u].z); o[6] = o[6] * sc + p * bflo(vw[u].w); o[7] = o[7] * sc + p * bfhi(vw[u].w);
        }
    }
    const float inv = 1.f / lsum;
    if (hh < 6) { v4u w; w.x = pk2(o[0] * inv, o[1] * inv); w.y = pk2(o[2] * inv, o[3] * inv); w.z = pk2(o[4] * inv, o[5] * inv); w.w = pk2(o[6] * inv, o[7] * inv);
        *(v4u*)((bf16*)(F.ws + WS_Y) + (size_t)qg * D + YC_DSA + h * 64 + dp * 8) = w; }
}

__device__ __forceinline__ int wave_suffix_incl(int v, int lane) {
#pragma unroll
    for (int o = 1; o < 64; o <<= 1) { const int t = __shfl_down(v, o); if (lane + o < 64) v += t; }
    return v;
}
__device__ __forceinline__ unsigned dsa_topk_compact(unsigned* cand, unsigned* hist, int n, int lane) {
    unsigned e[16];
#pragma unroll
    for (int j = 0; j < 16; ++j) { const int i = j * 64 + lane; e[j] = i < n ? cand[i] : 0u; }
    unsigned prefix = 0u, pmask = 0u; int k = 256;
#pragma unroll 1
    for (int shift = 24; shift >= 0; shift -= 8) {
        *(v4u*)(hist + 4 * lane) = (v4u){0u, 0u, 0u, 0u};
        LDS_WAIT(); asm volatile("" ::: "memory");
#pragma unroll
        for (int j = 0; j < 16; ++j) if (e[j] != 0u && (e[j] & pmask) == prefix) atomicAdd(&hist[(e[j] >> shift) & 255u], 1u);
        LDS_WAIT(); asm volatile("" ::: "memory");
        const v4u h = *(const v4u*)(hist + 4 * lane);
        const int sl = (int)(h.x + h.y + h.z + h.w);
        const int S = wave_suffix_incl(sl, lane);
        const int L = popc64(__ballot(S >= k)) - 1;
        int B = 0, kn = 0;
        { const int above = S - sl; const int c3 = above + (int)h.w, c2 = c3 + (int)h.z, c1 = c2 + (int)h.y;
          if (c3 >= k) { B = 3; kn = k - above; } else if (c2 >= k) { B = 2; kn = k - c3; } else if (c1 >= k) { B = 1; kn = k - c2; } else { B = 0; kn = k - c1; } }
        B = __builtin_amdgcn_readlane(B + 4 * lane, L); kn = __builtin_amdgcn_readlane(kn, L);
        prefix |= (unsigned)B << shift; pmask |= 255u << shift; k = kn;
        asm volatile("" ::: "memory");
    }
    const unsigned K = prefix; int outp = 0; const unsigned long long lt = (1ull << lane) - 1ull;
#pragma unroll
    for (int j = 0; j < 16; ++j) { const bool keep = e[j] >= K && e[j] != 0u; const unsigned long long km = __ballot(keep); if (keep) cand[outp + popc64(km & lt)] = e[j]; outp += popc64(km); }
    return K;
}
__device__ __forceinline__ void dsa_item(Frame& F, const Args& A, int l, int item) {
    const int lane = F.lane, wave = F.wave, qbase = item * 32, b = qbase >> 14, t0 = qbase & (SEQ - 1), r32 = lane & 31, hi = lane >> 5;
    unsigned* cand = (unsigned*)(F.lds + RING_OFF); unsigned* cnt = (unsigned*)(F.lds + LDS_DCNT); float* thr = (float*)(F.lds + LDS_DTHR); unsigned* hist = (unsigned*)(F.lds + LDS_HIST) + wave * 256;
    const float* aux = (const float*)(F.ws + WS_AUX); const _Float16* KI = (const _Float16*)(F.ws + WS_KI) + (size_t)b * SEQ * 32; const bf16* proj = (const bf16*)(F.ws + WS_PROJ);
    __syncthreads();
    if (F.tid < 32) { cnt[F.tid] = 0u; thr[F.tid] = -INFINITY; }
    h16x8 qb[4][2]; float wv[4];
    { const float* arow = aux + (size_t)(qbase + r32) * AUX_LD;
#pragma unroll
      for (int i = 0; i < 4; ++i) { wv[i] = arow[AC_IW + i] * (0.5f * 0.17677669529663687f);
#pragma unroll
        for (int kh = 0; kh < 2; ++kh) { const f32x4 a0 = *(const f32x4*)(arow + AC_IQ + i * 32 + kh * 16 + hi * 8), a1 = *(const f32x4*)(arow + AC_IQ + i * 32 + kh * 16 + hi * 8 + 4);
            h16x8 v; v[0] = (_Float16)a0[0]; v[1] = (_Float16)a0[1]; v[2] = (_Float16)a0[2]; v[3] = (_Float16)a0[3]; v[4] = (_Float16)a1[0]; v[5] = (_Float16)a1[1]; v[6] = (_Float16)a1[2]; v[7] = (_Float16)a1[3]; qb[i][kh] = v; } } }
    __syncthreads();
    const int ntile = (t0 >> 5) + 1, nround = (ntile + 7) >> 3;
    float th = -INFINITY;
    for (int rd = 0; rd < nround; ++rd) {
        const int j = rd * 8 + wave;
        if (j < ntile) {
            const _Float16* kp = KI + (size_t)(j * 32 + r32) * 32 + hi * 8;
            const h16x8 ka0 = *(const h16x8*)kp, ka1 = *(const h16x8*)(kp + 16);
            f32x16 acc[4];
#pragma unroll
            for (int i = 0; i < 4; ++i) { f32x16 z = {}; z = __builtin_amdgcn_mfma_f32_32x32x16_f16(ka0, qb[i][0], z, 0, 0, 0); acc[i] = __builtin_amdgcn_mfma_f32_32x32x16_f16(ka1, qb[i][1], z, 0, 0, 0); }
            const bool diag = (j == ntile - 1);
            float sc[16]; int n = 0;
#pragma unroll
            for (int r = 0; r < 16; ++r) { float s_ = fmaxf(acc[0][r], 0.f) * wv[0]; s_ += fmaxf(acc[1][r], 0.f) * wv[1]; s_ += fmaxf(acc[2][r], 0.f) * wv[2]; s_ += fmaxf(acc[3][r], 0.f) * wv[3]; s_ += 0.f;
                const int krel = 8 * (r >> 2) + 4 * hi + (r & 3);
                const bool p = (s_ >= th) && (!diag || krel <= r32);
                sc[r] = p ? s_ : -INFINITY; n += p ? 1 : 0; }
            if (n > 0) {
                unsigned slot = atomicAdd(&cnt[r32], (unsigned)n);
                unsigned* cq = cand + r32 * 1024;
#pragma unroll
                for (int r = 0; r < 16; ++r) if (sc[r] != -INFINITY) { const int s = j * 32 + 8 * (r >> 2) + 4 * hi + (r & 3); cq[slot] = (f2ord(sc[r]) & 0xffffc000u) | (unsigned)(16383 - s); ++slot; }
            }
        }
        __syncthreads();
        bool any = false;
#pragma unroll 1
        for (int qi = 0; qi < 4; ++qi) { const int q = wave * 4 + qi; const int n = (int)cnt[q];
            if (n > 768) { const unsigned K = dsa_topk_compact(cand + q * 1024, hist, n, lane); if (lane == 0) { cnt[q] = 256u; thr[q] = ord2f(((K >> 14) + 1u) << 14); } any = true; } }
        __syncthreads();
        th = thr[r32];
    }
#pragma unroll 1
    for (int qi = 0; qi < 4; ++qi) { const int q = wave * 4 + qi; const int n = (int)cnt[q];
        if (n > 256) { dsa_topk_compact(cand + q * 1024, hist, n, lane); if (lane == 0) cnt[q] = 256u; } }
    LDS_WAIT(); asm volatile("" ::: "memory");
    const int hh = lane >> 3, h = hh < 6 ? hh : 5, dp = lane & 7;
    const float* rb = A.in[I_RB];
#pragma unroll 1
    for (int qi = 0; qi < 4; ++qi) {
        const int q = wave * 4 + qi, qg = qbase + q, t = t0 + q; const int n = (int)cnt[q]; const unsigned* cq = cand + q * 1024;
        float q8[8];
        { const v4u qw = *(const v4u*)(proj + (size_t)qg * PROJ_LD + PC_DQ + h * 64 + dp * 8);
          q8[0] = bflo(qw.x) * 0.125f; q8[1] = bfhi(qw.x) * 0.125f; q8[2] = bflo(qw.y) * 0.125f; q8[3] = bfhi(qw.y) * 0.125f; q8[4] = bflo(qw.z) * 0.125f; q8[5] = bfhi(qw.z) * 0.125f; q8[6] = bflo(qw.w) * 0.125f; q8[7] = bfhi(qw.w) * 0.125f; }
        float m = -INFINITY, lsum = 0.f, o[8];
#pragma unroll
        for (int i = 0; i < 8; ++i) o[i] = 0.f;
        const bf16* kvbase = proj + (size_t)b * SEQ * PROJ_LD + PC_DK + h * 64 + dp * 8;
        for (int j0 = 0; j0 < n; j0 += 8) {
            v4u kw[8], vw[8]; int ss[8];
#pragma unroll
            for (int u = 0; u < 8; ++u) { const int j = (j0 + u < n) ? j0 + u : n - 1; ss[u] = 16383 - (int)(cq[j] & 0x3fffu); const bf16* kr = kvbase + (size_t)ss[u] * PROJ_LD; kw[u] = *(const v4u*)kr; vw[u] = *(const v4u*)(kr + 384); }
#pragma unroll
            for (int u = 0; u < 8; ++u) if (j0 + u < n) {
                float dot = q8[0] * bflo(kw[u].x) + q8[1] * bfhi(kw[u].x) + q8[2] * bflo(kw[u].y) + q8[3] * bfhi(kw[u].y) + q8[4] * bflo(kw[u].z) + q8[5] * bfhi(kw[u].z) + q8[6] * bflo(kw[u].w) + q8[7] * bfhi(kw[u].w);
                dot += __shfl_xor(dot, 1); dot += __shfl_xor(dot, 2); dot += __shfl_xor(dot, 4);
                const float logit = dot + rb[t5_bucket(t - ss[u]) * 6 + h];
                const float mn = fmaxf(m, logit), sc_ = expf(m - mn), p = expf(logit - mn);
                lsum = lsum * sc_ + p; m = mn;
                o[0] = o[0] * sc_ + p * bflo(vw[u].x); o[1] = o[1] * sc_ + p * bfhi(vw[u].x); o[2] = o[2] * sc_ + p * bflo(vw[u].y); o[3] = o[3] * sc_ + p * bfhi(vw[u].y);
                o[4] = o[4] * sc_ + p * bflo(vw[u].z); o[5] = o[5] * sc_ + p * bfhi(vw[u].z); o[6] = o[6] * sc_ + p * bflo(vw[u].w); o[7] = o[7] * sc_ + p * bfhi(vw[u].w);
            }
        }
        const float inv = 1.f / lsum;
        if (hh < 6) { v4u w; w.x = pk2(o[0] * inv, o[1] * inv); w.y = pk2(o[2] * inv, o[3] * inv); w.z = pk2(o[4] * inv, o[5] * inv); w.w = pk2(o[6] * inv, o[7] * inv);
            *(v4u*)((bf16*)(F.ws + WS_Y) + (size_t)qg * D + YC_DSA + h * 64 + dp * 8) = w; }
    }
}

constexpr int PH_PER_LAYER = 9, N_PHASES = 1 + DEPTH * PH_PER_LAYER;
__global__ void __launch_bounds__(NTHR, 2) fwd(const Args A) {
    extern __shared__ __attribute__((aligned(16))) unsigned char lds[];
    Frame F;
    F.lds = lds; F.tid = threadIdx.x; F.lane = F.tid & 63; F.wave = __builtin_amdgcn_readfirstlane(F.tid >> 6); F.G = gridDim.x;
    F.out = A.out; F.ws = A.ws;
    LAS unsigned char* lds3 = (LAS unsigned char*)lds;
    for (int u = F.tid; u < (LDS_BYTES - LDSCTL_OFF) / 4; u += NTHR) ((LAS unsigned*)(lds3 + LDSCTL_OFF))[u] = 0u;
    __syncthreads();
    const int lo = A.ph_lo, hi = A.ph_hi;
    XcdBarrier bar; bar.bar = (unsigned*)(F.ws + WS_CTL) + CW_BAR; bar.x = 0; bar.st = nullptr;
    if (hi - lo > 1) bar = xcd_barrier_post((unsigned*)(F.ws + WS_CTL) + CW_BAR, (volatile LAS unsigned*)(lds3 + MISC_OFF) + 8);
#define IN(k) (lo <= (k) && (k) < hi)
#define LAUNDER() do { int tid_ = threadIdx.x; asm volatile("" : "+v"(tid_)); F.tid = tid_; F.lane = tid_ & 63; } while (0)
#define SEAM(k) do { if (IN(k) && IN((k) + 1)) xcd_barrier(bar); } while (0)
    const int gw = blockIdx.x * NWAVES + F.wave, NGW = F.G * NWAVES;
    bf16* XB = (bf16*)(F.ws + WS_XB); bf16* PROJ = (bf16*)(F.ws + WS_PROJ); float* AUX = (float*)(F.ws + WS_AUX); bf16* Y = (bf16*)(F.ws + WS_Y); bf16* H = (bf16*)(F.ws + WS_H);
    float* V1 = (float*)(F.ws + WS_V1); float* V2 = (float*)(F.ws + WS_V2);

    if (IN(0)) { LAUNDER(); p0_prologue(F, A); } SEAM(0);

    for (int l = 0; l < DEPTH; ++l) {
        const int pb = 1 + l * PH_PER_LAYER;
        if (IN(pb + 0)) { LAUNDER();
            pg8::Gemm g{XB, w_ptr(F, l, WO_IN), T, NIN, D}; pg8::StaticOrder S; S.init(T, NIN, F.G, (int)blockIdx.x);
            pg8::EpiInProj E{PROJ, AUX, (_Float16*)(F.ws + WS_KI)};
            pg8::gemm_phase<pg8::EpiInProj, pg8::StaticOrder, true, true>(lds3 + RING_OFF, g, S, E);
        } SEAM(pb + 0);
        if (IN(pb + 1)) { LAUNDER();
            for (int it = blockIdx.x; it < T / 32; it += F.G) dsa_item(F, A, l, T / 32 - 1 - it);
            for (int it = blockIdx.x; it < 1024; it += F.G) lru_item(F, A, l, it, false);
            for (int it = blockIdx.x; it < 3072; it += F.G) gla_item(F, A, l, it, false);
        } SEAM(pb + 1);
        if (IN(pb + 2)) { LAUNDER();
            if (blockIdx.x < 96) gla_scan(F, blockIdx.x * NTHR + F.tid);
            for (int row = gw; row < 512; row += NGW) lru_scan_row(F, row);
        } SEAM(pb + 2);
        if (IN(pb + 3)) { LAUNDER();
            for (int it = blockIdx.x; it < 1024; it += F.G) lru_item(F, A, l, it, true);
            for (int it = blockIdx.x; it < 3072; it += F.G) gla_item(F, A, l, it, true);
            __syncthreads();
        } SEAM(pb + 3);
        if (IN(pb + 4)) { LAUNDER();
            pg8::Gemm g{Y, w_ptr(F, l, WO_OUT), T, D, D}; pg8::StaticOrder S; S.init(T, D, F.G, (int)blockIdx.x);
            pg8::EpiRes E{l == 0 ? A.in[I_X] : F.out, V1, DN_ALPHA};
            pg8::gemm_phase<pg8::EpiRes, pg8::StaticOrder, true, true>(lds3 + RING_OFF, g, S, E);
        } SEAM(pb + 4);
        if (IN(pb + 5)) { LAUNDER(); ln_phase(F, V1, A.in[I_LN1G] + l * D, A.in[I_LN1B] + l * D, F.out, XB); } SEAM(pb + 5);
        if (IN(pb + 6)) { LAUNDER();
            pg8::Gemm g{XB, w_ptr(F, l, WO_GU), T, NGU, D}; pg8::StaticOrder S; S.init(T, NGU, F.G, (int)blockIdx.x);
            pg8::EpiFfnUp E{H};
            pg8::gemm_phase<pg8::EpiFfnUp, pg8::StaticOrder, true, true>(lds3 + RING_OFF, g, S, E);
        } SEAM(pb + 6);
        if (IN(pb + 7)) { LAUNDER();
            pg8::Gemm g{H, w_ptr(F, l, WO_D), T, D, DFF}; pg8::StaticOrder S; S.init(T, D, F.G, (int)blockIdx.x);
            pg8::EpiRes E{F.out, V2, DN_ALPHA};
            pg8::gemm_phase<pg8::EpiRes, pg8::StaticOrder, true, true>(lds3 + RING_OFF, g, S, E);
        } SEAM(pb + 7);
        if (IN(pb + 8)) { LAUNDER(); ln_phase(F, V2, A.in[I_LN2G] + l * D, A.in[I_LN2B] + l * D, F.out, XB); } SEAM(pb + 8);
    }
#undef IN
#undef SEAM
}

extern "C" void kernel_launch(void* const* d_in, const int* in_sizes, int n_in, void* d_out, int out_size, void* d_ws, size_t ws_size, hipStream_t stream) {
    static int grid = 0;
    if (grid == 0) {
        if (n_in != N_INPUTS || in_sizes[0] != T * D || out_size != T * D || ws_size < WS_END) { fprintf(stderr, "kernel_launch: unexpected shapes (n_in %d, in0 %d, out %d, ws %zu, need %zu)\n", n_in, n_in > 0 ? in_sizes[0] : -1, out_size, ws_size, (size_t)WS_END); grid = -1; return; }
        int dev = 0, cus = 0, per_cu = 0;
        if (hipGetDevice(&dev) != hipSuccess || hipDeviceGetAttribute(&cus, hipDeviceAttributeMultiprocessorCount, dev) != hipSuccess) { grid = -1; return; }
        if (hipFuncSetAttribute((const void*)fwd, hipFuncAttributeMaxDynamicSharedMemorySize, LDS_BYTES) != hipSuccess) { fprintf(stderr, "kernel_launch: hipFuncSetAttribute failed\n"); grid = -1; return; }
        if (hipOccupancyMaxActiveBlocksPerMultiprocessor(&per_cu, (const void*)fwd, NTHR, LDS_BYTES) != hipSuccess || per_cu < 1) fprintf(stderr, "kernel_launch: occupancy query reports %d per CU\n", per_cu);
        (void)hipGetLastError();
        grid = cus;
        if (grid != 256) fprintf(stderr, "kernel_launch: %d CUs (expected 256)\n", grid);
    }
    if (grid < 0) return;
    (void)hipMemsetAsync((char*)d_ws + WS_CTL, 0, CTL_ZERO_BYTES, stream);
    Args a{};
    for (int i = 0; i < N_INPUTS; ++i) a.in[i] = (const float*)d_in[i];
    a.out = (float*)d_out; a.ws = (unsigned char*)d_ws;
#if MK_N_LAUNCHES == 1
    a.ph_lo = 0; a.ph_hi = N_PHASES;
    hipLaunchKernelGGL(fwd, dim3(grid), dim3(NTHR), LDS_BYTES, stream, a);
#else
    for (int ph = 0; ph < N_PHASES; ++ph) { a.ph_lo = ph; a.ph_hi = ph + 1; hipLaunchKernelGGL(fwd, dim3(grid), dim3(NTHR), LDS_BYTES, stream, a); }
#endif
}
```

```cpp
#define MK_N_LAUNCHES 1
#include <hip/hip_runtime.h>
#include <cstdio>
#include <cstdint>
#include <cmath>
namespace pg8 {
#define PG8_LAS __attribute__((address_space(3)))
typedef unsigned short bf16_t;
typedef short bf16x8 __attribute__((ext_vector_type(8)));
typedef float f32x4 __attribute__((ext_vector_type(4)));
typedef unsigned u32x4 __attribute__((ext_vector_type(4)));
constexpr int BM = 256, BK = 64, HALF = 128, HTB = HALF * BK * 2  , STAGE_BYTES = 8 * HTB, NXCD = 8, WGM = 8;

__host__ __device__ __forceinline__ int lds_byte(int r, int c) { const int st = (r >> 4) * 2 + (c >> 5), rr = r & 15, cc = c & 31, ob = rr * 64 + cc * 2; return st * 1024 + (ob ^ (((ob >> 9) & 1) << 5)); }
__host__ __device__ __forceinline__ void stage_rc(int b, int& R, int& C) { const int st = b / 1024, sb = b % 1024, swz = sb ^ (((sb >> 9) & 1) << 5); R = (st >> 1) * 16 + swz / 64; C = (st & 1) * 32 + (swz % 64) / 2; }
__host__ __device__ __forceinline__ int perm32(int rho) { const int n = rho >> 4, i = rho & 15; return 8 * (i >> 2) + 4 * n + (i & 3); }

struct Unit { int pm, pn; };
struct Gemm { const bf16_t* A; const bf16_t* Bt; int M, N, K; };

struct StaticOrder {
    int nM, nN, nwg, G, c;
    __host__ __device__ void init(int M, int N, int G_, int c_) { nM = M / BM; nN = N / BM; nwg = nM * nN; G = G_; c = c_; }
    __host__ __device__ bool next(int i, Unit& u) const {
        const long L = (long)i * G + c; if (L >= nwg) return false;
        int wgid = (int)L; { const int q = nwg / NXCD, r = nwg % NXCD, xcd = wgid % NXCD, off = wgid / NXCD; wgid = (xcd < r ? xcd * (q + 1) : r * (q + 1) + (xcd - r) * q) + off; }
        const int nig = WGM * nN, gid = wgid / nig, fm = gid * WGM, gsz = (nM - fm) < WGM ? (nM - fm) : WGM;
        u.pm = fm + ((wgid % nig) % gsz); u.pn = (wgid % nig) / gsz; return true;
    }
    __device__ __forceinline__ void a_ready(const Unit&) const {}
    __device__ __forceinline__ void done(const Unit&) const {}
};

__device__ __forceinline__ unsigned cvt_pk_bf16(float lo, float hi) { unsigned r; asm volatile("v_cvt_pk_bf16_f32 %0, %1, %2" : "=v"(r) : "v"(lo), "v"(hi)); return r; }
typedef float f32x2 __attribute__((ext_vector_type(2)));
constexpr int PROJ_LD = 3328, AUX_LD = 256, DFF = 2816, DM = 1024;
typedef _Float16 h16x8 __attribute__((ext_vector_type(8)));
struct EpiInProj {
    static constexpr bool PERM = true, AFTER_DRAIN = false;
    bf16_t* proj; float* aux; _Float16* ki;
    __device__ __forceinline__ void operator()(const f32x4 (&acc)[2][2][4][2], const Unit& u, int wr, int wc, int fr, int fq) const {
        const int row0 = u.pm * BM + wr * 64 + fr;
        if (u.pn < 13) {
            const int col0 = u.pn * BM + wc * 32 + 8 * fq;
#pragma unroll
            for (int ai = 0; ai < 2; ++ai)
#pragma unroll
                for (int m = 0; m < 4; ++m) { bf16_t* rowp = proj + (size_t)(row0 + ai * HALF + m * 16) * PROJ_LD + col0;
#pragma unroll
                    for (int bj = 0; bj < 2; ++bj) { const f32x4 v0 = acc[ai][bj][m][0], v1 = acc[ai][bj][m][1];
                        u32x4 w; w.x = cvt_pk_bf16(v0[0], v0[1]); w.y = cvt_pk_bf16(v0[2], v0[3]); w.z = cvt_pk_bf16(v1[0], v1[1]); w.w = cvt_pk_bf16(v1[2], v1[3]);
                        *(u32x4*)(rowp + bj * HALF) = w; } }
        } else {
            const int col0 = wc * 32 + 8 * fq;
#pragma unroll
            for (int ai = 0; ai < 2; ++ai)
#pragma unroll
                for (int m = 0; m < 4; ++m) { float* rowp = aux + (size_t)(row0 + ai * HALF + m * 16) * AUX_LD + col0;
#pragma unroll
                    for (int bj = 0; bj < 2; ++bj) { *(f32x4*)(rowp + bj * HALF) = acc[ai][bj][m][0]; *(f32x4*)(rowp + bj * HALF + 4) = acc[ai][bj][m][1];
                        const int cg = col0 + bj * HALF;
                        if (cg >= 144 && cg < 176) { const f32x4 v0 = acc[ai][bj][m][0], v1 = acc[ai][bj][m][1]; h16x8 hv;
                            hv[0] = (_Float16)v0[0]; hv[1] = (_Float16)v0[1]; hv[2] = (_Float16)v0[2]; hv[3] = (_Float16)v0[3]; hv[4] = (_Float16)v1[0]; hv[5] = (_Float16)v1[1]; hv[6] = (_Float16)v1[2]; hv[7] = (_Float16)v1[3];
                            *(h16x8*)(ki + (size_t)(row0 + ai * HALF + m * 16) * 32 + (cg - 144)) = hv; } } }
        }
    }
};
struct EpiFfnUp {
    static constexpr bool PERM = true, AFTER_DRAIN = false;
    bf16_t* H;
    __device__ __forceinline__ void operator()(const f32x4 (&acc)[2][2][4][2], const Unit& u, int wr, int wc, int fr, int fq) const {
        const int row0 = u.pm * BM + wr * 64 + fr, col0 = u.pn * HALF + wc * 32 + 8 * fq;
#pragma unroll
        for (int ai = 0; ai < 2; ++ai)
#pragma unroll
            for (int m = 0; m < 4; ++m) { bf16_t* rowp = H + (size_t)(row0 + ai * HALF + m * 16) * DFF + col0;
                float o[8];
#pragma unroll
                for (int n = 0; n < 2; ++n)
#pragma unroll
                    for (int j = 0; j < 4; ++j) { const float g = acc[ai][0][m][n][j], up = acc[ai][1][m][n][j];
                        const float sg = g * __builtin_amdgcn_rcpf(1.0f + __builtin_amdgcn_exp2f(-1.44269504089f * g)); o[n * 4 + j] = sg * up; }
                u32x4 w; w.x = cvt_pk_bf16(o[0], o[1]); w.y = cvt_pk_bf16(o[2], o[3]); w.z = cvt_pk_bf16(o[4], o[5]); w.w = cvt_pk_bf16(o[6], o[7]);
                *(u32x4*)rowp = w; }
    }
};
struct EpiRes {
    static constexpr bool PERM = false, AFTER_DRAIN = false;
    const float* base; float* out; float alpha;
    __device__ __forceinline__ void operator()(const f32x4 (&acc)[2][2][4][2], const Unit& u, int wr, int wc, int fr, int fq) const {
        const int row0 = u.pm * BM + wr * 64 + fr, col0 = u.pn * BM + wc * 32 + 4 * fq;
#pragma unroll
        for (int ai = 0; ai < 2; ++ai)
#pragma unroll
            for (int m = 0; m < 4; ++m) { const size_t off = (size_t)(row0 + ai * HALF + m * 16) * DM + col0;
#pragma unroll
                for (int bj = 0; bj < 2; ++bj)
#pragma unroll
                    for (int n = 0; n < 2; ++n) { const f32x4 b = *(const f32x4*)(base + off + bj * HALF + n * 16);
                        *(f32x4*)(out + off + bj * HALF + n * 16) = b * alpha + acc[ai][bj][m][n]; } }
    }
};
template <class Epi, class Sched, bool ALIGN_EPI = false, bool SP2 = false>
__device__ __forceinline__ void gemm_phase(PG8_LAS unsigned char* lds, const Gemm g, const Sched& S, const Epi& E, int wave_id) {
    int lane_ = (int)__builtin_amdgcn_mbcnt_hi(~0u, __builtin_amdgcn_mbcnt_lo(~0u, 0u)); asm volatile("" : "+v"(lane_));
    const int wid = wave_id, lane = lane_, tid = wid * 64 + lane, wr = wid >> 2, wc = wid & 3, fr = lane & 15, fq = lane >> 4;
    const int K = g.K, nt = K / BK;
    unsigned voffA[2], voffB[2];
#pragma unroll
    for (int i = 0; i < 2; ++i) { int R, C; stage_rc(tid * 16 + i * 8192, R, C); const int Rb = Epi::PERM ? ((R & ~31) + perm32(R & 31)) : R;
        voffA[i] = (unsigned)(R * K + C) * 2u; voffB[i] = (unsigned)(Rb * K + C) * 2u; }
    const size_t kstep = (size_t)(BK * 2);
    const size_t hstep = (size_t)HALF * K * 2;
    const size_t tstep = 2 * hstep;
    const unsigned ldsw = (unsigned)wid * 1024u;
    const int aoff = lds_byte(wr * 64 + fr, fq * 8), boff = lds_byte(wc * 32 + fr, fq * 8);
#define PG8_SA(b, h) (((b) * 2 + (h)) * HTB)
#define PG8_SB(b, h) ((4 + (b) * 2 + (h)) * HTB)
#define PG8_STAGE(bufoff, gbase, voff) do { _Pragma("unroll") for (int _i = 0; _i < 2; ++_i) \
        __builtin_amdgcn_global_load_lds((const unsigned*)((const char*)(gbase) + (voff)[_i]), (PG8_LAS unsigned*)(lds + (bufoff) + ldsw + _i * 8192), 16, 0, 0); } while (0)
#define PG8_LDA(dst, b, h) do { _Pragma("unroll") for (int m = 0; m < 4; ++m) _Pragma("unroll") for (int k = 0; k < 2; ++k) dst[m][k] = *(const PG8_LAS bf16x8*)(lds + PG8_SA(b, h) + aoff + m * 2048 + k * 1024); } while (0)
#define PG8_LDB(dst, b, h) do { _Pragma("unroll") for (int n = 0; n < 2; ++n) _Pragma("unroll") for (int k = 0; k < 2; ++k) dst[n][k] = *(const PG8_LAS bf16x8*)(lds + PG8_SB(b, h) + boff + n * 2048 + k * 1024); } while (0)
#define PG8_MMA(ai, bj, At, Bt) do { __builtin_amdgcn_s_setprio(1); _Pragma("unroll") for (int m = 0; m < 4; ++m) _Pragma("unroll") for (int n = 0; n < 2; ++n) _Pragma("unroll") for (int k = 0; k < 2; ++k) \
        acc[ai][bj][m][n] = __builtin_amdgcn_mfma_f32_16x16x32_bf16(Bt[n][k], At[m][k], acc[ai][bj][m][n], 0, 0, 0); __builtin_amdgcn_s_setprio(0); } while (0)
#define PG8_WAIT_V(n) asm volatile("s_waitcnt vmcnt(" #n ")" ::: "memory")
#define PG8_WAIT_L(n) asm volatile("s_waitcnt lgkmcnt(" #n ")" ::: "memory")
#define PG8_BAR __builtin_amdgcn_s_barrier()
#define PG8_SCHED __builtin_amdgcn_sched_barrier(0)
    Unit cur, nxt; int ui = 0;
    if (!S.next(0, cur)) return;
    f32x4 acc[2][2][4][2];
#pragma unroll
    for (int a = 0; a < 2; ++a)
#pragma unroll
        for (int b = 0; b < 2; ++b)
#pragma unroll
            for (int m = 0; m < 4; ++m)
#pragma unroll
                for (int n = 0; n < 2; ++n) acc[a][b][m][n] = (f32x4){0.f, 0.f, 0.f, 0.f};
    bf16x8 At[4][2], B0[2][2], B1[2][2];
    const char* cA = (const char*)g.A + (size_t)cur.pm * tstep; const char* cB = (const char*)g.Bt + (size_t)cur.pn * tstep;
    S.a_ready(cur);
    if constexpr (SP2) {
        PG8_STAGE(PG8_SB(0, 0), cB, voffB); PG8_STAGE(PG8_SB(0, 1), cB + hstep, voffB); PG8_STAGE(PG8_SA(0, 0), cA, voffA); PG8_STAGE(PG8_SA(0, 1), cA + hstep, voffA);
        if (wr == 1) PG8_BAR;
        PG8_WAIT_V(2); PG8_BAR;
        PG8_STAGE(PG8_SB(1, 0), cB + kstep, voffB); PG8_STAGE(PG8_SA(1, 0), cA + kstep, voffA); PG8_STAGE(PG8_SB(1, 1), cB + hstep + kstep, voffB);
        PG8_WAIT_V(6); PG8_BAR;
    } else {
        PG8_STAGE(PG8_SB(0, 0), cB, voffB); PG8_STAGE(PG8_SA(0, 0), cA, voffA); PG8_STAGE(PG8_SB(0, 1), cB + hstep, voffB); PG8_STAGE(PG8_SA(0, 1), cA + hstep, voffA);
        if (wr == 1) PG8_BAR;
        PG8_WAIT_V(4); PG8_BAR;
        PG8_STAGE(PG8_SB(1, 0), cB + kstep, voffB); PG8_STAGE(PG8_SA(1, 0), cA + kstep, voffA); PG8_STAGE(PG8_SB(1, 1), cB + hstep + kstep, voffB);
        PG8_WAIT_V(6); PG8_BAR;
    }
    for (;;) {
        const bool has_next = S.next(ui + 1, nxt);
        const char* nA = has_next ? (const char*)g.A + (size_t)nxt.pm * tstep : cA; const char* nB = has_next ? (const char*)g.Bt + (size_t)nxt.pn * tstep : cB;
        for (int t = 0; t < nt; t += 2) {
            const bool last = (t == nt - 2);
            const char* a1 = cA + (size_t)(t + 1) * kstep;
            const char* a2 = last ? nA : cA + (size_t)(t + 2) * kstep; const char* b2 = last ? nB : cB + (size_t)(t + 2) * kstep;
            const char* a3 = a2 + kstep; const char* b3 = b2 + kstep;
            if (last && has_next) S.a_ready(nxt);
            if constexpr (SP2) {
            PG8_LDB(B0, 0, 0); PG8_LDB(B1, 0, 1); PG8_SCHED; PG8_LDA(At, 0, 0); PG8_STAGE(PG8_SA(1, 1), a1 + hstep, voffA);
            PG8_WAIT_V(8); PG8_WAIT_L(0); PG8_BAR; PG8_MMA(0, 0, At, B0); PG8_MMA(0, 1, At, B1); PG8_BAR; PG8_SCHED;
            PG8_LDA(At, 0, 1); PG8_STAGE(PG8_SB(0, 0), b2, voffB); PG8_STAGE(PG8_SB(0, 1), b2 + hstep, voffB); PG8_STAGE(PG8_SA(0, 0), a2, voffA);
            PG8_WAIT_V(8); PG8_WAIT_L(0); PG8_BAR; PG8_MMA(1, 0, At, B0); PG8_MMA(1, 1, At, B1); PG8_BAR; PG8_SCHED;
            PG8_LDB(B0, 1, 0); PG8_LDB(B1, 1, 1); PG8_SCHED; PG8_LDA(At, 1, 0); PG8_STAGE(PG8_SA(0, 1), a2 + hstep, voffA);
            PG8_WAIT_V(8); PG8_WAIT_L(0); PG8_BAR; PG8_MMA(0, 0, At, B0); PG8_MMA(0, 1, At, B1); PG8_BAR; PG8_SCHED;
            PG8_LDA(At, 1, 1); PG8_STAGE(PG8_SB(1, 0), b3, voffB); PG8_STAGE(PG8_SB(1, 1), b3 + hstep, voffB); PG8_STAGE(PG8_SA(1, 0), a3, voffA);
            PG8_WAIT_V(8); PG8_WAIT_L(0); PG8_BAR; PG8_MMA(1, 0, At, B0); PG8_MMA(1, 1, At, B1); PG8_BAR; PG8_SCHED;
            } else {
            PG8_LDB(B0, 0, 0); PG8_SCHED; PG8_LDA(At, 0, 0); PG8_STAGE(PG8_SA(1, 1), a1 + hstep, voffA);
            PG8_WAIT_L(8); PG8_BAR; PG8_WAIT_L(0); PG8_MMA(0, 0, At, B0); PG8_BAR; PG8_SCHED;
            PG8_LDB(B1, 0, 1); PG8_STAGE(PG8_SB(0, 0), b2, voffB);
            PG8_BAR; PG8_WAIT_L(0); PG8_MMA(0, 1, At, B1); PG8_BAR;
            PG8_LDA(At, 0, 1); PG8_STAGE(PG8_SA(0, 0), a2, voffA);
            PG8_BAR; PG8_WAIT_L(0); PG8_MMA(1, 0, At, B0); PG8_BAR; PG8_SCHED;
            PG8_STAGE(PG8_SB(0, 1), b2 + hstep, voffB);
            PG8_WAIT_V(6); PG8_BAR; PG8_MMA(1, 1, At, B1); PG8_BAR;
            PG8_LDB(B0, 1, 0); PG8_SCHED; PG8_LDA(At, 1, 0); PG8_STAGE(PG8_SA(0, 1), a2 + hstep, voffA);
            PG8_WAIT_L(8); PG8_BAR; PG8_WAIT_L(0); PG8_MMA(0, 0, At, B0); PG8_BAR; PG8_SCHED;
            PG8_LDB(B1, 1, 1); PG8_STAGE(PG8_SB(1, 0), b3, voffB);
            PG8_BAR; PG8_WAIT_L(0); PG8_MMA(0, 1, At, B1); PG8_BAR;
            PG8_LDA(At, 1, 1); PG8_STAGE(PG8_SA(1, 0), a3, voffA);
            PG8_BAR; PG8_WAIT_L(0); PG8_MMA(1, 0, At, B0); PG8_BAR; PG8_SCHED;
            PG8_STAGE(PG8_SB(1, 1), b3 + hstep, voffB);
            PG8_WAIT_V(6); PG8_BAR; PG8_MMA(1, 1, At, B1); PG8_BAR;
            }
        }
        if constexpr (ALIGN_EPI) { if (wr == 0) PG8_BAR; }
        if constexpr (!Epi::AFTER_DRAIN) { E(acc, cur, wr, wc, fr, fq); S.done(cur); }
        if (!has_next) break;
#pragma unroll
        for (int a = 0; a < 2; ++a)
#pragma unroll
            for (int b = 0; b < 2; ++b)
#pragma unroll
                for (int m = 0; m < 4; ++m)
#pragma unroll
                    for (int n = 0; n < 2; ++n) acc[a][b][m][n] = (f32x4){0.f, 0.f, 0.f, 0.f};
        cur = nxt; cA = nA; cB = nB; ++ui;
        if constexpr (ALIGN_EPI) { if (wr == 1) PG8_BAR; }
    }
    PG8_WAIT_V(0);
    if constexpr (!ALIGN_EPI) { if (wr == 0) PG8_BAR; }
    PG8_BAR;
    if constexpr (Epi::AFTER_DRAIN) { E.fused(acc, cur, wr, wc, fr, fq, lds, wid, lane); S.done(cur); }
#undef PG8_SA
#undef PG8_SB
#undef PG8_STAGE
#undef PG8_LDA
#undef PG8_LDB
#undef PG8_MMA
#undef PG8_WAIT_V
#undef PG8_WAIT_L
#undef PG8_BAR
#undef PG8_SCHED
}
}

#ifndef MK_N_LAUNCHES
#define MK_N_LAUNCHES 1
#endif
constexpr int NWAVES = 8, NTHR = 512;
constexpr int BATCH = 2, SEQ = 16384, T = BATCH * SEQ, D = 1024, DEPTH = 2, DFF = 2816;
constexpr int NIN = 3584, NGU = 5632, PROJ_LD = 3328, AUX_LD = 256;
constexpr float DN_ALPHA = 1.41421356237309515f, LN_EPS = 1e-5f;
constexpr int PC_LX = 0, PC_LG = 256, PC_GQ = 512, PC_GK = 896, PC_GV = 1280, PC_GG = 1664, PC_DQ = 2048, PC_DK = 2432, PC_DV = 2816;
constexpr int AC_GLR = 0, AC_IQ = 16, AC_IK = 144, AC_IW = 176;
constexpr int YC_LRU = 0, YC_GLA = 256, YC_DSA = 640;
enum { I_X = 0, I_WIN, I_CONVW, I_CONVB, I_WA, I_BA, I_WX, I_BX, I_LAM, I_WG2, I_BG, I_NG, I_RB, I_WOUT, I_LN1G, I_LN1B, I_WFG, I_WFU, I_WFD, I_LN2G, I_LN2B, N_INPUTS };

constexpr size_t MiB = 1u << 20;
constexpr size_t WS_CTL = 0, CTL_ZERO_BYTES = 1 * MiB;
constexpr size_t WS_W = 1 * MiB, W_LAYER = 26 * MiB, WO_IN = 0, WO_OUT = 7 * MiB, WO_GU = 9 * MiB, WO_D = 20 * MiB;
constexpr size_t WS_XB = 54 * MiB, WS_PROJ = 118 * MiB, WS_AUX = 326 * MiB, WS_R2 = 358 * MiB, WS_SEL = 486 * MiB, WS_KI = 502 * MiB, WS_END = 504 * MiB;
constexpr size_t WS_V1 = WS_PROJ, WS_H = WS_PROJ, WS_Y = WS_R2, WS_GLAU = WS_R2 + 64 * MiB, WS_DEC = WS_R2 + 112 * MiB, WS_LSUM = WS_R2 + 113 * MiB, WS_CARRY = WS_R2 + 117 * MiB, WS_V2 = WS_R2, WS_BM = WS_XB;
static_assert(WO_IN + (size_t)NIN * D * 2 <= WO_OUT && WO_OUT + (size_t)D * D * 2 <= WO_GU && WO_GU + (size_t)NGU * D * 2 <= WO_D && WO_D + (size_t)D * DFF * 2 <= W_LAYER, "weight map");
static_assert(WS_W + 2 * W_LAYER <= WS_XB && WS_XB + (size_t)T * D * 2 <= WS_PROJ && WS_PROJ + (size_t)T * PROJ_LD * 2 <= WS_AUX && WS_AUX + (size_t)T * AUX_LD * 4 <= WS_R2, "ws map");
static_assert((size_t)T * DFF * 2 <= WS_AUX - WS_PROJ && (size_t)T * D * 4 <= WS_AUX - WS_PROJ && WS_CARRY + 2 * MiB <= WS_END && (size_t)T * D * 4 <= WS_END - WS_R2, "ws overlays");
constexpr int CW_BAR = 4096;

constexpr int RING_OFF = 0, RING_BYTES = 131072;
constexpr int LDSCTL_OFF = RING_BYTES, MISC_OFF = LDSCTL_OFF + 320;
constexpr int LDS_BYTES = 147456;
constexpr int LDS_DCNT = LDSCTL_OFF + 1024, LDS_DTHR = LDS_DCNT + 128, LDS_HIST = LDSCTL_OFF + 2048;

#define GAS __attribute__((address_space(1)))
#define LAS __attribute__((address_space(3)))
typedef unsigned short bf16;
typedef unsigned v4u __attribute__((ext_vector_type(4)));
typedef unsigned v2u __attribute__((ext_vector_type(2)));
typedef float f32x4 __attribute__((ext_vector_type(4)));
typedef GAS unsigned gu32;
typedef _Float16 h16x8 __attribute__((ext_vector_type(8)));
typedef float f32x16 __attribute__((ext_vector_type(16)));
#define RLX_AGENT __ATOMIC_RELAXED, __HIP_MEMORY_SCOPE_AGENT
#define LDS_WAIT() asm volatile("s_waitcnt lgkmcnt(0)" ::: "memory")
#define VM_WAIT() asm volatile("s_waitcnt vmcnt(0)" ::: "memory")
__device__ __forceinline__ unsigned f2bf(float f) { unsigned u = __builtin_bit_cast(unsigned, f); return (u + 0x7fffu + ((u >> 16) & 1u)) >> 16; }
__device__ __forceinline__ unsigned pk2(float lo, float hi) { return f2bf(lo) | (f2bf(hi) << 16); }
__device__ __forceinline__ float bf2f(unsigned short h) { return __builtin_bit_cast(float, (unsigned)h << 16); }
__device__ __forceinline__ float bflo(unsigned w) { return __builtin_bit_cast(float, w << 16); }
__device__ __forceinline__ float bfhi(unsigned w) { return __builtin_bit_cast(float, w & 0xffff0000u); }

#define XB_TMO      128
#define XB_XCNT(j)  (256  + 64 * (j))
#define XB_XSUB(j)  (1280 + 64 * (j))
#define XB_XGEN(j)  (2304 + 64 * (j))
#define XB_TOP      3328
#define XB_TOPGEN   3392
#define XCD_BAR_WORDS 3456
#define XB_SPIN_CAP (1u << 18)

__device__ __forceinline__ unsigned xb_ld(unsigned* p)              { return __hip_atomic_load(p, __ATOMIC_RELAXED, __HIP_MEMORY_SCOPE_AGENT); }
__device__ __forceinline__ unsigned xb_add(unsigned* p, unsigned v) { return __hip_atomic_fetch_add(p, v, __ATOMIC_RELAXED, __HIP_MEMORY_SCOPE_AGENT); }
__device__ __forceinline__ unsigned xb_xcc_id() { return (unsigned)__builtin_amdgcn_s_getreg((3 << 11) | 20) & 0xFu; }
#define XB_SPIN(cond, bar) do { unsigned _sp = 0; while (cond) { __builtin_amdgcn_s_sleep(1); \
    if ((++_sp & 255u) == 0u) { if (xb_ld(&(bar)[XB_TMO])) break; if (_sp > XB_SPIN_CAP) { atomicAdd(&(bar)[XB_TMO], 1u); break; } } } } while (0)

struct XcdBarrier {
    unsigned* bar; unsigned x;
    volatile LAS unsigned* st;
};

__device__ __forceinline__ XcdBarrier xcd_barrier_post(unsigned* bar, volatile LAS unsigned* st) {
    XcdBarrier b; b.bar = bar; b.x = xb_xcc_id(); b.st = st;
    if (threadIdx.x == 0) (void)xb_add(&bar[XB_XCNT(b.x)], 1u);
    return b;
}
__device__ __forceinline__ void xcd_barrier_complete(unsigned* bar, unsigned x, unsigned& nloc, unsigned& nx) {
    const unsigned G = gridDim.x * gridDim.y * gridDim.z;
    unsigned sum, cnt, mine, sp = 0u;
    for (;;) {
        sum = 0u; cnt = 0u; mine = 0u;
#pragma unroll
        for (unsigned j = 0; j < 16; ++j) { const unsigned c = xb_ld(&bar[XB_XCNT(j)]); sum += c; cnt += (c > 0u) ? 1u : 0u; mine = (j == x) ? c : mine; }
        if (sum == G) break;
        __builtin_amdgcn_s_sleep(1);
        if ((++sp & 255u) == 0u) { if (xb_ld(&bar[XB_TMO])) break; if (sp > XB_SPIN_CAP) { atomicAdd(&bar[XB_TMO], 1u); break; } }
    }
    nloc = mine > 0u ? mine : 1u; nx = cnt > 0u ? cnt : 1u;
}

__device__ __forceinline__ void xcd_barrier(const XcdBarrier& b) {
    asm volatile("s_waitcnt vmcnt(0)" ::: "memory");
    __syncthreads();
    if (threadIdx.x == 0) {
        unsigned* bar = b.bar;
        __builtin_amdgcn_s_waitcnt(0);
        unsigned nloc = b.st[0], nx = b.st[1];
        if (nloc == 0u) { xcd_barrier_complete(bar, b.x, nloc, nx); b.st[0] = nloc; b.st[1] = nx; }
        const unsigned old = xb_add(&bar[XB_XSUB(b.x)], 1u);
        const unsigned gen = old / nloc;
        if (old + 1u == (gen + 1u) * nloc) {
            __builtin_amdgcn_fence(__ATOMIC_RELEASE, "agent");
            asm volatile("s_waitcnt vmcnt(0)" ::: "memory");
            const unsigned og = xb_add(&bar[XB_TOP], 1u);
            const unsigned tg = og / nx;
            if (og + 1u == (tg + 1u) * nx) xb_add(&bar[XB_TOPGEN], 1u);
            else XB_SPIN(xb_ld(&bar[XB_TOPGEN]) == tg, bar);
            __builtin_amdgcn_fence(__ATOMIC_ACQUIRE, "agent");
            xb_add(&bar[XB_XGEN(b.x)], 1u);
            asm volatile("s_waitcnt vmcnt(0)" ::: "memory");
        } else {
            XB_SPIN(xb_ld(&bar[XB_XGEN(b.x)]) == gen, bar);
            __builtin_amdgcn_fence(__ATOMIC_ACQUIRE, "agent");
            asm volatile("s_waitcnt vmcnt(0)" ::: "memory");
        }
    }
    __syncthreads();
}


struct Args { const float* in[N_INPUTS]; float* out; unsigned char* ws; int ph_lo, ph_hi; };
struct Frame {
    unsigned char* lds;
    int tid, lane, wave, G;
    float* out; unsigned char* ws;
};
__device__ __forceinline__ bf16* w_ptr(const Frame& F, int l, size_t off) { return (bf16*)(F.ws + WS_W + (size_t)l * W_LAYER + off); }

__device__ __forceinline__ float wave_sum(float v) {
#pragma unroll
    for (int o = 1; o < 64; o <<= 1) v += __shfl_xor(v, o);
    return v;
}

__device__ __forceinline__ void transpose_item(const float* W, int K, int N, bf16* Wt, float* scr, int kb, int rb, int lane, int sc, float scale = 1.f) {
    const int k0 = 64 * kb, r0 = 32 * rb, rl = lane & 31;
#pragma unroll 8
    for (int i = 0; i < 32; ++i) { const int kk = 2 * i + (lane >> 5); scr[kk * 33 + rl] = sc >= 0 ? W[(size_t)(k0 + kk) * N + sc] * scale : 0.f; }
    LDS_WAIT(); asm volatile("" ::: "memory");
    const int c = lane & 7;
#pragma unroll
    for (int j = 0; j < 4; ++j) { const int n = (lane >> 3) + 8 * j; const float* s = scr + (8 * c) * 33 + n;
        v4u o; o.x = pk2(s[0 * 33], s[1 * 33]); o.y = pk2(s[2 * 33], s[3 * 33]); o.z = pk2(s[4 * 33], s[5 * 33]); o.w = pk2(s[6 * 33], s[7 * 33]);
        *(v4u*)(Wt + (size_t)(r0 + n) * K + k0 + 8 * c) = o; }
    LDS_WAIT(); asm volatile("" ::: "memory");
}
__device__ __forceinline__ int win_src(int r) {
    if (r < 2048) return r;
    if (r < 3200) return r + 16;
    if (r < 3328) return -1;
    if (r < 3344) return 2048 + (r - 3328);
    if (r < 3508) return 3216 + (r - 3344);
    return -1;
}
__device__ __forceinline__ void p0_prologue(Frame& F, const Args& A) {
    float* scr = (float*)(F.lds + RING_OFF + F.wave * 16384);
    const int gw = blockIdx.x * NWAVES + F.wave, NGW = F.G * NWAVES;
    constexpr int I_IN = 16 * (NIN / 32), I_OUT = 16 * (D / 32), I_GU = 16 * (NGU / 32), I_D = (DFF / 64) * (D / 32), I_L = I_IN + I_OUT + I_GU + I_D;
    for (int it = gw; it < DEPTH * I_L; it += NGW) {
        const int l = it / I_L; int r = it % I_L;
        if (r < I_IN) { const int kb = r / (NIN / 32), rb = r % (NIN / 32); const int row_ = rb * 32 + (F.lane & 31);
            transpose_item(A.in[I_WIN] + (size_t)l * D * 3380, D, 3380, w_ptr(F, l, WO_IN), scr, kb, rb, F.lane, win_src(row_), (row_ >= PC_DQ && row_ < PC_DQ + 384) ? 0.125f * 1.4426950408889634f : 1.f); continue; } r -= I_IN;
        if (r < I_OUT) { const int kb = r / (D / 32), rb = r % (D / 32); transpose_item(A.in[I_WOUT] + (size_t)l * D * D, D, D, w_ptr(F, l, WO_OUT), scr, kb, rb, F.lane, rb * 32 + (F.lane & 31)); continue; } r -= I_OUT;
        if (r < I_GU) { const int kb = r / (NGU / 32), rb = r % (NGU / 32); const int row = rb * 32 + (F.lane & 31), tile = row >> 8, w = row & 255; const bool up = w >= 128;
            transpose_item(A.in[up ? I_WFU : I_WFG] + (size_t)l * D * DFF, D, DFF, w_ptr(F, l, WO_GU), scr, kb, rb, F.lane, tile * 128 + (w & 127)); continue; } r -= I_GU;
        { const int kb = r / (D / 32), rb = r % (D / 32); transpose_item(A.in[I_WFD] + (size_t)l * DFF * D, DFF, D, w_ptr(F, l, WO_D), scr, kb, rb, F.lane, rb * 32 + (F.lane & 31)); }
    }
    const float* x = A.in[I_X]; bf16* xb = (bf16*)(F.ws + WS_XB);
    for (int m = gw; m < T; m += NGW) {
        const f32x4* xr = (const f32x4*)(x + (size_t)m * D) + F.lane; unsigned long long* o8 = (unsigned long long*)(xb + (size_t)m * D) + F.lane;
#pragma unroll
        for (int j = 0; j < 4; ++j) { const f32x4 v = xr[64 * j]; o8[64 * j] = (unsigned long long)pk2(v.x, v.y) | ((unsigned long long)pk2(v.z, v.w) << 32); }
    }
}

__device__ __forceinline__ void ln_phase(Frame& F, const float* V, const float* g, const float* b, float* xf, bf16* xb) {
    const int gw = blockIdx.x * NWAVES + F.wave, NGW = F.G * NWAVES;
    f32x4 gv[4], bv[4];
#pragma unroll
    for (int j = 0; j < 4; ++j) { gv[j] = ((const f32x4*)g)[F.lane + 64 * j]; bv[j] = ((const f32x4*)b)[F.lane + 64 * j]; }
    for (int m = gw; m < T; m += NGW) {
        const f32x4* xr = (const f32x4*)(V + (size_t)m * D) + F.lane;
        f32x4 v[4]; float s = 0.f;
#pragma unroll
        for (int j = 0; j < 4; ++j) { v[j] = xr[64 * j]; s += (v[j].x + v[j].y) + (v[j].z + v[j].w); }
        const float mean = wave_sum(s) * (1.f / D); float s2 = 0.f;
#pragma unroll
        for (int j = 0; j < 4; ++j) { v[j] = v[j] - mean; s2 += (v[j].x * v[j].x + v[j].y * v[j].y) + (v[j].z * v[j].z + v[j].w * v[j].w); }
        const float rstd = 1.f / sqrtf(wave_sum(s2) * (1.f / D) + LN_EPS);
        f32x4* of = (f32x4*)(xf + (size_t)m * D) + F.lane; unsigned long long* o8 = (unsigned long long*)(xb + (size_t)m * D) + F.lane;
#pragma unroll
        for (int j = 0; j < 4; ++j) { const f32x4 o = v[j] * rstd * gv[j] + bv[j]; of[64 * j] = o; o8[64 * j] = (unsigned long long)pk2(o.x, o.y) | ((unsigned long long)pk2(o.z, o.w) << 32); }
    }
}

__device__ __forceinline__ float sigmoidf_(float x) { return 1.f / (1.f + expf(-x)); }
__device__ __forceinline__ float gelu_tanh(float x) { const float u = 0.7978845608028654f * (x + 0.044715f * x * x * x); return 0.5f * x * (1.f + tanhf(u)); }
__device__ __forceinline__ void lru_item(Frame& F, const Args& A, int l, int it, bool fin) {
    float* XC = (float*)(F.lds + RING_OFF);
    const bf16* proj = (const bf16*)(F.ws + WS_PROJ);
    const int b = it >> 9, t0 = (it & 511) * 32, c = F.tid & 255, half = F.tid >> 8, ts = t0 + half * 16, ck = ts >> 4;
    const float* cw = A.in[I_CONVW] + (size_t)l * 4 * 256; const float cb = A.in[I_CONVB][l * 256 + c];
    const float w0 = cw[c], w1 = cw[256 + c], w2 = cw[512 + c], w3 = cw[768 + c];
    __syncthreads();
    {
        float xm3 = 0.f, xm2 = 0.f, xm1 = 0.f;
        if (ts >= 3) { xm3 = bf2f(proj[(size_t)(b * SEQ + ts - 3) * PROJ_LD + PC_LX + c]); xm2 = bf2f(proj[(size_t)(b * SEQ + ts - 2) * PROJ_LD + PC_LX + c]); xm1 = bf2f(proj[(size_t)(b * SEQ + ts - 1) * PROJ_LD + PC_LX + c]); }
#pragma unroll 4
        for (int i = 0; i < 16; ++i) { const float x0 = bf2f(proj[(size_t)(b * SEQ + ts + i) * PROJ_LD + PC_LX + c]);
            XC[(half * 16 + i) * 256 + c] = cb + w0 * xm3 + w1 * xm2 + w2 * xm1 + w3 * x0; xm3 = xm2; xm2 = xm1; xm1 = x0; }
    }
    __syncthreads();
    const int n = c >> 6, j = c & 63;
    const float* wa = A.in[I_WA] + (size_t)l * 4 * 64 * 64 + (size_t)n * 64 * 64 + j; const float* wx = A.in[I_WX] + (size_t)l * 4 * 64 * 64 + (size_t)n * 64 * 64 + j;
    const float ba = A.in[I_BA][l * 256 + c], bx = A.in[I_BX][l * 256 + c], lam = A.in[I_LAM][l * 256 + c];
    const float sp8 = -8.f * log1pf(expf(-lam));
    float h = 0.f, P = 1.f;
    if (fin) h = ((const float*)(F.ws + WS_CARRY))[(size_t)(b * 256 + c) * 1024 + ck];
    float rp[16], ip[16];
#pragma unroll
    for (int i = 0; i < 16; ++i) { rp[i] = ba; ip[i] = bx; }
    for (int k = 0; k < 64; ++k) { const float a_ = wa[k * 64], x_ = wx[k * 64];
#pragma unroll
        for (int i = 0; i < 16; ++i) { const float xv = XC[(half * 16 + i) * 256 + n * 64 + k]; rp[i] += xv * a_; ip[i] += xv * x_; } }
    bf16* Y = (bf16*)(F.ws + WS_Y);
#pragma unroll
    for (int i = 0; i < 16; ++i) {
        const float xc = XC[(half * 16 + i) * 256 + c];
        const float r = sigmoidf_(rp[i]), ig = sigmoidf_(ip[i]);
        const float la = sp8 * r, a = expf(la), u = sqrtf(-expm1f(2.f * la)) * (ig * xc);
        h = a * h + u; P *= a;
        if (fin) { const size_t tok = (size_t)(b * SEQ + ts + i); const float g = bf2f(proj[tok * PROJ_LD + PC_LG + c]); Y[tok * D + YC_LRU + c] = (bf16)f2bf(h * gelu_tanh(g)); }
    }
    if (!fin) { float2* S = (float2*)(F.ws + WS_LSUM); S[(size_t)(b * 256 + c) * 1024 + ck] = make_float2(P, h); }
}
__device__ __forceinline__ void lru_scan_row(Frame& F, int row) {
    const float2* S = (const float2*)(F.ws + WS_LSUM) + (size_t)row * 1024 + F.lane * 16; float* C = (float*)(F.ws + WS_CARRY) + (size_t)row * 1024 + F.lane * 16;
    float2 e[16];
#pragma unroll
    for (int i = 0; i < 16; ++i) e[i] = S[i];
    float P = 1.f, h = 0.f;
#pragma unroll
    for (int i = 0; i < 16; ++i) { h = e[i].x * h + e[i].y; P *= e[i].x; }
#pragma unroll
    for (int o = 1; o < 64; o <<= 1) { const float Pp = __shfl_up(P, o), hp = __shfl_up(h, o); if (F.lane >= o) { h = P * hp + h; P = Pp * P; } }
    float hc = __shfl_up(h, 1); if (F.lane == 0) hc = 0.f;
#pragma unroll
    for (int i = 0; i < 16; ++i) { C[i] = hc; hc = e[i].x * hc + e[i].y; }
}

__device__ __forceinline__ void gla_item(Frame& F, const Args& A, int l, int it, bool fin) {
    constexpr int LP = 65;
    float* bc = (float*)(F.lds + RING_OFF); float* qd = bc + 64 * LP; float* ki = qd + 64 * LP; float* ke = ki + 64 * LP; float* vv = ke + 64 * LP; float* att = vv + 64 * LP;
    float* glr = att + 64 * LP; float* w2 = glr + 1024; float* bg = w2 + 1024;
    const int b = it / 1536, r_ = it % 1536, n = r_ / 6, h = r_ % 6; const size_t tok0 = (size_t)b * SEQ + (size_t)n * 64;
    const bf16* proj = (const bf16*)(F.ws + WS_PROJ); const float* aux = (const float*)(F.ws + WS_AUX);
    float* U = (float*)(F.ws + WS_GLAU) + (size_t)it * 4096; float* DEC = (float*)(F.ws + WS_DEC) + (size_t)it * 64;
    const int tid = F.tid;
    __syncthreads();
    for (int i = tid; i < 1024; i += NTHR) { const int c = i >> 4, r = i & 15; glr[i] = aux[(tok0 + c) * AUX_LD + AC_GLR + r]; }
    for (int i = tid; i < 1024; i += NTHR) { const int r = i >> 6, d = i & 63; w2[i] = A.in[I_WG2][(size_t)l * 16 * 384 + r * 384 + h * 64 + d]; }
    if (tid < 64) bg[tid] = A.in[I_BG][l * 384 + h * 64 + tid];
    __syncthreads();
    for (int e = tid; e < 4096; e += NTHR) { const int c = e >> 6, d = e & 63; float z = bg[d];
#pragma unroll
        for (int r = 0; r < 16; ++r) z += glr[c * 16 + r] * w2[r * 64 + d];
        bc[c * LP + d] = (fminf(z, 0.f) - log1pf(expf(-fabsf(z)))) * (1.f / 16.f); }
    __syncthreads();
    if (tid < 64) { float s = 0.f; for (int c = 0; c < 64; ++c) { s += bc[c * LP + tid]; bc[c * LP + tid] = s; } }
    __syncthreads();
    for (int e = tid; e < 4096; e += NTHR) { const int c = e >> 6, d = e & 63; const float b_ = bc[c * LP + d], bl = bc[63 * LP + d];
        const bf16* row = proj + (tok0 + c) * PROJ_LD + h * 64 + d;
        const float q = bf2f(row[PC_GQ]), k = bf2f(row[PC_GK]), v = bf2f(row[PC_GV]);
        qd[c * LP + d] = q * 0.125f * expf(b_); ki[c * LP + d] = k * expf(-b_); ke[c * LP + d] = k * expf(bl - b_); vv[c * LP + d] = v; }
    __syncthreads();
    if (!fin) {
        const int d = tid >> 3, dv0 = (tid & 7) * 8; float acc[8];
#pragma unroll
        for (int j = 0; j < 8; ++j) acc[j] = 0.f;
        for (int c = 0; c < 64; ++c) { const float kd = ke[c * LP + d];
#pragma unroll
            for (int j = 0; j < 8; ++j) acc[j] += kd * vv[c * LP + dv0 + j]; }
#pragma unroll
        for (int j = 0; j < 8; ++j) U[d * 64 + dv0 + j] = acc[j];
        if (tid < 64) DEC[tid] = expf(bc[63 * LP + tid]);
    } else {
        const int c = tid >> 3, s0 = (tid & 7) * 8, dv0 = s0; float a[8];
#pragma unroll
        for (int j = 0; j < 8; ++j) a[j] = 0.f;
        for (int d = 0; d < 64; ++d) { const float qv = qd[c * LP + d];
#pragma unroll
            for (int j = 0; j < 8; ++j) a[j] += qv * ki[(s0 + j) * LP + d]; }
#pragma unroll
        for (int j = 0; j < 8; ++j) att[c * LP + s0 + j] = (s0 + j <= c) ? a[j] : 0.f;
        for (int e = tid; e < 4096; e += NTHR) ke[(e >> 6) * LP + (e & 63)] = U[e];
        __syncthreads();
        float o[8];
#pragma unroll
        for (int j = 0; j < 8; ++j) o[j] = 0.f;
        for (int s = 0; s < 64; ++s) { const float av = att[c * LP + s];
#pragma unroll
            for (int j = 0; j < 8; ++j) o[j] += av * vv[s * LP + dv0 + j]; }
        for (int d = 0; d < 64; ++d) { const float qv = qd[c * LP + d];
#pragma unroll
            for (int j = 0; j < 8; ++j) o[j] += qv * ke[d * LP + dv0 + j]; }
        float ss = 0.f;
#pragma unroll
        for (int j = 0; j < 8; ++j) ss += o[j] * o[j];
        ss += __shfl_xor(ss, 1); ss += __shfl_xor(ss, 2); ss += __shfl_xor(ss, 4);
        const float rs = 1.f / sqrtf(ss * (1.f / 64.f) + 1e-6f);
        const bf16* grow = proj + (tok0 + c) * PROJ_LD + PC_GG + h * 64 + dv0; const float* ng = A.in[I_NG] + l * 384 + h * 64 + dv0;
        float y[8];
#pragma unroll
        for (int j = 0; j < 8; ++j) { const float g = bf2f(grow[j]); y[j] = o[j] * rs * ng[j] * (g / (1.f + expf(-g))); }
        v4u w; w.x = pk2(y[0], y[1]); w.y = pk2(y[2], y[3]); w.z = pk2(y[4], y[5]); w.w = pk2(y[6], y[7]);
        *(v4u*)((bf16*)(F.ws + WS_Y) + (tok0 + c) * D + YC_GLA + h * 64 + dv0) = w;
    }
}
__device__ __forceinline__ void gla_scan(Frame& F, int e) {
    const int bh = e >> 12, idx = e & 4095, d = idx >> 6, b = bh / 6, h = bh % 6;
    float* U = (float*)(F.ws + WS_GLAU); const float* DEC = (const float*)(F.ws + WS_DEC);
    float S = 0.f;
    for (int n0 = 0; n0 < 256; n0 += 8) {
        float u[8], dc[8];
#pragma unroll
        for (int i = 0; i < 8; ++i) { const size_t it = (size_t)b * 1536 + (size_t)(n0 + i) * 6 + h; u[i] = U[it * 4096 + idx]; dc[i] = DEC[it * 64 + d]; }
#pragma unroll
        for (int i = 0; i < 8; ++i) { const size_t it = (size_t)b * 1536 + (size_t)(n0 + i) * 6 + h; U[it * 4096 + idx] = S; S = dc[i] * S + u[i]; }
    }
}

__device__ __forceinline__ unsigned f2ord(float f) { const unsigned u = __builtin_bit_cast(unsigned, f); return u ^ ((u >> 31) ? 0xffffffffu : 0x80000000u); }
__device__ __forceinline__ float ord2f(unsigned v) { const unsigned u = (v & 0x80000000u) ? (v ^ 0x80000000u) : ~v; return __builtin_bit_cast(float, u); }
__device__ __forceinline__ int popc64(unsigned long long m) { return __builtin_popcountll(m); }
__device__ __forceinline__ int t5_bucket(int n) { if (n < 16) return n; const int v = 16 + (int)(__log2f((float)n * (1.f / 16.f)) * (16.f / 3.f)); return v < 31 ? v : 31; }
__device__ __forceinline__ unsigned dsa_compact(v2u* buf, int n, int lane) {
    unsigned o[8], id[8];
#pragma unroll
    for (int j = 0; j < 8; ++j) { const int e = j * 64 + lane; if (e < n) { const v2u x = buf[e]; o[j] = x.x; id[j] = x.y; } else { o[j] = 0u; id[j] = 0u; } }
    unsigned v = 0u;
    for (int bit = 31; bit >= 0; --bit) { const unsigned cand = v | (1u << bit); int c = 0;
#pragma unroll
        for (int j = 0; j < 8; ++j) c += popc64(__ballot(o[j] >= cand));
        if (c >= 256) v = cand; }
    int ngt = 0;
#pragma unroll
    for (int j = 0; j < 8; ++j) ngt += popc64(__ballot(o[j] > v));
    const int need = 256 - ngt; int outp = 0, tie_seen = 0;
    const unsigned long long lt = (1ull << lane) - 1ull;
#pragma unroll
    for (int j = 0; j < 8; ++j) {
        const bool isgt = o[j] > v, iseq = o[j] == v;
        const unsigned long long eqm = __ballot(iseq);
        const bool keep = isgt || (iseq && (tie_seen + popc64(eqm & lt)) < need);
        const unsigned long long km = __ballot(keep);
        if (keep) { v2u x; x.x = o[j]; x.y = id[j]; buf[outp + popc64(km & lt)] = x; }
        outp += popc64(km); tie_seen += popc64(eqm);
    }
    return v;
}
__device__ __forceinline__ void dsa_query(Frame& F, const Args& A, int l, int qg) {
    const int lane = F.lane, b = qg >> 14, t = qg & (SEQ - 1);
    float* qs = (float*)(F.lds + RING_OFF + F.wave * 5120); v2u* buf = (v2u*)(F.lds + RING_OFF + F.wave * 5120 + 512 + 512);
    const float* aux = (const float*)(F.ws + WS_AUX); const bf16* proj = (const bf16*)(F.ws + WS_PROJ);
    const float* arow = aux + (size_t)qg * AUX_LD;
    qs[lane] = arow[AC_IQ + lane]; qs[64 + lane] = arow[AC_IQ + 64 + lane];
    float wv[4];
#pragma unroll
    for (int i = 0; i < 4; ++i) wv[i] = arow[AC_IW + i] * 0.5f;
    LDS_WAIT(); asm volatile("" ::: "memory");
    int cnt = 0; float thr = -INFINITY;
    const int ntile = (t >> 6) + 1;
    const unsigned long long lt = (1ull << lane) - 1ull;
    for (int tile = 0; tile < ntile; ++tile) {
        const int s = tile * 64 + lane; const bool valid = s <= t; const int sc = valid ? s : t;
        const f32x4* kp = (const f32x4*)(aux + ((size_t)b * SEQ + sc) * AUX_LD + AC_IK);
        f32x4 k[8];
#pragma unroll
        for (int j = 0; j < 8; ++j) k[j] = kp[j];
        float score = 0.f;
#pragma unroll
        for (int i = 0; i < 4; ++i) { float d = 0.f;
#pragma unroll
            for (int j = 0; j < 8; ++j) { const f32x4 q4 = *(const f32x4*)(qs + i * 32 + j * 4); d += q4.x * k[j].x; d += q4.y * k[j].y; d += q4.z * k[j].z; d += q4.w * k[j].w; }
            score += fmaxf(d, 0.f) * 0.17677669529663687f * wv[i]; }
        score += 0.f;
        const bool pass = valid && (score > thr);
        const unsigned long long pm = __ballot(pass);
        if (pass) { v2u x; x.x = f2ord(score); x.y = (unsigned)s; buf[cnt + popc64(pm & lt)] = x; }
        cnt += popc64(pm);
        if (cnt > 512 - 64) { LDS_WAIT(); asm volatile("" ::: "memory"); thr = ord2f(dsa_compact(buf, cnt, lane)); cnt = 256; LDS_WAIT(); asm volatile("" ::: "memory"); }
    }
    LDS_WAIT(); asm volatile("" ::: "memory");
    if (cnt > 256) { dsa_compact(buf, cnt, lane); cnt = 256; LDS_WAIT(); asm volatile("" ::: "memory"); }
    const int hh = lane >> 3, h = hh < 6 ? hh : 5, dp = lane & 7;
    float q8[8];
    { const v4u qw = *(const v4u*)(proj + (size_t)qg * PROJ_LD + PC_DQ + h * 64 + dp * 8);
      q8[0] = bflo(qw.x) * 0.125f; q8[1] = bfhi(qw.x) * 0.125f; q8[2] = bflo(qw.y) * 0.125f; q8[3] = bfhi(qw.y) * 0.125f; q8[4] = bflo(qw.z) * 0.125f; q8[5] = bfhi(qw.z) * 0.125f; q8[6] = bflo(qw.w) * 0.125f; q8[7] = bfhi(qw.w) * 0.125f; }
    const float* rb = A.in[I_RB];
    float m = -INFINITY, lsum = 0.f, o[8];
#pragma unroll
    for (int i = 0; i < 8; ++i) o[i] = 0.f;
    const bf16* kvbase = proj + (size_t)b * SEQ * PROJ_LD + PC_DK + h * 64 + dp * 8;
    for (int j0 = 0; j0 < cnt; j0 += 8) {
        v4u kw[8], vw[8]; int ss[8];
#pragma unroll
        for (int u = 0; u < 8; ++u) { const int j = (j0 + u < cnt) ? j0 + u : cnt - 1; ss[u] = (int)buf[j].y; const bf16* kr = kvbase + (size_t)ss[u] * PROJ_LD; kw[u] = *(const v4u*)kr; vw[u] = *(const v4u*)(kr + 384); }
#pragma unroll
        for (int u = 0; u < 8; ++u) if (j0 + u < cnt) {
            float dot = q8[0] * bflo(kw[u].x) + q8[1] * bfhi(kw[u].x) + q8[2] * bflo(kw[u].y) + q8[3] * bfhi(kw[u].y) + q8[4] * bflo(kw[u].z) + q8[5] * bfhi(kw[u].z) + q8[6] * bflo(kw[u].w) + q8[7] * bfhi(kw[u].w);
            dot += __shfl_xor(dot, 1); dot += __shfl_xor(dot, 2); dot += __shfl_xor(dot, 4);
            const float logit = dot + rb[t5_bucket(t - ss[u]) * 6 + h];
            const float mn = fmaxf(m, logit), sc = expf(m - mn), p = expf(logit - mn);
            lsum = lsum * sc + p; m = mn;
            o[0] = o[0] * sc + p * bflo(vw[u].x); o[1] = o[1] * sc + p * bfhi(vw[u].x); o[2] = o[2] * sc + p * bflo(vw[u].y); o[3] = o[3] * sc + p * bfhi(vw[u].y);
            o[4] = o[4] * sc + p * bflo(vw[u].z); o[5] = o[5] * sc + p * bfhi(vw[u].z); o[6] = o[6] * sc + p * bflo(vw[u].w); o[7] = o[7] * sc + p * bfhi(vw[u].w);
        }
    }
    const float inv = 1.f / lsum;
    if (hh < 6) { v4u w; w.x = pk2(o[0] * inv, o[1] * inv); w.y = pk2(o[2] * inv, o[3] * inv); w.z = pk2(o[4] * inv, o[5] * inv); w.w = pk2(o[6] * inv, o[7] * inv);
        *(v4u*)((bf16*)(F.ws + WS_Y) + (size_t)qg * D + YC_DSA + h * 64 + dp * 8) = w; }
}

__device__ __forceinline__ int wave_suffix_incl(int v, int lane) {
#pragma unroll
    for (int o = 1; o < 64; o <<= 1) { const int t = __shfl_down(v, o); if (lane + o < 64) v += t; }
    return v;
}
__device__ __forceinline__ unsigned dsa_topk_compact(unsigned* cand, unsigned* hist, int n, int lane) {
    unsigned e[16];
#pragma unroll
    for (int j = 0; j < 16; ++j) { const int i = j * 64 + lane; e[j] = i < n ? cand[i] : 0u; }
    unsigned prefix = 0u, pmask = 0u; int k = 256;
#pragma unroll 1
    for (int shift = 24; shift >= 0; shift -= 8) {
        *(v4u*)(hist + 4 * lane) = (v4u){0u, 0u, 0u, 0u};
        LDS_WAIT(); asm volatile("" ::: "memory");
#pragma unroll
        for (int j = 0; j < 16; ++j) if (e[j] != 0u && (e[j] & pmask) == prefix) atomicAdd(&hist[(e[j] >> shift) & 255u], 1u);
        LDS_WAIT(); asm volatile("" ::: "memory");
        const v4u h = *(const v4u*)(hist + 4 * lane);
        const int sl = (int)(h.x + h.y + h.z + h.w);
        const int S = wave_suffix_incl(sl, lane);
        const int L = popc64(__ballot(S >= k)) - 1;
        int B = 0, kn = 0;
        { const int above = S - sl; const int c3 = above + (int)h.w, c2 = c3 + (int)h.z, c1 = c2 + (int)h.y;
          if (c3 >= k) { B = 3; kn = k - above; } else if (c2 >= k) { B = 2; kn = k - c3; } else if (c1 >= k) { B = 1; kn = k - c2; } else { B = 0; kn = k - c1; } }
        B = __builtin_amdgcn_readlane(B + 4 * lane, L); kn = __builtin_amdgcn_readlane(kn, L);
        prefix |= (unsigned)B << shift; pmask |= 255u << shift; k = kn;
        asm volatile("" ::: "memory");
    }
    const unsigned K = prefix; int outp = 0; const unsigned long long lt = (1ull << lane) - 1ull;
#pragma unroll
    for (int j = 0; j < 16; ++j) { const bool keep = e[j] >= K && e[j] != 0u; const unsigned long long km = __ballot(keep); if (keep) cand[outp + popc64(km & lt)] = e[j]; outp += popc64(km); }
    return K;
}
__device__ __forceinline__ void dsa_item(Frame& F, const Args& A, int l, int item) {
    const int lane = F.lane, wave = F.wave, qbase = item * 32, b = qbase >> 14, t0 = qbase & (SEQ - 1), r32 = lane & 31, hi = lane >> 5;
    unsigned* cand = (unsigned*)(F.lds + RING_OFF); unsigned* cnt = (unsigned*)(F.lds + LDS_DCNT); float* thr = (float*)(F.lds + LDS_DTHR); unsigned* hist = (unsigned*)(F.lds + LDS_HIST) + wave * 256;
    const float* aux = (const float*)(F.ws + WS_AUX); const _Float16* KI = (const _Float16*)(F.ws + WS_KI) + (size_t)b * SEQ * 32; const bf16* proj = (const bf16*)(F.ws + WS_PROJ);
    __syncthreads();
    if (F.tid < 32) { cnt[F.tid] = 0u; thr[F.tid] = -INFINITY; }
    h16x8 qb[4][2]; float wv[4];
    { const float* arow = aux + (size_t)(qbase + r32) * AUX_LD;
#pragma unroll
      for (int i = 0; i < 4; ++i) { wv[i] = arow[AC_IW + i] * (0.5f * 0.17677669529663687f);
#pragma unroll
        for (int kh = 0; kh < 2; ++kh) { const f32x4 a0 = *(const f32x4*)(arow + AC_IQ + i * 32 + kh * 16 + hi * 8), a1 = *(const f32x4*)(arow + AC_IQ + i * 32 + kh * 16 + hi * 8 + 4);
            h16x8 v; v[0] = (_Float16)a0[0]; v[1] = (_Float16)a0[1]; v[2] = (_Float16)a0[2]; v[3] = (_Float16)a0[3]; v[4] = (_Float16)a1[0]; v[5] = (_Float16)a1[1]; v[6] = (_Float16)a1[2]; v[7] = (_Float16)a1[3]; qb[i][kh] = v; } } }
    __syncthreads();
    const int ntile = (t0 >> 5) + 1, nround = (ntile + 7) >> 3;
    float th = -INFINITY;
    for (int rd = 0; rd < nround; ++rd) {
        const int j = rd * 8 + wave;
        if (j < ntile) {
            const _Float16* kp = KI + (size_t)(j * 32 + r32) * 32 + hi * 8;
            const h16x8 ka0 = *(const h16x8*)kp, ka1 = *(const h16x8*)(kp + 16);
            f32x16 acc[4];
#pragma unroll
            for (int i = 0; i < 4; ++i) { f32x16 z = {}; z = __builtin_amdgcn_mfma_f32_32x32x16_f16(ka0, qb[i][0], z, 0, 0, 0); acc[i] = __builtin_amdgcn_mfma_f32_32x32x16_f16(ka1, qb[i][1], z, 0, 0, 0); }
            const bool diag = (j == ntile - 1);
            float sc[16]; int n = 0;
#pragma unroll
            for (int r = 0; r < 16; ++r) { float s_ = fmaxf(acc[0][r], 0.f) * wv[0]; s_ += fmaxf(acc[1][r], 0.f) * wv[1]; s_ += fmaxf(acc[2][r], 0.f) * wv[2]; s_ += fmaxf(acc[3][r], 0.f) * wv[3]; s_ += 0.f;
                const int krel = 8 * (r >> 2) + 4 * hi + (r & 3);
                const bool p = (s_ >= th) && (!diag || krel <= r32);
                sc[r] = p ? s_ : -INFINITY; n += p ? 1 : 0; }
            if (n > 0) {
                unsigned slot = atomicAdd(&cnt[r32], (unsigned)n);
                unsigned* cq = cand + r32 * 1024;
#pragma unroll
                for (int r = 0; r < 16; ++r) if (sc[r] != -INFINITY) { const int s = j * 32 + 8 * (r >> 2) + 4 * hi + (r & 3); cq[slot] = (f2ord(sc[r]) & 0xffffc000u) | (unsigned)(16383 - s); ++slot; }
            }
        }
        __syncthreads();
        bool any = false;
#pragma unroll 1
        for (int qi = 0; qi < 4; ++qi) { const int q = wave * 4 + qi; const int n = (int)cnt[q];
            if (n > 768) { const unsigned K = dsa_topk_compact(cand + q * 1024, hist, n, lane); if (lane == 0) { cnt[q] = 256u; thr[q] = ord2f(((K >> 14) + 1u) << 14); } any = true; } }
        __syncthreads();
        th = thr[r32];
    }
#pragma unroll 1
    for (int qi = 0; qi < 4; ++qi) { const int q = wave * 4 + qi; const int n = (int)cnt[q];
        if (n > 256) { dsa_topk_compact(cand + q * 1024, hist, n, lane); if (lane == 0) cnt[q] = 256u; } }
    LDS_WAIT(); asm volatile("" ::: "memory");
#ifndef NO_BMTAIL
#pragma unroll 1
    for (int qi = 0; qi < 4; ++qi) {
        const int q = wave * 4 + qi; const int n = (int)cnt[q]; unsigned* cq = cand + q * 1024; unsigned* bm = cq + 512;
        *(v4u*)(bm + 8 * lane) = (v4u){0u, 0u, 0u, 0u}; *(v4u*)(bm + 8 * lane + 4) = (v4u){0u, 0u, 0u, 0u};
        LDS_WAIT(); asm volatile("" ::: "memory");
#pragma unroll
        for (int j = 0; j < 4; ++j) { const int e = j * 64 + lane; if (e < n) { const unsigned s = 16383u - (cq[e] & 0x3fffu); atomicOr(&bm[s >> 5], 1u << (s & 31u)); } }
    }
    __syncthreads();
    { unsigned* BM = (unsigned*)(F.ws + WS_BM); const int ntp = 2 * ((t0 >> 8) + 1), qbg = qbase >> 8, ql0 = qbase & 255;
      for (int idx = F.tid; idx < ntp * 32; idx += NTHR) { const int q = idx & 31, tp = idx >> 5;
          const v4u w = *(const v4u*)(cand + q * 1024 + 512 + tp * 4);
          *(v4u*)(BM + (((size_t)qbg * 128 + tp) * 256 + ql0 + q) * 4) = w; } }
#endif
}
#include <hip/hip_bf16.h>
#include <cmath>
namespace attn_body {
using bf16=__hip_bfloat16;
using bf16x8=__attribute__((ext_vector_type(8)))short;
using s16x4=__attribute__((ext_vector_type(4)))short;
using f32x16=__attribute__((ext_vector_type(16)))float;
using u32x4=__attribute__((ext_vector_type(4)))unsigned;
constexpr int BATCH=2,NHEAD=6,SEQ=16384,D=64,QP=3328,OP=1024;
constexpr int NW=8,QBLK=32,QB=QBLK*NW,KVBLK=64,NQB=SEQ/QB;
constexpr int ATTN_UNIT_ROWS=QB;
__device__ __forceinline__ int crow(int r,int hi){return (r&3)+8*(r>>2)+4*hi;}
#define SBAR() __builtin_amdgcn_sched_barrier(0)
__device__ __forceinline__ void cmask(f32x16&p0,f32x16&p1,int jb,int qrel,int hi){
  const float NEG=-INFINITY; int kb=64*jb+4*hi;
  #pragma unroll
  for(int r=0;r<16;++r){int kv=kb+(r&3)+8*(r>>2); if(kv>qrel)p0[r]=NEG; if(kv+32>qrel)p1[r]=NEG;}
}

constexpr int NSLOT=3, SLOTB=8192;
constexpr int LDS_K=0, LDS_V=NSLOT*SLOTB, LDS_WS=2*NSLOT*SLOTB, LDS_OST=LDS_WS+NW*64*4, LDS_BT=LDS_OST+NW*4096, LDS_MK=LDS_BT+1024, LDS_BYTES=LDS_MK+2*4096;
constexpr float C2=0.125f*1.4426950408889634f;
__device__ __forceinline__ void glds16(const void*gsrc,unsigned lds_dst){unsigned keep;
  asm volatile("s_mov_b32 %0, m0\n\ts_mov_b32 m0, %2\n\ts_nop 0\n\tglobal_load_lds_dwordx4 %1, off\n\ts_mov_b32 m0, %0":"=&s"(keep):"v"(gsrc),"s"(lds_dst):"memory");}
__device__ __forceinline__ float max3f(float a,float b,float c){float r;asm("v_max3_f32 %0, %1, %2, %3":"=v"(r):"v"(a),"v"(b),"v"(c));return r;}
__device__ __forceinline__ float max2f(float a,float b){float r;asm("v_max_f32_e32 %0, %1, %2":"=v"(r):"v"(a),"v"(b));return r;}
__device__ __forceinline__ float fadd_s(float a,float b){float r;asm("v_add_f32_e32 %0, %1, %2":"=v"(r):"v"(a),"v"(b));return r;}
__device__ __forceinline__ float fsub_s(float a,float b){float r;asm("v_sub_f32_e32 %0, %1, %2":"=v"(r):"v"(a),"v"(b));return r;}
typedef float f32x2_t __attribute__((ext_vector_type(2))); typedef __bf16 bf16x2_t __attribute__((ext_vector_type(2)));
__device__ __forceinline__ unsigned cvtpk_s(float lo,float hi){f32x2_t v={lo,hi};bf16x2_t b=__builtin_convertvector(v,bf16x2_t);return __builtin_bit_cast(unsigned,b);}
__device__ __forceinline__ void glds16s(unsigned voff,const void*sbase,unsigned lds_dst){unsigned keep;
  asm volatile("s_nop 4\n\ts_mov_b32 %0, m0\n\ts_mov_b32 m0, %3\n\ts_nop 0\n\tglobal_load_lds_dwordx4 %1, %2\n\ts_mov_b32 m0, %0":"=&s"(keep):"v"(voff),"s"(sbase),"s"(lds_dst):"memory");}
#define WAIT_BAR(N) asm volatile("s_waitcnt vmcnt(" #N ") lgkmcnt(0)\n\ts_barrier":::"memory")

__device__ __forceinline__ void qkt(f32x16&p0,f32x16&p1,const char*Kslot,const bf16x8*qr,const f32x16&negm,int r32,int hi){
  const char*kb=Kslot+hi*1024+r32*16;
  #pragma unroll
  for(int d0=0;d0<4;++d0){
    const bf16x8 b0=*reinterpret_cast<const bf16x8*>(kb+d0*2048);
    const bf16x8 b1=*reinterpret_cast<const bf16x8*>(kb+d0*2048+512);
    if(d0==0){p0=__builtin_amdgcn_mfma_f32_32x32x16_bf16(b0,qr[0],negm,0,0,0);p1=__builtin_amdgcn_mfma_f32_32x32x16_bf16(b1,qr[0],negm,0,0,0);}
    else{p0=__builtin_amdgcn_mfma_f32_32x32x16_bf16(b0,qr[d0],p0,0,0,0);p1=__builtin_amdgcn_mfma_f32_32x32x16_bf16(b1,qr[d0],p1,0,0,0);}}
}
typedef __attribute__((address_space(3))) const char* lds_cptr;
typedef short v4i16_t __attribute__((ext_vector_type(4)));
__device__ __forceinline__ void kload8(bf16x8*kf,lds_cptr kp){
  kf[0]=*(const __attribute__((address_space(3))) bf16x8*)(kp);      kf[1]=*(const __attribute__((address_space(3))) bf16x8*)(kp+512);
  kf[2]=*(const __attribute__((address_space(3))) bf16x8*)(kp+2048); kf[3]=*(const __attribute__((address_space(3))) bf16x8*)(kp+2560);
  kf[4]=*(const __attribute__((address_space(3))) bf16x8*)(kp+4096); kf[5]=*(const __attribute__((address_space(3))) bf16x8*)(kp+4608);
  kf[6]=*(const __attribute__((address_space(3))) bf16x8*)(kp+6144); kf[7]=*(const __attribute__((address_space(3))) bf16x8*)(kp+6656);
}
__device__ __forceinline__ void kload2(bf16x8*kf,lds_cptr kp,int j){ kf[2*j]=*(const __attribute__((address_space(3))) bf16x8*)(kp+j*2048); kf[2*j+1]=*(const __attribute__((address_space(3))) bf16x8*)(kp+j*2048+512); }
__device__ __forceinline__ s16x4 vtr(lds_cptr p){ return __builtin_bit_cast(s16x4,__builtin_amdgcn_ds_read_tr16_b64_v4i16((__attribute__((address_space(3))) v4i16_t*)p)); }
__device__ __forceinline__ float rowmax(const f32x16&p0,const f32x16&p1){
  float a=max3f(p0[0],p0[1],p1[0]),b=max3f(p0[2],p0[3],p1[1]);a=max3f(a,p1[2],p1[3]);
  #pragma unroll
  for(int r=4;r<16;r+=4){a=max3f(a,p0[r],p0[r+1]);b=max3f(b,p0[r+2],p0[r+3]);a=max3f(a,p1[r],p1[r+1]);b=max3f(b,p1[r+2],p1[r+3]);}
  const float m=max2f(a,b);
  auto rr=__builtin_amdgcn_permlane32_swap(__float_as_uint(m),__float_as_uint(m),false,false);
  return max2f(__uint_as_float(rr[0]),__uint_as_float(rr[1]));
}
__device__ __forceinline__ void pv(f32x16*o,int vb,bf16x8 pa0,bf16x8 pa1,bf16x8 pa2,bf16x8 pa3){
  #pragma unroll
  for(int d0=0;d0<2;++d0){s16x4 lo[4],hi[4];
    #pragma unroll
    for(int ks=0;ks<4;++ks){
      asm volatile("ds_read_b64_tr_b16 %0,%1 offset:%c2":"=&v"(lo[ks]):"v"(vb),"i"(d0*4096+ks*1024):"memory");
      asm volatile("ds_read_b64_tr_b16 %0,%1 offset:%c2":"=&v"(hi[ks]):"v"(vb),"i"(d0*4096+ks*1024+512):"memory");}
    asm volatile("s_waitcnt lgkmcnt(0)":::"memory");SBAR();
    #define PK(k) (bf16x8){lo[k][0],lo[k][1],lo[k][2],lo[k][3],hi[k][0],hi[k][1],hi[k][2],hi[k][3]}
    o[d0]=__builtin_amdgcn_mfma_f32_32x32x16_bf16(pa0,PK(0),o[d0],0,0,0);
    o[d0]=__builtin_amdgcn_mfma_f32_32x32x16_bf16(pa1,PK(1),o[d0],0,0,0);
    o[d0]=__builtin_amdgcn_mfma_f32_32x32x16_bf16(pa2,PK(2),o[d0],0,0,0);
    o[d0]=__builtin_amdgcn_mfma_f32_32x32x16_bf16(pa3,PK(3),o[d0],0,0,0);
    #undef PK
  }
}

#ifndef ATTN_STORE16
#define ATTN_STORE16(p,v) (*(u32x4*)(p)=(v))
#endif
template<int THRL> __device__ __forceinline__ void attn_unit(int wave_id,int b,int h,int qb,const bf16*Q,const bf16*__restrict__ K,const bf16*__restrict__ V,bf16*O,const unsigned*__restrict__ BM,const float*__restrict__ rb,char*shm){
  int lane_=(int)__builtin_amdgcn_mbcnt_hi(~0u,__builtin_amdgcn_mbcnt_lo(~0u,0u)); asm volatile("":"+v"(lane_)); const int wid=wave_id,lane=lane_,tid=wid*64+lane,r32=lane&31,hi=lane>>5;
  const long rowbase=(long)b*SEQ; const int q0=qb*QB;
  const bf16*Qw=Q+(rowbase+q0+wid*QBLK)*QP+h*D;
  const bf16*Kh=K+rowbase*QP+h*D,*Vh=V+rowbase*QP+h*D;
  const unsigned lds0=(unsigned)(uintptr_t)shm;
  float*wsf=(float*)(shm+LDS_WS)+wid*64;
  const unsigned koff=(unsigned)(lane*QP+wid*8)*2u;
  const unsigned voff=(unsigned)((16*(wid&3)+(lane>>2))*QP+(wid>>2)*32+(lane&3)*8)*2u;
  const unsigned kdst=lds0+LDS_K+wid*1024, vdst=lds0+LDS_V+wid*1024;
  #define DMA_K(t,slot) glds16s(koff,Kh+(long)(t)*KVBLK*QP,(unsigned)__builtin_amdgcn_readfirstlane(kdst+(slot)))
  #define DMA_V(t,slot) glds16s(voff,Vh+(long)(t)*KVBLK*QP,(unsigned)__builtin_amdgcn_readfirstlane(vdst+(slot)))
  const int vb0=(int)(lds0+LDS_V)+((lane>>4)&1)*32+(lane&3)*8+(4*hi+((lane&15)>>2))*64;
  const char*Kbase=shm+LDS_K; bf16x8 kf[8];
  const lds_cptr shm3=(lds_cptr)shm; const lds_cptr kp0=shm3+LDS_K+hi*1024+r32*16; const lds_cptr vp0=shm3+LDS_V+((lane>>4)&1)*32+(lane&3)*8+(4*hi+((lane&15)>>2))*64;
  const int NT=(q0+QB)/KVBLK;
  const unsigned* mbase=BM+((size_t)(b*(SEQ/QB)+qb)*(SEQ/128))*QB*4;
  const unsigned mdst=lds0+LDS_MK+(wid&3)*1024;
  #define DMA_M(e) do{ if(wid<4) glds16s((unsigned)(((wid&3)*64+lane)*16),mbase+(size_t)((e)>>1)*QB*4,(unsigned)__builtin_amdgcn_readfirstlane(mdst+(((e)>>1)&1)*4096)); }while(0)
  const float cfar=rb[31*NHEAD+h]*1.4426950408889634f;
  { float*bt=(float*)(shm+LDS_BT); if(tid<128){ int n=tid; int bk=n<16?n:(16+(int)(__log2f((float)n*(1.f/16.f))*(16.f/3.f))); bk=bk<31?bk:31; bt[tid]=rb[bk*NHEAD+h]*1.4426950408889634f-cfar; } if(tid==128)bt[128]=0.f; }
  DMA_M(0); if(NT>2){DMA_M(2);}
  DMA_K(0,0);DMA_V(0,0);DMA_K(1,SLOTB);
  bf16x8 qr[4];
  #pragma unroll
  for(int d0=0;d0<4;++d0)qr[d0]=*reinterpret_cast<const bf16x8*>(&Qw[(long)r32*QP+d0*16+hi*8]);
  float mhat=0.f,l_reg=0.f;f32x16 o[2];o[0]=f32x16{};o[1]=f32x16{};float cm=cfar; const f32x16 zc=f32x16{};
  const int qrel=wid*QBLK+r32;
  const __attribute__((address_space(3))) float*btab=(const __attribute__((address_space(3))) float*)((lds_cptr)shm+LDS_BT);
  #define MASKB(P0,P1,t) do{ const lds_cptr mp_=(lds_cptr)shm+(LDS_MK+(wid*QBLK+r32)*16+(((t)>>1)&1)*4096+((t)&1)*8); const unsigned mx_=*(const __attribute__((address_space(3))) unsigned*)(mp_)>>(4*hi), my_=*(const __attribute__((address_space(3))) unsigned*)(mp_+4)>>(4*hi); \
      _Pragma("unroll") for(int r=0;r<16;++r){ const int cb_=(r&3)+8*(r>>2); const unsigned s0_=(unsigned)__builtin_amdgcn_sbfe((int)mx_,cb_,1), s1_=(unsigned)__builtin_amdgcn_sbfe((int)my_,cb_,1); \
        P0[r]=__uint_as_float((__float_as_uint(P0[r]+cm)&s0_)|(~s0_&0xff800000u)); P1[r]=__uint_as_float((__float_as_uint(P1[r]+cm)&s1_)|(~s1_&0xff800000u)); } }while(0)
  #define CMASK(P0,P1,t) do{ if((t)>=NT-6){ const int db_=q0+qrel-64*(t)-4*hi; \
      _Pragma("unroll") for(int r=0;r<16;++r){ const int d0_=db_-((r&3)+8*(r>>2)); const int i0_=d0_<0?0:(d0_>128?128:d0_); const int d1_=d0_-32; const int i1_=d1_<0?0:(d1_>128?128:d1_); P0[r]+=btab[i0_]; P1[r]+=btab[i1_]; } } }while(0)
  bool resc=false;
  #define START(P0,P1) do{ const float rm=rowmax(P0,P1); resc=false; \
    { const float dl=__builtin_fmaxf(rm,0.f); mhat=fadd_s(mhat,dl); \
      _Pragma("unroll") for(int r=0;r<16;++r){P0[r]=fsub_s(P0[r],dl);P1[r]=fsub_s(P1[r],dl);} \
      cm=cfar-mhat; } \
    _Pragma("unroll") for(int r=0;r<16;++r)P0[r]=__builtin_amdgcn_exp2f(P0[r]); }while(0)
  #define RESC() do{ if(resc){ asm volatile("s_waitcnt lgkmcnt(0)":::"memory"); \
      _Pragma("unroll") for(int d_=0;d_<2;++d_) _Pragma("unroll") for(int r=0;r<16;++r)o[d_][r]*=wsf[crow(r,hi)]; } }while(0)
  f32x16 pA0,pA1,pB0,pB1;
  int sl_prev=0,sl_cur=0,sl_next=SLOTB;
  #define ROT() do{sl_prev=sl_cur;sl_cur=sl_next;sl_next=(sl_next==(NSLOT-1)*SLOTB)?0:sl_next+SLOTB;}while(0)
  DMA_K(2,2*SLOTB);
  WAIT_BAR(3);
  qkt(pA0,pA1,Kbase,qr,zc,r32,hi);asm volatile("s_nop 15\n\ts_nop 7":"+v"(pA0),"+v"(pA1));MASKB(pA0,pA1,0);CMASK(pA0,pA1,0);
  START(pA0,pA1);
  _Pragma("unroll") for(int r=0;r<16;++r)pA1[r]=__builtin_amdgcn_exp2f(pA1[r]);
  WAIT_BAR(0);
  DMA_K(3,0);DMA_V(1,SLOTB);
  ROT();
  kload8(kf,kp0+sl_cur);
  WAIT_BAR(2);
  s16x4 vlo[8],vhi[8]; u32x4 pw0,pw1,pw2,pw3;
  #define PKW(P,B) cvtpk_s(P[B],P[B+1])
  #define PAF(k) __builtin_bit_cast(bf16x8,pw##k)
  #define VFR(i) (bf16x8){vlo[i][0],vlo[i][1],vlo[i][2],vlo[i][3],vhi[i][0],vhi[i][1],vhi[i][2],vhi[i][3]}
  #define PIN(x) asm volatile("":"+v"(x))
  #define MX3(a,b,c) __builtin_fmaxf(__builtin_fmaxf((a),(b)),(c))
  #define GAPA(MF,A0,A1,A2,A3,W0,W1,PW) do{ MF; sacc+=A0; sacc+=A1; sacc+=A2; sacc+=A3; PIN(sacc); W0; W1; PIN(PW); SBAR(); }while(0)
  #define EX(v) __builtin_amdgcn_exp2f(v)
  #define GAPB(MF,X,B) do{ MF; X[B]=EX(X[B]); X[B+1]=EX(X[B+1]); X[B+2]=EX(X[B+2]); X[B+3]=EX(X[B+3]); PIN(X); SBAR(); }while(0)
  #define VRD(i) do{ vlo[i]=vtr(vp_+(((i)>>2)*4096+((i)&3)*1024)); vhi[i]=vtr(vp_+(((i)>>2)*4096+((i)&3)*1024+512)); }while(0)
  #define KRD(G,j) do{ if(G){ kload2(kf,kp0+sl_next,j); SBAR(); } }while(0)
  #define STEP(C0,C1,P0,P1,t,GK,GV,GL) do{ SBAR(); \
    const lds_cptr vp_=vp0+sl_prev; \
    VRD(0); SBAR(); float sacc=(P0[0]+P0[1]); \
    GAPA(C0=__builtin_amdgcn_mfma_f32_32x32x16_bf16(kf[0],qr[0],zc,0,0,0), P0[2],P0[3],P0[4],P0[5],     pw0[0]=PKW(P0,0), pw0[1]=PKW(P0,2), pw0); \
    VRD(4); SBAR(); GAPA(C1=__builtin_amdgcn_mfma_f32_32x32x16_bf16(kf[1],qr[0],zc,0,0,0), P0[6],P0[7],P0[8],P0[9],     pw0[2]=PKW(P0,4), pw0[3]=PKW(P0,6), pw0); \
    VRD(1); SBAR(); GAPA(C0=__builtin_amdgcn_mfma_f32_32x32x16_bf16(kf[2],qr[1],C0,0,0,0),   P0[10],P0[11],P0[12],P0[13], pw1[0]=PKW(P0,8), pw1[1]=PKW(P0,10), pw1); \
    VRD(5); SBAR(); GAPA(C1=__builtin_amdgcn_mfma_f32_32x32x16_bf16(kf[3],qr[1],C1,0,0,0),   P0[14],P0[15],P1[0],P1[1],   pw1[2]=PKW(P0,12),pw1[3]=PKW(P0,14), pw1); \
    VRD(2); SBAR(); GAPA(C0=__builtin_amdgcn_mfma_f32_32x32x16_bf16(kf[4],qr[2],C0,0,0,0),   P1[2],P1[3],P1[4],P1[5],     pw2[0]=PKW(P1,0), pw2[1]=PKW(P1,2), pw2); \
    VRD(6); SBAR(); GAPA(C1=__builtin_amdgcn_mfma_f32_32x32x16_bf16(kf[5],qr[2],C1,0,0,0),   P1[6],P1[7],P1[8],P1[9],     pw2[2]=PKW(P1,4), pw2[3]=PKW(P1,6), pw2); \
    VRD(3); SBAR(); GAPA(C0=__builtin_amdgcn_mfma_f32_32x32x16_bf16(kf[6],qr[3],C0,0,0,0),   P1[10],P1[11],P1[12],P1[13], pw3[0]=PKW(P1,8), pw3[1]=PKW(P1,10), pw3); \
    VRD(7); SBAR(); GAPA(C1=__builtin_amdgcn_mfma_f32_32x32x16_bf16(kf[7],qr[3],C1,0,0,0),   P1[14],P1[15],0.f,0.f,       pw3[2]=PKW(P1,12),pw3[3]=PKW(P1,14), pw3); \
    l_reg+=sacc; \
    if((((t)&1)==0)&&((t)+2<NT)){DMA_M((t)+2);} if(GK){DMA_K((t)+3,sl_cur);} if(GV){DMA_V((t)+1,sl_next);} \
    MASKB(C0,C1,t); CMASK(C0,C1,t); \
    { float a=MX3(C0[0],C0[1],C1[0]),b=MX3(C0[2],C0[3],C1[1]); a=MX3(a,C1[2],C1[3]); \
      _Pragma("unroll") for(int r=4;r<16;r+=4){a=MX3(a,C0[r],C0[r+1]);b=MX3(b,C0[r+2],C0[r+3]);a=MX3(a,C1[r],C1[r+1]);b=MX3(b,C1[r+2],C1[r+3]);} \
      float rm=__builtin_fmaxf(a,b); { auto rr=__builtin_amdgcn_permlane32_swap(__float_as_uint(rm),__float_as_uint(rm),false,false); rm=__builtin_fmaxf(__uint_as_float(rr[0]),__uint_as_float(rr[1])); } \
      resc=false; \
      if(__builtin_expect(__any(rm>(float)THRL),0)){ const float dl=__builtin_fmaxf(rm,0.f); mhat+=dl; \
        _Pragma("unroll") for(int r=0;r<16;++r){C0[r]-=dl;C1[r]-=dl;} \
        cm=cfar-mhat; \
        const float f=__builtin_amdgcn_exp2f(-dl); l_reg*=f; if(hi==0)wsf[r32]=f; resc=true; } } \
    SBAR(); \
    GAPB(o[0]=__builtin_amdgcn_mfma_f32_32x32x16_bf16(PAF(0),VFR(0),o[0],0,0,0), C0,0); \
    GAPB(o[1]=__builtin_amdgcn_mfma_f32_32x32x16_bf16(PAF(0),VFR(4),o[1],0,0,0), C0,4); \
    KRD(GL,0); GAPB(o[0]=__builtin_amdgcn_mfma_f32_32x32x16_bf16(PAF(1),VFR(1),o[0],0,0,0), C0,8); \
    KRD(GL,1); GAPB(o[1]=__builtin_amdgcn_mfma_f32_32x32x16_bf16(PAF(1),VFR(5),o[1],0,0,0), C0,12); \
    KRD(GL,2); GAPB(o[0]=__builtin_amdgcn_mfma_f32_32x32x16_bf16(PAF(2),VFR(2),o[0],0,0,0), C1,0); \
    KRD(GL,3); GAPB(o[1]=__builtin_amdgcn_mfma_f32_32x32x16_bf16(PAF(2),VFR(6),o[1],0,0,0), C1,4); \
    GAPB(o[0]=__builtin_amdgcn_mfma_f32_32x32x16_bf16(PAF(3),VFR(3),o[0],0,0,0), C1,8); \
    GAPB(o[1]=__builtin_amdgcn_mfma_f32_32x32x16_bf16(PAF(3),VFR(7),o[1],0,0,0), C1,12); \
    }while(0)
  int t=1;
  #undef CMASK
  #define CMASK(P0,P1,t) do{}while(0)
  for(;t+7<NT;t+=2){
    STEP(pB0,pB1,pA0,pA1,t,true,true,true);     WAIT_BAR(2); RESC(); ROT();
    STEP(pA0,pA1,pB0,pB1,t+1,true,true,true);   WAIT_BAR(2); RESC(); ROT();
  }
  #undef CMASK
  #define CMASK(P0,P1,t) do{ if((t)>=NT-6){ const int db_=q0+qrel-64*(t)-4*hi; \
      _Pragma("unroll") for(int r=0;r<16;++r){ const int d0_=db_-((r&3)+8*(r>>2)); const int i0_=d0_<0?0:(d0_>128?128:d0_); const int d1_=d0_-32; const int i1_=d1_<0?0:(d1_>128?128:d1_); P0[r]+=btab[i0_]; P1[r]+=btab[i1_]; } } }while(0)
  #define ENDW(tt) do{ if((tt)+3<NT){WAIT_BAR(2);} else if((tt)+2<NT){WAIT_BAR(1);} else {WAIT_BAR(0);} }while(0)
  for(;t+1<NT;t+=2){
    STEP(pB0,pB1,pA0,pA1,t,(t+3<NT),(t+1<NT),(t+1<NT));       ENDW(t);   RESC(); ROT();
    STEP(pA0,pA1,pB0,pB1,t+1,(t+4<NT),(t+2<NT),(t+2<NT));     ENDW(t+1); RESC(); ROT();
  }
  STEP(pB0,pB1,pA0,pA1,NT-1,false,false,false); RESC();
  { float sacc=pB0[0]+pB0[1]; _Pragma("unroll") for(int r=2;r<16;++r)sacc+=pB0[r]; _Pragma("unroll") for(int r=0;r<16;++r)sacc+=pB1[r]; l_reg+=sacc;
    pw0=(u32x4){PKW(pB0,0),PKW(pB0,2),PKW(pB0,4),PKW(pB0,6)};pw1=(u32x4){PKW(pB0,8),PKW(pB0,10),PKW(pB0,12),PKW(pB0,14)};pw2=(u32x4){PKW(pB1,0),PKW(pB1,2),PKW(pB1,4),PKW(pB1,6)};pw3=(u32x4){PKW(pB1,8),PKW(pB1,10),PKW(pB1,12),PKW(pB1,14)};
    SBAR(); pv(o,vb0+sl_cur,PAF(0),PAF(1),PAF(2),PAF(3)); }
  #undef PKW
  #undef PAF
  #undef VFR
  #undef PIN
  #undef MX3
  #undef GAPA
  #undef GAPB
  #undef EX
  #undef VRD
  #undef KRD
  #undef STEP
  #undef ENDW
  {auto rr=__builtin_amdgcn_permlane32_swap(__float_as_uint(l_reg),__float_as_uint(l_reg),false,false);l_reg=__uint_as_float(rr[0])+__uint_as_float(rr[1]);}
  if(hi==0)wsf[32+r32]=l_reg;asm volatile("s_waitcnt lgkmcnt(0)":::"memory");
  float rli[16];
  #pragma unroll
  for(int r=0;r<16;++r)rli[r]=__builtin_amdgcn_rcpf(wsf[32+crow(r,hi)]);
  bf16*Ow=O+(rowbase+q0+wid*QBLK)*OP+h*D;
  { bf16*stg=(bf16*)(shm+LDS_OST)+wid*2048;
    #pragma unroll
    for(int r=0;r<16;++r){const int orow=crow(r,hi);
      #pragma unroll
      for(int d0=0;d0<2;++d0)stg[orow*64+d0*32+r32]=__float2bfloat16(o[d0][r]*rli[r]);}
    asm volatile("s_waitcnt lgkmcnt(0)":::"memory");
    #pragma unroll
    for(int i=0;i<4;++i){const int row=i*8+(lane>>3),ch=lane&7; const u32x4 v=*(const u32x4*)(stg+row*64+ch*8); ATTN_STORE16(Ow+(long)row*OP+ch*8,v);} }
  asm volatile("s_waitcnt lgkmcnt(0)\n\ts_barrier":::"memory");
  #undef DMA_K
  #undef DMA_V
  #undef DMA_M
  #undef MASKB
  #undef CMASK
  #undef START
  #undef RESC
  #undef ROT
}
constexpr int ATTN_LDS_BYTES=LDS_BYTES;
#undef SBAR
#undef WAIT_BAR
}

constexpr int CW_QUEUE = 8192;
__device__ __forceinline__ void dsa_attn_phase(Frame& F, const Args& A, int l) {
    unsigned* ctr = (unsigned*)(F.ws + WS_CTL) + CW_QUEUE + 64 * l;
    volatile unsigned* slot = (volatile unsigned*)(F.lds + LDSCTL_OFF + 512);
    const attn_body::bf16* proj = (const attn_body::bf16*)(F.ws + WS_PROJ);
    for (;;) {
        if (F.tid == 0) *slot = atomicAdd(ctr, 1u);
        __syncthreads();
        const unsigned u = (unsigned)__builtin_amdgcn_readfirstlane((int)*slot);
        __syncthreads();
        if (u >= 768u) break;
        const int qb = 63 - (int)(u / 12u), bh = (int)(u % 12u), b = bh / 6, h = bh % 6;
        attn_body::attn_unit<8>(F.wave, b, h, qb, proj + PC_DQ, proj + PC_DK, proj + PC_DV, (attn_body::bf16*)(F.ws + WS_Y) + YC_DSA, (const unsigned*)(F.ws + WS_BM), A.in[I_RB], (char*)(F.lds + RING_OFF));
    }
}

constexpr int PH_PER_LAYER = 9, N_PHASES = 1 + DEPTH * PH_PER_LAYER;
__global__ void __launch_bounds__(NTHR, 2) fwd(const Args A) {
    extern __shared__ __attribute__((aligned(16))) unsigned char lds[];
    Frame F;
    F.lds = lds; F.tid = threadIdx.x; F.lane = F.tid & 63; F.wave = __builtin_amdgcn_readfirstlane(F.tid >> 6); F.G = gridDim.x;
    F.out = A.out; F.ws = A.ws;
    LAS unsigned char* lds3 = (LAS unsigned char*)lds;
    for (int u = F.tid; u < (LDS_BYTES - LDSCTL_OFF) / 4; u += NTHR) ((LAS unsigned*)(lds3 + LDSCTL_OFF))[u] = 0u;
    __syncthreads();
    const int lo = A.ph_lo, hi = A.ph_hi;
    XcdBarrier bar; bar.bar = (unsigned*)(F.ws + WS_CTL) + CW_BAR; bar.x = 0; bar.st = nullptr;
    if (hi - lo > 1) bar = xcd_barrier_post((unsigned*)(F.ws + WS_CTL) + CW_BAR, (volatile LAS unsigned*)(lds3 + MISC_OFF) + 8);
#define IN(k) (lo <= (k) && (k) < hi)
#define LAUNDER() do { int lane_ = (int)__builtin_amdgcn_mbcnt_hi(~0u, __builtin_amdgcn_mbcnt_lo(~0u, 0u)); asm volatile("" : "+v"(lane_)); F.lane = lane_; F.tid = F.wave * 64 + lane_; } while (0)
#ifndef REPMASK
#define REPMASK 0
#endif
#define REPS(j) (((REPMASK >> (j)) & 1) + 1)
#define SEAM(k) do { if (IN(k) && IN((k) + 1)) xcd_barrier(bar); } while (0)
#define gw (blockIdx.x * NWAVES + F.wave)
#define NGW (F.G * NWAVES)
#define XB ((bf16*)(A.ws + WS_XB))
#define PROJ ((bf16*)(A.ws + WS_PROJ))
#define AUX ((float*)(A.ws + WS_AUX))
#define Y ((bf16*)(A.ws + WS_Y))
#define H ((bf16*)(A.ws + WS_H))
#define V1 ((float*)(A.ws + WS_V1))
#define V2 ((float*)(A.ws + WS_V2))

    if (IN(0)) { LAUNDER(); for (int rep = 0; rep < REPS(5); ++rep) p0_prologue(F, A); } SEAM(0);

    for (int l = 0; l < DEPTH; ++l) {
        const int pb = 1 + l * PH_PER_LAYER;
        if (IN(pb + 0)) { LAUNDER();
            pg8::Gemm g{XB, w_ptr(F, l, WO_IN), T, NIN, D}; pg8::StaticOrder S; S.init(T, NIN, F.G, (int)blockIdx.x);
            pg8::EpiInProj E{PROJ, AUX, (_Float16*)(F.ws + WS_KI)};
            for (int rep = 0; rep < REPS(3); ++rep) {
            pg8::gemm_phase<pg8::EpiInProj, pg8::StaticOrder, true, true>(lds3 + RING_OFF, g, S, E, F.wave); }
        } SEAM(pb + 0);
        if (IN(pb + 1)) { LAUNDER();
            for (int rep = 0; rep < REPS(0); ++rep) for (int it = blockIdx.x; it < T / 32; it += F.G) dsa_item(F, A, l, T / 32 - 1 - it);
            for (int rep = 0; rep < REPS(1); ++rep) for (int it = blockIdx.x; it < 1024; it += F.G) lru_item(F, A, l, it, false);
            for (int rep = 0; rep < REPS(2); ++rep) for (int it = blockIdx.x; it < 3072; it += F.G) gla_item(F, A, l, it, false);
        } SEAM(pb + 1);
        if (IN(pb + 2)) { LAUNDER();
            if (blockIdx.x < 96) gla_scan(F, blockIdx.x * NTHR + F.tid);
            for (int row = gw; row < 512; row += NGW) lru_scan_row(F, row);
#ifndef NO_ATTN
            dsa_attn_phase(F, A, l);
#endif
        } SEAM(pb + 2);
        if (IN(pb + 3)) { LAUNDER();
            for (int rep = 0; rep < REPS(1); ++rep) for (int it = blockIdx.x; it < 1024; it += F.G) lru_item(F, A, l, it, true);
            for (int rep = 0; rep < REPS(2); ++rep) for (int it = blockIdx.x; it < 3072; it += F.G) gla_item(F, A, l, it, true);
            __syncthreads();
        } SEAM(pb + 3);
        if (IN(pb + 4)) { LAUNDER();
            pg8::Gemm g{Y, w_ptr(F, l, WO_OUT), T, D, D}; pg8::StaticOrder S; S.init(T, D, F.G, (int)blockIdx.x);
            pg8::EpiRes E{l == 0 ? A.in[I_X] : F.out, V1, DN_ALPHA};
            for (int rep = 0; rep < REPS(3); ++rep) {
            pg8::gemm_phase<pg8::EpiRes, pg8::StaticOrder, true, true>(lds3 + RING_OFF, g, S, E, F.wave); }
        } SEAM(pb + 4);
        if (IN(pb + 5)) { LAUNDER(); for (int rep = 0; rep < REPS(4); ++rep) ln_phase(F, V1, A.in[I_LN1G] + l * D, A.in[I_LN1B] + l * D, F.out, XB); } SEAM(pb + 5);
        if (IN(pb + 6)) { LAUNDER();
            pg8::Gemm g{XB, w_ptr(F, l, WO_GU), T, NGU, D}; pg8::StaticOrder S; S.init(T, NGU, F.G, (int)blockIdx.x);
            pg8::EpiFfnUp E{H};
            for (int rep = 0; rep < REPS(3); ++rep) {
            pg8::gemm_phase<pg8::EpiFfnUp, pg8::StaticOrder, true, true>(lds3 + RING_OFF, g, S, E, F.wave); }
        } SEAM(pb + 6);
        if (IN(pb + 7)) { LAUNDER();
            pg8::Gemm g{H, w_ptr(F, l, WO_D), T, D, DFF}; pg8::StaticOrder S; S.init(T, D, F.G, (int)blockIdx.x);
            pg8::EpiRes E{F.out, V2, DN_ALPHA};
            for (int rep = 0; rep < REPS(3); ++rep) {
            pg8::gemm_phase<pg8::EpiRes, pg8::StaticOrder, true, true>(lds3 + RING_OFF, g, S, E, F.wave); }
        } SEAM(pb + 7);
        if (IN(pb + 8)) { LAUNDER(); for (int rep = 0; rep < REPS(4); ++rep) ln_phase(F, V2, A.in[I_LN2G] + l * D, A.in[I_LN2B] + l * D, F.out, XB); } SEAM(pb + 8);
    }
#undef IN
#undef SEAM
#undef gw
#undef NGW
#undef XB
#undef PROJ
#undef AUX
#undef Y
#undef H
#undef V1
#undef V2
}

extern "C" void kernel_launch(void* const* d_in, const int* in_sizes, int n_in, void* d_out, int out_size, void* d_ws, size_t ws_size, hipStream_t stream) {
    static int grid = 0;
    if (grid == 0) {
        if (n_in != N_INPUTS || in_sizes[0] != T * D || out_size != T * D || ws_size < WS_END) { fprintf(stderr, "kernel_launch: unexpected shapes (n_in %d, in0 %d, out %d, ws %zu, need %zu)\n", n_in, n_in > 0 ? in_sizes[0] : -1, out_size, ws_size, (size_t)WS_END); grid = -1; return; }
        int dev = 0, cus = 0, per_cu = 0;
        if (hipGetDevice(&dev) != hipSuccess || hipDeviceGetAttribute(&cus, hipDeviceAttributeMultiprocessorCount, dev) != hipSuccess) { grid = -1; return; }
        if (hipFuncSetAttribute((const void*)fwd, hipFuncAttributeMaxDynamicSharedMemorySize, LDS_BYTES) != hipSuccess) { fprintf(stderr, "kernel_launch: hipFuncSetAttribute failed\n"); grid = -1; return; }
        if (hipOccupancyMaxActiveBlocksPerMultiprocessor(&per_cu, (const void*)fwd, NTHR, LDS_BYTES) != hipSuccess || per_cu < 1) fprintf(stderr, "kernel_launch: occupancy query reports %d per CU\n", per_cu);
        (void)hipGetLastError();
        grid = cus;
        if (grid != 256) fprintf(stderr, "kernel_launch: %d CUs (expected 256)\n", grid);
    }
    if (grid < 0) return;
    (void)hipMemsetAsync((char*)d_ws + WS_CTL, 0, CTL_ZERO_BYTES, stream);
    Args a{};
    for (int i = 0; i < N_INPUTS; ++i) a.in[i] = (const float*)d_in[i];
    a.out = (float*)d_out; a.ws = (unsigned char*)d_ws;
#if MK_N_LAUNCHES == 1
    a.ph_lo = 0; a.ph_hi = N_PHASES;
    hipLaunchKernelGGL(fwd, dim3(grid), dim3(NTHR), LDS_BYTES, stream, a);
#else
    for (int ph = 0; ph < N_PHASES; ++ph) { a.ph_lo = ph; a.ph_hi = ph + 1; hipLaunchKernelGGL(fwd, dim3(grid), dim3(NTHR), LDS_BYTES, stream, a); }
#endif
}
```

```cpp
#define MK_N_LAUNCHES 1
#include <hip/hip_runtime.h>
#include <cstdio>
#include <cstdint>
#include <cmath>
namespace pg8 {
#define PG8_LAS __attribute__((address_space(3)))
typedef unsigned short bf16_t;
typedef short bf16x8 __attribute__((ext_vector_type(8)));
typedef float f32x4 __attribute__((ext_vector_type(4)));
typedef unsigned u32x4 __attribute__((ext_vector_type(4)));
constexpr int BM = 256, BK = 64, HALF = 128, HTB = HALF * BK * 2  , STAGE_BYTES = 8 * HTB, NXCD = 8, WGM = 8;

__host__ __device__ __forceinline__ int lds_byte(int r, int c) { const int st = (r >> 4) * 2 + (c >> 5), rr = r & 15, cc = c & 31, ob = rr * 64 + cc * 2; return st * 1024 + (ob ^ (((ob >> 9) & 1) << 5)); }
__host__ __device__ __forceinline__ void stage_rc(int b, int& R, int& C) { const int st = b / 1024, sb = b % 1024, swz = sb ^ (((sb >> 9) & 1) << 5); R = (st >> 1) * 16 + swz / 64; C = (st & 1) * 32 + (swz % 64) / 2; }
__host__ __device__ __forceinline__ int perm32(int rho) { const int n = rho >> 4, i = rho & 15; return 8 * (i >> 2) + 4 * n + (i & 3); }

struct Unit { int pm, pn; };
struct Gemm { const bf16_t* A; const bf16_t* Bt; int M, N, K; };

struct StaticOrder {
    int nM, nN, nwg, G, c;
    __host__ __device__ void init(int M, int N, int G_, int c_) { nM = M / BM; nN = N / BM; nwg = nM * nN; G = G_; c = c_; }
    __host__ __device__ bool next(int i, Unit& u) const {
        const long L = (long)i * G + c; if (L >= nwg) return false;
        int wgid = (int)L; { const int q = nwg / NXCD, r = nwg % NXCD, xcd = wgid % NXCD, off = wgid / NXCD; wgid = (xcd < r ? xcd * (q + 1) : r * (q + 1) + (xcd - r) * q) + off; }
        const int nig = WGM * nN, gid = wgid / nig, fm = gid * WGM, gsz = (nM - fm) < WGM ? (nM - fm) : WGM;
        u.pm = fm + ((wgid % nig) % gsz); u.pn = (wgid % nig) / gsz; return true;
    }
    __device__ __forceinline__ void a_ready(const Unit&) const {}
    __device__ __forceinline__ void done(const Unit&) const {}
};

__device__ __forceinline__ unsigned cvt_pk_bf16(float lo, float hi) { unsigned r; asm volatile("v_cvt_pk_bf16_f32 %0, %1, %2" : "=v"(r) : "v"(lo), "v"(hi)); return r; }
typedef float f32x2 __attribute__((ext_vector_type(2)));
constexpr int PROJ_LD = 3328, AUX_LD = 256, DFF = 2816, DM = 1024;
typedef _Float16 h16x8 __attribute__((ext_vector_type(8)));
struct EpiInProj {
    static constexpr bool PERM = true, AFTER_DRAIN = false;
    bf16_t* proj; float* aux; _Float16* ki;
    __device__ __forceinline__ void operator()(const f32x4 (&acc)[2][2][4][2], const Unit& u, int wr, int wc, int fr, int fq) const {
        const int row0 = u.pm * BM + wr * 64 + fr;
        if (u.pn < 13) {
            const int col0 = u.pn * BM + wc * 32 + 8 * fq;
#pragma unroll
            for (int ai = 0; ai < 2; ++ai)
#pragma unroll
                for (int m = 0; m < 4; ++m) { bf16_t* rowp = proj + (size_t)(row0 + ai * HALF + m * 16) * PROJ_LD + col0;
#pragma unroll
                    for (int bj = 0; bj < 2; ++bj) { const f32x4 v0 = acc[ai][bj][m][0], v1 = acc[ai][bj][m][1];
                        u32x4 w; w.x = cvt_pk_bf16(v0[0], v0[1]); w.y = cvt_pk_bf16(v0[2], v0[3]); w.z = cvt_pk_bf16(v1[0], v1[1]); w.w = cvt_pk_bf16(v1[2], v1[3]);
                        *(u32x4*)(rowp + bj * HALF) = w; } }
        } else {
            const int col0 = wc * 32 + 8 * fq;
#pragma unroll
            for (int ai = 0; ai < 2; ++ai)
#pragma unroll
                for (int m = 0; m < 4; ++m) { float* rowp = aux + (size_t)(row0 + ai * HALF + m * 16) * AUX_LD + col0;
#pragma unroll
                    for (int bj = 0; bj < 2; ++bj) { *(f32x4*)(rowp + bj * HALF) = acc[ai][bj][m][0]; *(f32x4*)(rowp + bj * HALF + 4) = acc[ai][bj][m][1];
                        const int cg = col0 + bj * HALF;
                        if (cg >= 144 && cg < 176) { const f32x4 v0 = acc[ai][bj][m][0], v1 = acc[ai][bj][m][1]; h16x8 hv;
                            hv[0] = (_Float16)v0[0]; hv[1] = (_Float16)v0[1]; hv[2] = (_Float16)v0[2]; hv[3] = (_Float16)v0[3]; hv[4] = (_Float16)v1[0]; hv[5] = (_Float16)v1[1]; hv[6] = (_Float16)v1[2]; hv[7] = (_Float16)v1[3];
                            *(h16x8*)(ki + (size_t)(row0 + ai * HALF + m * 16) * 32 + (cg - 144)) = hv; } } }
        }
    }
};
struct EpiFfnUp {
    static constexpr bool PERM = true, AFTER_DRAIN = false;
    bf16_t* H;
    __device__ __forceinline__ void operator()(const f32x4 (&acc)[2][2][4][2], const Unit& u, int wr, int wc, int fr, int fq) const {
        const int row0 = u.pm * BM + wr * 64 + fr, col0 = u.pn * HALF + wc * 32 + 8 * fq;
#pragma unroll
        for (int ai = 0; ai < 2; ++ai)
#pragma unroll
            for (int m = 0; m < 4; ++m) { bf16_t* rowp = H + (size_t)(row0 + ai * HALF + m * 16) * DFF + col0;
                float o[8];
#pragma unroll
                for (int n = 0; n < 2; ++n)
#pragma unroll
                    for (int j = 0; j < 4; ++j) { const float g = acc[ai][0][m][n][j], up = acc[ai][1][m][n][j];
                        const float sg = g * __builtin_amdgcn_rcpf(1.0f + __builtin_amdgcn_exp2f(-1.44269504089f * g)); o[n * 4 + j] = sg * up; }
                u32x4 w; w.x = cvt_pk_bf16(o[0], o[1]); w.y = cvt_pk_bf16(o[2], o[3]); w.z = cvt_pk_bf16(o[4], o[5]); w.w = cvt_pk_bf16(o[6], o[7]);
                *(u32x4*)rowp = w; }
    }
};
struct EpiRes {
    static constexpr bool PERM = false, AFTER_DRAIN = false;
    const float* base; float* out; float alpha;
    __device__ __forceinline__ void operator()(const f32x4 (&acc)[2][2][4][2], const Unit& u, int wr, int wc, int fr, int fq) const {
        const int row0 = u.pm * BM + wr * 64 + fr, col0 = u.pn * BM + wc * 32 + 4 * fq;
#pragma unroll
        for (int ai = 0; ai < 2; ++ai)
#pragma unroll
            for (int m = 0; m < 4; ++m) { const size_t off = (size_t)(row0 + ai * HALF + m * 16) * DM + col0;
#pragma unroll
                for (int bj = 0; bj < 2; ++bj)
#pragma unroll
                    for (int n = 0; n < 2; ++n) { const f32x4 b = *(const f32x4*)(base + off + bj * HALF + n * 16);
                        *(f32x4*)(out + off + bj * HALF + n * 16) = b * alpha + acc[ai][bj][m][n]; } }
    }
};
template <class Epi, class Sched, bool ALIGN_EPI = false, bool SP2 = false>
__device__ __forceinline__ void gemm_phase(PG8_LAS unsigned char* lds, const Gemm g, const Sched& S, const Epi& E, int wave_id) {
    int lane_ = (int)__builtin_amdgcn_mbcnt_hi(~0u, __builtin_amdgcn_mbcnt_lo(~0u, 0u)); asm volatile("" : "+v"(lane_));
    const int wid = wave_id, lane = lane_, tid = wid * 64 + lane, wr = wid >> 2, wc = wid & 3, fr = lane & 15, fq = lane >> 4;
    const int K = g.K, nt = K / BK;
    unsigned voffA[2], voffB[2];
#pragma unroll
    for (int i = 0; i < 2; ++i) { int R, C; stage_rc(tid * 16 + i * 8192, R, C); const int Rb = Epi::PERM ? ((R & ~31) + perm32(R & 31)) : R;
        voffA[i] = (unsigned)(R * K + C) * 2u; voffB[i] = (unsigned)(Rb * K + C) * 2u; }
    const size_t kstep = (size_t)(BK * 2);
    const size_t hstep = (size_t)HALF * K * 2;
    const size_t tstep = 2 * hstep;
    const unsigned ldsw = (unsigned)wid * 1024u;
    const int aoff = lds_byte(wr * 64 + fr, fq * 8), boff = lds_byte(wc * 32 + fr, fq * 8);
#define PG8_SA(b, h) (((b) * 2 + (h)) * HTB)
#define PG8_SB(b, h) ((4 + (b) * 2 + (h)) * HTB)
#define PG8_STAGE(bufoff, gbase, voff) do { _Pragma("unroll") for (int _i = 0; _i < 2; ++_i) \
        __builtin_amdgcn_global_load_lds((const unsigned*)((const char*)(gbase) + (voff)[_i]), (PG8_LAS unsigned*)(lds + (bufoff) + ldsw + _i * 8192), 16, 0, 0); } while (0)
#define PG8_LDA(dst, b, h) do { _Pragma("unroll") for (int m = 0; m < 4; ++m) _Pragma("unroll") for (int k = 0; k < 2; ++k) dst[m][k] = *(const PG8_LAS bf16x8*)(lds + PG8_SA(b, h) + aoff + m * 2048 + k * 1024); } while (0)
#define PG8_LDB(dst, b, h) do { _Pragma("unroll") for (int n = 0; n < 2; ++n) _Pragma("unroll") for (int k = 0; k < 2; ++k) dst[n][k] = *(const PG8_LAS bf16x8*)(lds + PG8_SB(b, h) + boff + n * 2048 + k * 1024); } while (0)
#define PG8_MMA(ai, bj, At, Bt) do { __builtin_amdgcn_s_setprio(1); _Pragma("unroll") for (int m = 0; m < 4; ++m) _Pragma("unroll") for (int n = 0; n < 2; ++n) _Pragma("unroll") for (int k = 0; k < 2; ++k) \
        acc[ai][bj][m][n] = __builtin_amdgcn_mfma_f32_16x16x32_bf16(Bt[n][k], At[m][k], acc[ai][bj][m][n], 0, 0, 0); __builtin_amdgcn_s_setprio(0); } while (0)
#define PG8_WAIT_V(n) asm volatile("s_waitcnt vmcnt(" #n ")" ::: "memory")
#define PG8_WAIT_L(n) asm volatile("s_waitcnt lgkmcnt(" #n ")" ::: "memory")
#define PG8_BAR __builtin_amdgcn_s_barrier()
#define PG8_SCHED __builtin_amdgcn_sched_barrier(0)
    Unit cur, nxt; int ui = 0;
    if (!S.next(0, cur)) return;
    f32x4 acc[2][2][4][2];
#pragma unroll
    for (int a = 0; a < 2; ++a)
#pragma unroll
        for (int b = 0; b < 2; ++b)
#pragma unroll
            for (int m = 0; m < 4; ++m)
#pragma unroll
                for (int n = 0; n < 2; ++n) acc[a][b][m][n] = (f32x4){0.f, 0.f, 0.f, 0.f};
    bf16x8 At[4][2], B0[2][2], B1[2][2];
    const char* cA = (const char*)g.A + (size_t)cur.pm * tstep; const char* cB = (const char*)g.Bt + (size_t)cur.pn * tstep;
    S.a_ready(cur);
    if constexpr (SP2) {
        PG8_STAGE(PG8_SB(0, 0), cB, voffB); PG8_STAGE(PG8_SB(0, 1), cB + hstep, voffB); PG8_STAGE(PG8_SA(0, 0), cA, voffA); PG8_STAGE(PG8_SA(0, 1), cA + hstep, voffA);
        if (wr == 1) PG8_BAR;
        PG8_WAIT_V(2); PG8_BAR;
        PG8_STAGE(PG8_SB(1, 0), cB + kstep, voffB); PG8_STAGE(PG8_SA(1, 0), cA + kstep, voffA); PG8_STAGE(PG8_SB(1, 1), cB + hstep + kstep, voffB);
        PG8_WAIT_V(6); PG8_BAR;
    } else {
        PG8_STAGE(PG8_SB(0, 0), cB, voffB); PG8_STAGE(PG8_SA(0, 0), cA, voffA); PG8_STAGE(PG8_SB(0, 1), cB + hstep, voffB); PG8_STAGE(PG8_SA(0, 1), cA + hstep, voffA);
        if (wr == 1) PG8_BAR;
        PG8_WAIT_V(4); PG8_BAR;
        PG8_STAGE(PG8_SB(1, 0), cB + kstep, voffB); PG8_STAGE(PG8_SA(1, 0), cA + kstep, voffA); PG8_STAGE(PG8_SB(1, 1), cB + hstep + kstep, voffB);
        PG8_WAIT_V(6); PG8_BAR;
    }
    for (;;) {
        const bool has_next = S.next(ui + 1, nxt);
        const char* nA = has_next ? (const char*)g.A + (size_t)nxt.pm * tstep : cA; const char* nB = has_next ? (const char*)g.Bt + (size_t)nxt.pn * tstep : cB;
        for (int t = 0; t < nt; t += 2) {
            const bool last = (t == nt - 2);
            const char* a1 = cA + (size_t)(t + 1) * kstep;
            const char* a2 = last ? nA : cA + (size_t)(t + 2) * kstep; const char* b2 = last ? nB : cB + (size_t)(t + 2) * kstep;
            const char* a3 = a2 + kstep; const char* b3 = b2 + kstep;
            if (last && has_next) S.a_ready(nxt);
            if constexpr (SP2) {
            PG8_LDB(B0, 0, 0); PG8_LDB(B1, 0, 1); PG8_SCHED; PG8_LDA(At, 0, 0); PG8_STAGE(PG8_SA(1, 1), a1 + hstep, voffA);
            PG8_WAIT_V(8); PG8_WAIT_L(0); PG8_BAR; PG8_MMA(0, 0, At, B0); PG8_MMA(0, 1, At, B1); PG8_BAR; PG8_SCHED;
            PG8_LDA(At, 0, 1); PG8_STAGE(PG8_SB(0, 0), b2, voffB); PG8_STAGE(PG8_SB(0, 1), b2 + hstep, voffB); PG8_STAGE(PG8_SA(0, 0), a2, voffA);
            PG8_WAIT_V(8); PG8_WAIT_L(0); PG8_BAR; PG8_MMA(1, 0, At, B0); PG8_MMA(1, 1, At, B1); PG8_BAR; PG8_SCHED;
            PG8_LDB(B0, 1, 0); PG8_LDB(B1, 1, 1); PG8_SCHED; PG8_LDA(At, 1, 0); PG8_STAGE(PG8_SA(0, 1), a2 + hstep, voffA);
            PG8_WAIT_V(8); PG8_WAIT_L(0); PG8_BAR; PG8_MMA(0, 0, At, B0); PG8_MMA(0, 1, At, B1); PG8_BAR; PG8_SCHED;
            PG8_LDA(At, 1, 1); PG8_STAGE(PG8_SB(1, 0), b3, voffB); PG8_STAGE(PG8_SB(1, 1), b3 + hstep, voffB); PG8_STAGE(PG8_SA(1, 0), a3, voffA);
            PG8_WAIT_V(8); PG8_WAIT_L(0); PG8_BAR; PG8_MMA(1, 0, At, B0); PG8_MMA(1, 1, At, B1); PG8_BAR; PG8_SCHED;
            } else {
            PG8_LDB(B0, 0, 0); PG8_SCHED; PG8_LDA(At, 0, 0); PG8_STAGE(PG8_SA(1, 1), a1 + hstep, voffA);
            PG8_WAIT_L(8); PG8_BAR; PG8_WAIT_L(0); PG8_MMA(0, 0, At, B0); PG8_BAR; PG8_SCHED;
            PG8_LDB(B1, 0, 1); PG8_STAGE(PG8_SB(0, 0), b2, voffB);
            PG8_BAR; PG8_WAIT_L(0); PG8_MMA(0, 1, At, B1); PG8_BAR;
            PG8_LDA(At, 0, 1); PG8_STAGE(PG8_SA(0, 0), a2, voffA);
            PG8_BAR; PG8_WAIT_L(0); PG8_MMA(1, 0, At, B0); PG8_BAR; PG8_SCHED;
            PG8_STAGE(PG8_SB(0, 1), b2 + hstep, voffB);
            PG8_WAIT_V(6); PG8_BAR; PG8_MMA(1, 1, At, B1); PG8_BAR;
            PG8_LDB(B0, 1, 0); PG8_SCHED; PG8_LDA(At, 1, 0); PG8_STAGE(PG8_SA(0, 1), a2 + hstep, voffA);
            PG8_WAIT_L(8); PG8_BAR; PG8_WAIT_L(0); PG8_MMA(0, 0, At, B0); PG8_BAR; PG8_SCHED;
            PG8_LDB(B1, 1, 1); PG8_STAGE(PG8_SB(1, 0), b3, voffB);
            PG8_BAR; PG8_WAIT_L(0); PG8_MMA(0, 1, At, B1); PG8_BAR;
            PG8_LDA(At, 1, 1); PG8_STAGE(PG8_SA(1, 0), a3, voffA);
            PG8_BAR; PG8_WAIT_L(0); PG8_MMA(1, 0, At, B0); PG8_BAR; PG8_SCHED;
            PG8_STAGE(PG8_SB(1, 1), b3 + hstep, voffB);
            PG8_WAIT_V(6); PG8_BAR; PG8_MMA(1, 1, At, B1); PG8_BAR;
            }
        }
        if constexpr (ALIGN_EPI) { if (wr == 0) PG8_BAR; }
        if constexpr (!Epi::AFTER_DRAIN) { E(acc, cur, wr, wc, fr, fq); S.done(cur); }
        if (!has_next) break;
#pragma unroll
        for (int a = 0; a < 2; ++a)
#pragma unroll
            for (int b = 0; b < 2; ++b)
#pragma unroll
                for (int m = 0; m < 4; ++m)
#pragma unroll
                    for (int n = 0; n < 2; ++n) acc[a][b][m][n] = (f32x4){0.f, 0.f, 0.f, 0.f};
        cur = nxt; cA = nA; cB = nB; ++ui;
        if constexpr (ALIGN_EPI) { if (wr == 1) PG8_BAR; }
    }
    PG8_WAIT_V(0);
    if constexpr (!ALIGN_EPI) { if (wr == 0) PG8_BAR; }
    PG8_BAR;
    if constexpr (Epi::AFTER_DRAIN) { E.fused(acc, cur, wr, wc, fr, fq, lds, wid, lane); S.done(cur); }
#undef PG8_SA
#undef PG8_SB
#undef PG8_STAGE
#undef PG8_LDA
#undef PG8_LDB
#undef PG8_MMA
#undef PG8_WAIT_V
#undef PG8_WAIT_L
#undef PG8_BAR
#undef PG8_SCHED
}
}

#ifndef MK_N_LAUNCHES
#define MK_N_LAUNCHES 1
#endif
constexpr int NWAVES = 8, NTHR = 512;
constexpr int BATCH = 2, SEQ = 16384, T = BATCH * SEQ, D = 1024, DEPTH = 2, DFF = 2816;
constexpr int NIN = 3584, NGU = 5632, PROJ_LD = 3328, AUX_LD = 256;
constexpr float DN_ALPHA = 1.41421356237309515f, LN_EPS = 1e-5f;
constexpr int PC_LX = 0, PC_LG = 256, PC_GQ = 512, PC_GK = 896, PC_GV = 1280, PC_GG = 1664, PC_DQ = 2048, PC_DK = 2432, PC_DV = 2816;
constexpr int AC_GLR = 0, AC_IQ = 16, AC_IK = 144, AC_IW = 176;
constexpr int YC_LRU = 0, YC_GLA = 256, YC_DSA = 640;
enum { I_X = 0, I_WIN, I_CONVW, I_CONVB, I_WA, I_BA, I_WX, I_BX, I_LAM, I_WG2, I_BG, I_NG, I_RB, I_WOUT, I_LN1G, I_LN1B, I_WFG, I_WFU, I_WFD, I_LN2G, I_LN2B, N_INPUTS };

constexpr size_t MiB = 1u << 20;
constexpr size_t WS_CTL = 0, CTL_ZERO_BYTES = 1 * MiB;
constexpr size_t WS_W = 1 * MiB, W_LAYER = 26 * MiB, WO_IN = 0, WO_OUT = 7 * MiB, WO_GU = 9 * MiB, WO_D = 20 * MiB;
constexpr size_t WS_XB = 54 * MiB, WS_PROJ = 118 * MiB, WS_AUX = 326 * MiB, WS_R2 = 358 * MiB, WS_SEL = 486 * MiB, WS_KI = 502 * MiB, WS_END = 504 * MiB;
constexpr size_t WS_V1 = WS_PROJ, WS_H = WS_PROJ, WS_Y = WS_R2, WS_GLAU = WS_R2 + 64 * MiB, WS_DEC = WS_R2 + 112 * MiB, WS_LSUM = WS_R2 + 113 * MiB, WS_CARRY = WS_R2 + 117 * MiB, WS_V2 = WS_R2, WS_BM = WS_XB;
static_assert(WO_IN + (size_t)NIN * D * 2 <= WO_OUT && WO_OUT + (size_t)D * D * 2 <= WO_GU && WO_GU + (size_t)NGU * D * 2 <= WO_D && WO_D + (size_t)D * DFF * 2 <= W_LAYER, "weight map");
static_assert(WS_W + 2 * W_LAYER <= WS_XB && WS_XB + (size_t)T * D * 2 <= WS_PROJ && WS_PROJ + (size_t)T * PROJ_LD * 2 <= WS_AUX && WS_AUX + (size_t)T * AUX_LD * 4 <= WS_R2, "ws map");
static_assert((size_t)T * DFF * 2 <= WS_AUX - WS_PROJ && (size_t)T * D * 4 <= WS_AUX - WS_PROJ && WS_CARRY + 2 * MiB <= WS_END && (size_t)T * D * 4 <= WS_END - WS_R2, "ws overlays");
constexpr int CW_BAR = 4096;

constexpr int RING_OFF = 0, RING_BYTES = 131072;
constexpr int LDSCTL_OFF = RING_BYTES, MISC_OFF = LDSCTL_OFF + 320;
constexpr int LDS_BYTES = 147456;
constexpr int LDS_DCNT = LDSCTL_OFF + 1024, LDS_DTHR = LDS_DCNT + 128, LDS_HIST = LDSCTL_OFF + 2048;

#define GAS __attribute__((address_space(1)))
#define LAS __attribute__((address_space(3)))
typedef unsigned short bf16;
typedef unsigned v4u __attribute__((ext_vector_type(4)));
typedef unsigned v2u __attribute__((ext_vector_type(2)));
typedef float f32x4 __attribute__((ext_vector_type(4)));
typedef GAS unsigned gu32;
typedef _Float16 h16x8 __attribute__((ext_vector_type(8)));
typedef float f32x16 __attribute__((ext_vector_type(16)));
#define RLX_AGENT __ATOMIC_RELAXED, __HIP_MEMORY_SCOPE_AGENT
#define LDS_WAIT() asm volatile("s_waitcnt lgkmcnt(0)" ::: "memory")
#define VM_WAIT() asm volatile("s_waitcnt vmcnt(0)" ::: "memory")
__device__ __forceinline__ unsigned f2bf(float f) { unsigned u = __builtin_bit_cast(unsigned, f); return (u + 0x7fffu + ((u >> 16) & 1u)) >> 16; }
__device__ __forceinline__ unsigned pk2(float lo, float hi) { return f2bf(lo) | (f2bf(hi) << 16); }
__device__ __forceinline__ float bf2f(unsigned short h) { return __builtin_bit_cast(float, (unsigned)h << 16); }
__device__ __forceinline__ float bflo(unsigned w) { return __builtin_bit_cast(float, w << 16); }
__device__ __forceinline__ float bfhi(unsigned w) { return __builtin_bit_cast(float, w & 0xffff0000u); }

#define XB_TMO      128
#define XB_XCNT(j)  (256  + 64 * (j))
#define XB_XSUB(j)  (1280 + 64 * (j))
#define XB_XGEN(j)  (2304 + 64 * (j))
#define XB_TOP      3328
#define XB_TOPGEN   3392
#define XCD_BAR_WORDS 3456
#define XB_SPIN_CAP (1u << 18)

__device__ __forceinline__ unsigned xb_ld(unsigned* p)              { return __hip_atomic_load(p, __ATOMIC_RELAXED, __HIP_MEMORY_SCOPE_AGENT); }
__device__ __forceinline__ unsigned xb_add(unsigned* p, unsigned v) { return __hip_atomic_fetch_add(p, v, __ATOMIC_RELAXED, __HIP_MEMORY_SCOPE_AGENT); }
__device__ __forceinline__ unsigned xb_xcc_id() { return (unsigned)__builtin_amdgcn_s_getreg((3 << 11) | 20) & 0xFu; }
#define XB_SPIN(cond, bar) do { unsigned _sp = 0; while (cond) { __builtin_amdgcn_s_sleep(1); \
    if ((++_sp & 255u) == 0u) { if (xb_ld(&(bar)[XB_TMO])) break; if (_sp > XB_SPIN_CAP) { atomicAdd(&(bar)[XB_TMO], 1u); break; } } } } while (0)

struct XcdBarrier {
    unsigned* bar; unsigned x; int wave;
    volatile LAS unsigned* st;
};

__device__ __forceinline__ XcdBarrier xcd_barrier_post(unsigned* bar, volatile LAS unsigned* st, int wave) {
    XcdBarrier b; b.bar = bar; b.x = xb_xcc_id(); b.st = st; b.wave = wave;
    if (wave == 0 && __builtin_amdgcn_mbcnt_hi(~0u, __builtin_amdgcn_mbcnt_lo(~0u, 0u)) == 0u) (void)xb_add(&bar[XB_XCNT(b.x)], 1u);
    return b;
}
__device__ __forceinline__ void xcd_barrier_complete(unsigned* bar, unsigned x, unsigned& nloc, unsigned& nx) {
    const unsigned G = gridDim.x * gridDim.y * gridDim.z;
    unsigned sum, cnt, mine, sp = 0u;
    for (;;) {
        sum = 0u; cnt = 0u; mine = 0u;
#pragma unroll
        for (unsigned j = 0; j < 16; ++j) { const unsigned c = xb_ld(&bar[XB_XCNT(j)]); sum += c; cnt += (c > 0u) ? 1u : 0u; mine = (j == x) ? c : mine; }
        if (sum == G) break;
        __builtin_amdgcn_s_sleep(1);
        if ((++sp & 255u) == 0u) { if (xb_ld(&bar[XB_TMO])) break; if (sp > XB_SPIN_CAP) { atomicAdd(&bar[XB_TMO], 1u); break; } }
    }
    nloc = mine > 0u ? mine : 1u; nx = cnt > 0u ? cnt : 1u;
}

__device__ __forceinline__ void xcd_barrier(const XcdBarrier& b) {
    asm volatile("s_waitcnt vmcnt(0)" ::: "memory");
    __syncthreads();
    if (b.wave == 0 && __builtin_amdgcn_mbcnt_hi(~0u, __builtin_amdgcn_mbcnt_lo(~0u, 0u)) == 0u) {
        unsigned* bar = b.bar;
        __builtin_amdgcn_s_waitcnt(0);
        unsigned nloc = b.st[0], nx = b.st[1];
        if (nloc == 0u) { xcd_barrier_complete(bar, b.x, nloc, nx); b.st[0] = nloc; b.st[1] = nx; }
        const unsigned old = xb_add(&bar[XB_XSUB(b.x)], 1u);
        const unsigned gen = old / nloc;
        if (old + 1u == (gen + 1u) * nloc) {
            __builtin_amdgcn_fence(__ATOMIC_RELEASE, "agent");
            asm volatile("s_waitcnt vmcnt(0)" ::: "memory");
            const unsigned og = xb_add(&bar[XB_TOP], 1u);
            const unsigned tg = og / nx;
            if (og + 1u == (tg + 1u) * nx) xb_add(&bar[XB_TOPGEN], 1u);
            else XB_SPIN(xb_ld(&bar[XB_TOPGEN]) == tg, bar);
            __builtin_amdgcn_fence(__ATOMIC_ACQUIRE, "agent");
            xb_add(&bar[XB_XGEN(b.x)], 1u);
            asm volatile("s_waitcnt vmcnt(0)" ::: "memory");
        } else {
            XB_SPIN(xb_ld(&bar[XB_XGEN(b.x)]) == gen, bar);
            __builtin_amdgcn_fence(__ATOMIC_ACQUIRE, "agent");
            asm volatile("s_waitcnt vmcnt(0)" ::: "memory");
        }
    }
    __syncthreads();
}


struct Args { const float* in[N_INPUTS]; float* out; unsigned char* ws; int ph_lo, ph_hi; };
struct Frame {
    unsigned char* lds;
    int tid, lane, wave, G;
    float* out; unsigned char* ws;
};
__device__ __forceinline__ bf16* w_ptr(const Frame& F, int l, size_t off) { return (bf16*)(F.ws + WS_W + (size_t)l * W_LAYER + off); }

__device__ __forceinline__ float wave_sum(float v) {
#pragma unroll
    for (int o = 1; o < 64; o <<= 1) v += __shfl_xor(v, o);
    return v;
}

__device__ __forceinline__ void transpose_item(const float* W, int K, int N, bf16* Wt, float* scr, int kb, int rb, int lane, int sc, float scale = 1.f) {
    const int k0 = 64 * kb, r0 = 32 * rb, rl = lane & 31;
#pragma unroll 8
    for (int i = 0; i < 32; ++i) { const int kk = 2 * i + (lane >> 5); scr[kk * 33 + rl] = sc >= 0 ? W[(size_t)(k0 + kk) * N + sc] * scale : 0.f; }
    LDS_WAIT(); asm volatile("" ::: "memory");
    const int c = lane & 7;
#pragma unroll
    for (int j = 0; j < 4; ++j) { const int n = (lane >> 3) + 8 * j; const float* s = scr + (8 * c) * 33 + n;
        v4u o; o.x = pk2(s[0 * 33], s[1 * 33]); o.y = pk2(s[2 * 33], s[3 * 33]); o.z = pk2(s[4 * 33], s[5 * 33]); o.w = pk2(s[6 * 33], s[7 * 33]);
        *(v4u*)(Wt + (size_t)(r0 + n) * K + k0 + 8 * c) = o; }
    LDS_WAIT(); asm volatile("" ::: "memory");
}
__device__ __forceinline__ int win_src(int r) {
    if (r < 2048) return r;
    if (r < 3200) return r + 16;
    if (r < 3328) return -1;
    if (r < 3344) return 2048 + (r - 3328);
    if (r < 3508) return 3216 + (r - 3344);
    return -1;
}
__device__ __forceinline__ void p0_prologue(Frame& F, const Args& A) {
    float* scr = (float*)(F.lds + RING_OFF + F.wave * 16384);
    const int gw = blockIdx.x * NWAVES + F.wave, NGW = F.G * NWAVES;
    constexpr int I_IN = 16 * (NIN / 32), I_OUT = 16 * (D / 32), I_GU = 16 * (NGU / 32), I_D = (DFF / 64) * (D / 32), I_L = I_IN + I_OUT + I_GU + I_D;
    for (int it = gw; it < DEPTH * I_L; it += NGW) {
        const int l = it / I_L; int r = it % I_L;
        if (r < I_IN) { const int kb = r / (NIN / 32), rb = r % (NIN / 32); const int row_ = rb * 32 + (F.lane & 31);
            transpose_item(A.in[I_WIN] + (size_t)l * D * 3380, D, 3380, w_ptr(F, l, WO_IN), scr, kb, rb, F.lane, win_src(row_), (row_ >= PC_DQ && row_ < PC_DQ + 384) ? 0.125f * 1.4426950408889634f : 1.f); continue; } r -= I_IN;
        if (r < I_OUT) { const int kb = r / (D / 32), rb = r % (D / 32); transpose_item(A.in[I_WOUT] + (size_t)l * D * D, D, D, w_ptr(F, l, WO_OUT), scr, kb, rb, F.lane, rb * 32 + (F.lane & 31)); continue; } r -= I_OUT;
        if (r < I_GU) { const int kb = r / (NGU / 32), rb = r % (NGU / 32); const int row = rb * 32 + (F.lane & 31), tile = row >> 8, w = row & 255; const bool up = w >= 128;
            transpose_item(A.in[up ? I_WFU : I_WFG] + (size_t)l * D * DFF, D, DFF, w_ptr(F, l, WO_GU), scr, kb, rb, F.lane, tile * 128 + (w & 127)); continue; } r -= I_GU;
        { const int kb = r / (D / 32), rb = r % (D / 32); transpose_item(A.in[I_WFD] + (size_t)l * DFF * D, DFF, D, w_ptr(F, l, WO_D), scr, kb, rb, F.lane, rb * 32 + (F.lane & 31)); }
    }
    const float* x = A.in[I_X]; bf16* xb = (bf16*)(F.ws + WS_XB);
    for (int m = gw; m < T; m += NGW) {
        const f32x4* xr = (const f32x4*)(x + (size_t)m * D) + F.lane; unsigned long long* o8 = (unsigned long long*)(xb + (size_t)m * D) + F.lane;
#pragma unroll
        for (int j = 0; j < 4; ++j) { const f32x4 v = xr[64 * j]; o8[64 * j] = (unsigned long long)pk2(v.x, v.y) | ((unsigned long long)pk2(v.z, v.w) << 32); }
    }
}

__device__ __forceinline__ void ln_phase(Frame& F, const float* V, const float* g, const float* b, float* xf, bf16* xb) {
    const int gw = blockIdx.x * NWAVES + F.wave, NGW = F.G * NWAVES;
    f32x4 gv[4], bv[4];
#pragma unroll
    for (int j = 0; j < 4; ++j) { gv[j] = ((const f32x4*)g)[F.lane + 64 * j]; bv[j] = ((const f32x4*)b)[F.lane + 64 * j]; }
    for (int m = gw; m < T; m += NGW) {
        const f32x4* xr = (const f32x4*)(V + (size_t)m * D) + F.lane;
        f32x4 v[4]; float s = 0.f;
#pragma unroll
        for (int j = 0; j < 4; ++j) { v[j] = xr[64 * j]; s += (v[j].x + v[j].y) + (v[j].z + v[j].w); }
        const float mean = wave_sum(s) * (1.f / D); float s2 = 0.f;
#pragma unroll
        for (int j = 0; j < 4; ++j) { v[j] = v[j] - mean; s2 += (v[j].x * v[j].x + v[j].y * v[j].y) + (v[j].z * v[j].z + v[j].w * v[j].w); }
        const float rstd = 1.f / sqrtf(wave_sum(s2) * (1.f / D) + LN_EPS);
        f32x4* of = (f32x4*)(xf + (size_t)m * D) + F.lane; unsigned long long* o8 = (unsigned long long*)(xb + (size_t)m * D) + F.lane;
#pragma unroll
        for (int j = 0; j < 4; ++j) { const f32x4 o = v[j] * rstd * gv[j] + bv[j]; of[64 * j] = o; o8[64 * j] = (unsigned long long)pk2(o.x, o.y) | ((unsigned long long)pk2(o.z, o.w) << 32); }
    }
}

__device__ __forceinline__ float sigmoidf_(float x) { return 1.f / (1.f + expf(-x)); }
__device__ __forceinline__ float gelu_tanh(float x) { const float u = 0.7978845608028654f * (x + 0.044715f * x * x * x); return 0.5f * x * (1.f + tanhf(u)); }
__device__ __forceinline__ void lru_item(Frame& F, const Args& A, int l, int it, bool fin) {
    float* XC = (float*)(F.lds + RING_OFF);
    const bf16* proj = (const bf16*)(F.ws + WS_PROJ);
    const int b = it >> 9, t0 = (it & 511) * 32, c = F.tid & 255, half = F.tid >> 8, ts = t0 + half * 16, ck = ts >> 4;
    const float* cw = A.in[I_CONVW] + (size_t)l * 4 * 256; const float cb = A.in[I_CONVB][l * 256 + c];
    const float w0 = cw[c], w1 = cw[256 + c], w2 = cw[512 + c], w3 = cw[768 + c];
    __syncthreads();
    {
        float xm3 = 0.f, xm2 = 0.f, xm1 = 0.f;
        if (ts >= 3) { xm3 = bf2f(proj[(size_t)(b * SEQ + ts - 3) * PROJ_LD + PC_LX + c]); xm2 = bf2f(proj[(size_t)(b * SEQ + ts - 2) * PROJ_LD + PC_LX + c]); xm1 = bf2f(proj[(size_t)(b * SEQ + ts - 1) * PROJ_LD + PC_LX + c]); }
#pragma unroll 4
        for (int i = 0; i < 16; ++i) { const float x0 = bf2f(proj[(size_t)(b * SEQ + ts + i) * PROJ_LD + PC_LX + c]);
            XC[(half * 16 + i) * 256 + c] = cb + w0 * xm3 + w1 * xm2 + w2 * xm1 + w3 * x0; xm3 = xm2; xm2 = xm1; xm1 = x0; }
    }
    __syncthreads();
    const int n = c >> 6, j = c & 63;
    const float* wa = A.in[I_WA] + (size_t)l * 4 * 64 * 64 + (size_t)n * 64 * 64 + j; const float* wx = A.in[I_WX] + (size_t)l * 4 * 64 * 64 + (size_t)n * 64 * 64 + j;
    const float ba = A.in[I_BA][l * 256 + c], bx = A.in[I_BX][l * 256 + c], lam = A.in[I_LAM][l * 256 + c];
    const float sp8 = -8.f * log1pf(expf(-lam));
    float h = 0.f, P = 1.f;
    if (fin) h = ((const float*)(F.ws + WS_CARRY))[(size_t)(b * 256 + c) * 1024 + ck];
    float rp[16], ip[16];
#pragma unroll
    for (int i = 0; i < 16; ++i) { rp[i] = ba; ip[i] = bx; }
    for (int k = 0; k < 64; ++k) { const float a_ = wa[k * 64], x_ = wx[k * 64];
#pragma unroll
        for (int i = 0; i < 16; ++i) { const float xv = XC[(half * 16 + i) * 256 + n * 64 + k]; rp[i] += xv * a_; ip[i] += xv * x_; } }
    bf16* Y = (bf16*)(F.ws + WS_Y);
#pragma unroll
    for (int i = 0; i < 16; ++i) {
        const float xc = XC[(half * 16 + i) * 256 + c];
        const float r = sigmoidf_(rp[i]), ig = sigmoidf_(ip[i]);
        const float la = sp8 * r, a = expf(la), u = sqrtf(-expm1f(2.f * la)) * (ig * xc);
        h = a * h + u; P *= a;
        if (fin) { const size_t tok = (size_t)(b * SEQ + ts + i); const float g = bf2f(proj[tok * PROJ_LD + PC_LG + c]); Y[tok * D + YC_LRU + c] = (bf16)f2bf(h * gelu_tanh(g)); }
    }
    if (!fin) { float2* S = (float2*)(F.ws + WS_LSUM); S[(size_t)(b * 256 + c) * 1024 + ck] = make_float2(P, h); }
}
__device__ __forceinline__ void lru_scan_row(Frame& F, int row) {
    const float2* S = (const float2*)(F.ws + WS_LSUM) + (size_t)row * 1024 + F.lane * 16; float* C = (float*)(F.ws + WS_CARRY) + (size_t)row * 1024 + F.lane * 16;
    float2 e[16];
#pragma unroll
    for (int i = 0; i < 16; ++i) e[i] = S[i];
    float P = 1.f, h = 0.f;
#pragma unroll
    for (int i = 0; i < 16; ++i) { h = e[i].x * h + e[i].y; P *= e[i].x; }
#pragma unroll
    for (int o = 1; o < 64; o <<= 1) { const float Pp = __shfl_up(P, o), hp = __shfl_up(h, o); if (F.lane >= o) { h = P * hp + h; P = Pp * P; } }
    float hc = __shfl_up(h, 1); if (F.lane == 0) hc = 0.f;
#pragma unroll
    for (int i = 0; i < 16; ++i) { C[i] = hc; hc = e[i].x * hc + e[i].y; }
}

__device__ __forceinline__ void gla_item(Frame& F, const Args& A, int l, int it, bool fin) {
    constexpr int LP = 65;
    float* bc = (float*)(F.lds + RING_OFF); float* qd = bc + 64 * LP; float* ki = qd + 64 * LP; float* ke = ki + 64 * LP; float* vv = ke + 64 * LP; float* att = vv + 64 * LP;
    float* glr = att + 64 * LP; float* w2 = glr + 1024; float* bg = w2 + 1024;
    const int b = it / 1536, r_ = it % 1536, n = r_ / 6, h = r_ % 6; const size_t tok0 = (size_t)b * SEQ + (size_t)n * 64;
    const bf16* proj = (const bf16*)(F.ws + WS_PROJ); const float* aux = (const float*)(F.ws + WS_AUX);
    float* U = (float*)(F.ws + WS_GLAU) + (size_t)it * 4096; float* DEC = (float*)(F.ws + WS_DEC) + (size_t)it * 64;
    const int tid = F.tid;
    __syncthreads();
    for (int i = tid; i < 1024; i += NTHR) { const int c = i >> 4, r = i & 15; glr[i] = aux[(tok0 + c) * AUX_LD + AC_GLR + r]; }
    for (int i = tid; i < 1024; i += NTHR) { const int r = i >> 6, d = i & 63; w2[i] = A.in[I_WG2][(size_t)l * 16 * 384 + r * 384 + h * 64 + d]; }
    if (tid < 64) bg[tid] = A.in[I_BG][l * 384 + h * 64 + tid];
    __syncthreads();
    for (int e = tid; e < 4096; e += NTHR) { const int c = e >> 6, d = e & 63; float z = bg[d];
#pragma unroll
        for (int r = 0; r < 16; ++r) z += glr[c * 16 + r] * w2[r * 64 + d];
        bc[c * LP + d] = (fminf(z, 0.f) - log1pf(expf(-fabsf(z)))) * (1.f / 16.f); }
    __syncthreads();
    if (tid < 64) { float s = 0.f; for (int c = 0; c < 64; ++c) { s += bc[c * LP + tid]; bc[c * LP + tid] = s; } }
    __syncthreads();
    for (int e = tid; e < 4096; e += NTHR) { const int c = e >> 6, d = e & 63; const float b_ = bc[c * LP + d], bl = bc[63 * LP + d];
        const bf16* row = proj + (tok0 + c) * PROJ_LD + h * 64 + d;
        const float q = bf2f(row[PC_GQ]), k = bf2f(row[PC_GK]), v = bf2f(row[PC_GV]);
        qd[c * LP + d] = q * 0.125f * expf(b_); ki[c * LP + d] = k * expf(-b_); ke[c * LP + d] = k * expf(bl - b_); vv[c * LP + d] = v; }
    __syncthreads();
    if (!fin) {
        const int d = tid >> 3, dv0 = (tid & 7) * 8; float acc[8];
#pragma unroll
        for (int j = 0; j < 8; ++j) acc[j] = 0.f;
        for (int c = 0; c < 64; ++c) { const float kd = ke[c * LP + d];
#pragma unroll
            for (int j = 0; j < 8; ++j) acc[j] += kd * vv[c * LP + dv0 + j]; }
#pragma unroll
        for (int j = 0; j < 8; ++j) U[d * 64 + dv0 + j] = acc[j];
        if (tid < 64) DEC[tid] = expf(bc[63 * LP + tid]);
    } else {
        const int c = tid >> 3, s0 = (tid & 7) * 8, dv0 = s0; float a[8];
#pragma unroll
        for (int j = 0; j < 8; ++j) a[j] = 0.f;
        for (int d = 0; d < 64; ++d) { const float qv = qd[c * LP + d];
#pragma unroll
            for (int j = 0; j < 8; ++j) a[j] += qv * ki[(s0 + j) * LP + d]; }
#pragma unroll
        for (int j = 0; j < 8; ++j) att[c * LP + s0 + j] = (s0 + j <= c) ? a[j] : 0.f;
        for (int e = tid; e < 4096; e += NTHR) ke[(e >> 6) * LP + (e & 63)] = U[e];
        __syncthreads();
        float o[8];
#pragma unroll
        for (int j = 0; j < 8; ++j) o[j] = 0.f;
        for (int s = 0; s < 64; ++s) { const float av = att[c * LP + s];
#pragma unroll
            for (int j = 0; j < 8; ++j) o[j] += av * vv[s * LP + dv0 + j]; }
        for (int d = 0; d < 64; ++d) { const float qv = qd[c * LP + d];
#pragma unroll
            for (int j = 0; j < 8; ++j) o[j] += qv * ke[d * LP + dv0 + j]; }
        float ss = 0.f;
#pragma unroll
        for (int j = 0; j < 8; ++j) ss += o[j] * o[j];
        ss += __shfl_xor(ss, 1); ss += __shfl_xor(ss, 2); ss += __shfl_xor(ss, 4);
        const float rs = 1.f / sqrtf(ss * (1.f / 64.f) + 1e-6f);
        const bf16* grow = proj + (tok0 + c) * PROJ_LD + PC_GG + h * 64 + dv0; const float* ng = A.in[I_NG] + l * 384 + h * 64 + dv0;
        float y[8];
#pragma unroll
        for (int j = 0; j < 8; ++j) { const float g = bf2f(grow[j]); y[j] = o[j] * rs * ng[j] * (g / (1.f + expf(-g))); }
        v4u w; w.x = pk2(y[0], y[1]); w.y = pk2(y[2], y[3]); w.z = pk2(y[4], y[5]); w.w = pk2(y[6], y[7]);
        *(v4u*)((bf16*)(F.ws + WS_Y) + (tok0 + c) * D + YC_GLA + h * 64 + dv0) = w;
    }
}
__device__ __forceinline__ void gla_scan(Frame& F, int e) {
    const int bh = e >> 12, idx = e & 4095, d = idx >> 6, b = bh / 6, h = bh % 6;
    float* U = (float*)(F.ws + WS_GLAU); const float* DEC = (const float*)(F.ws + WS_DEC);
    float S = 0.f;
    for (int n0 = 0; n0 < 256; n0 += 8) {
        float u[8], dc[8];
#pragma unroll
        for (int i = 0; i < 8; ++i) { const size_t it = (size_t)b * 1536 + (size_t)(n0 + i) * 6 + h; u[i] = U[it * 4096 + idx]; dc[i] = DEC[it * 64 + d]; }
#pragma unroll
        for (int i = 0; i < 8; ++i) { const size_t it = (size_t)b * 1536 + (size_t)(n0 + i) * 6 + h; U[it * 4096 + idx] = S; S = dc[i] * S + u[i]; }
    }
}

__device__ __forceinline__ unsigned f2ord(float f) { const unsigned u = __builtin_bit_cast(unsigned, f); return u ^ ((u >> 31) ? 0xffffffffu : 0x80000000u); }
__device__ __forceinline__ float ord2f(unsigned v) { const unsigned u = (v & 0x80000000u) ? (v ^ 0x80000000u) : ~v; return __builtin_bit_cast(float, u); }
__device__ __forceinline__ int popc64(unsigned long long m) { return __builtin_popcountll(m); }
__device__ __forceinline__ int t5_bucket(int n) { if (n < 16) return n; const int v = 16 + (int)(__log2f((float)n * (1.f / 16.f)) * (16.f / 3.f)); return v < 31 ? v : 31; }
__device__ __forceinline__ unsigned dsa_compact(v2u* buf, int n, int lane) {
    unsigned o[8], id[8];
#pragma unroll
    for (int j = 0; j < 8; ++j) { const int e = j * 64 + lane; if (e < n) { const v2u x = buf[e]; o[j] = x.x; id[j] = x.y; } else { o[j] = 0u; id[j] = 0u; } }
    unsigned v = 0u;
    for (int bit = 31; bit >= 0; --bit) { const unsigned cand = v | (1u << bit); int c = 0;
#pragma unroll
        for (int j = 0; j < 8; ++j) c += popc64(__ballot(o[j] >= cand));
        if (c >= 256) v = cand; }
    int ngt = 0;
#pragma unroll
    for (int j = 0; j < 8; ++j) ngt += popc64(__ballot(o[j] > v));
    const int need = 256 - ngt; int outp = 0, tie_seen = 0;
    const unsigned long long lt = (1ull << lane) - 1ull;
#pragma unroll
    for (int j = 0; j < 8; ++j) {
        const bool isgt = o[j] > v, iseq = o[j] == v;
        const unsigned long long eqm = __ballot(iseq);
        const bool keep = isgt || (iseq && (tie_seen + popc64(eqm & lt)) < need);
        const unsigned long long km = __ballot(keep);
        if (keep) { v2u x; x.x = o[j]; x.y = id[j]; buf[outp + popc64(km & lt)] = x; }
        outp += popc64(km); tie_seen += popc64(eqm);
    }
    return v;
}
__device__ __forceinline__ void dsa_query(Frame& F, const Args& A, int l, int qg) {
    const int lane = F.lane, b = qg >> 14, t = qg & (SEQ - 1);
    float* qs = (float*)(F.lds + RING_OFF + F.wave * 5120); v2u* buf = (v2u*)(F.lds + RING_OFF + F.wave * 5120 + 512 + 512);
    const float* aux = (const float*)(F.ws + WS_AUX); const bf16* proj = (const bf16*)(F.ws + WS_PROJ);
    const float* arow = aux + (size_t)qg * AUX_LD;
    qs[lane] = arow[AC_IQ + lane]; qs[64 + lane] = arow[AC_IQ + 64 + lane];
    float wv[4];
#pragma unroll
    for (int i = 0; i < 4; ++i) wv[i] = arow[AC_IW + i] * 0.5f;
    LDS_WAIT(); asm volatile("" ::: "memory");
    int cnt = 0; float thr = -INFINITY;
    const int ntile = (t >> 6) + 1;
    const unsigned long long lt = (1ull << lane) - 1ull;
    for (int tile = 0; tile < ntile; ++tile) {
        const int s = tile * 64 + lane; const bool valid = s <= t; const int sc = valid ? s : t;
        const f32x4* kp = (const f32x4*)(aux + ((size_t)b * SEQ + sc) * AUX_LD + AC_IK);
        f32x4 k[8];
#pragma unroll
        for (int j = 0; j < 8; ++j) k[j] = kp[j];
        float score = 0.f;
#pragma unroll
        for (int i = 0; i < 4; ++i) { float d = 0.f;
#pragma unroll
            for (int j = 0; j < 8; ++j) { const f32x4 q4 = *(const f32x4*)(qs + i * 32 + j * 4); d += q4.x * k[j].x; d += q4.y * k[j].y; d += q4.z * k[j].z; d += q4.w * k[j].w; }
            score += fmaxf(d, 0.f) * 0.17677669529663687f * wv[i]; }
        score += 0.f;
        const bool pass = valid && (score > thr);
        const unsigned long long pm = __ballot(pass);
        if (pass) { v2u x; x.x = f2ord(score); x.y = (unsigned)s; buf[cnt + popc64(pm & lt)] = x; }
        cnt += popc64(pm);
        if (cnt > 512 - 64) { LDS_WAIT(); asm volatile("" ::: "memory"); thr = ord2f(dsa_compact(buf, cnt, lane)); cnt = 256; LDS_WAIT(); asm volatile("" ::: "memory"); }
    }
    LDS_WAIT(); asm volatile("" ::: "memory");
    if (cnt > 256) { dsa_compact(buf, cnt, lane); cnt = 256; LDS_WAIT(); asm volatile("" ::: "memory"); }
    const int hh = lane >> 3, h = hh < 6 ? hh : 5, dp = lane & 7;
    float q8[8];
    { const v4u qw = *(const v4u*)(proj + (size_t)qg * PROJ_LD + PC_DQ + h * 64 + dp * 8);
      q8[0] = bflo(qw.x) * 0.125f; q8[1] = bfhi(qw.x) * 0.125f; q8[2] = bflo(qw.y) * 0.125f; q8[3] = bfhi(qw.y) * 0.125f; q8[4] = bflo(qw.z) * 0.125f; q8[5] = bfhi(qw.z) * 0.125f; q8[6] = bflo(qw.w) * 0.125f; q8[7] = bfhi(qw.w) * 0.125f; }
    const float* rb = A.in[I_RB];
    float m = -INFINITY, lsum = 0.f, o[8];
#pragma unroll
    for (int i = 0; i < 8; ++i) o[i] = 0.f;
    const bf16* kvbase = proj + (size_t)b * SEQ * PROJ_LD + PC_DK + h * 64 + dp * 8;
    for (int j0 = 0; j0 < cnt; j0 += 8) {
        v4u kw[8], vw[8]; int ss[8];
#pragma unroll
        for (int u = 0; u < 8; ++u) { const int j = (j0 + u < cnt) ? j0 + u : cnt - 1; ss[u] = (int)buf[j].y; const bf16* kr = kvbase + (size_t)ss[u] * PROJ_LD; kw[u] = *(const v4u*)kr; vw[u] = *(const v4u*)(kr + 384); }
#pragma unroll
        for (int u = 0; u < 8; ++u) if (j0 + u < cnt) {
            float dot = q8[0] * bflo(kw[u].x) + q8[1] * bfhi(kw[u].x) + q8[2] * bflo(kw[u].y) + q8[3] * bfhi(kw[u].y) + q8[4] * bflo(kw[u].z) + q8[5] * bfhi(kw[u].z) + q8[6] * bflo(kw[u].w) + q8[7] * bfhi(kw[u].w);
            dot += __shfl_xor(dot, 1); dot += __shfl_xor(dot, 2); dot += __shfl_xor(dot, 4);
            const float logit = dot + rb[t5_bucket(t - ss[u]) * 6 + h];
            const float mn = fmaxf(m, logit), sc = expf(m - mn), p = expf(logit - mn);
            lsum = lsum * sc + p; m = mn;
            o[0] = o[0] * sc + p * bflo(vw[u].x); o[1] = o[1] * sc + p * bfhi(vw[u].x); o[2] = o[2] * sc + p * bflo(vw[u].y); o[3] = o[3] * sc + p * bfhi(vw[u].y);
            o[4] = o[4] * sc + p * bflo(vw[u].z); o[5] = o[5] * sc + p * bfhi(vw[u].z); o[6] = o[6] * sc + p * bflo(vw[u].w); o[7] = o[7] * sc + p * bfhi(vw[u].w);
        }
    }
    const float inv = 1.f / lsum;
    if (hh < 6) { v4u w; w.x = pk2(o[0] * inv, o[1] * inv); w.y = pk2(o[2] * inv, o[3] * inv); w.z = pk2(o[4] * inv, o[5] * inv); w.w = pk2(o[6] * inv, o[7] * inv);
        *(v4u*)((bf16*)(F.ws + WS_Y) + (size_t)qg * D + YC_DSA + h * 64 + dp * 8) = w; }
}

typedef short gbf16x8 __attribute__((ext_vector_type(8)));
__device__ __forceinline__ gbf16x8 gla_frag(const unsigned short* tile, int row, int k0) { return *(const gbf16x8*)(tile + row * 72 + k0); }
__device__ __forceinline__ void gla_item2(Frame& F, const Args& A, int l, int it, bool fin) {
    constexpr int LP = 65, TS = 64 * 72;
    float* bc = (float*)(F.lds + RING_OFF); float* Ot = bc + 64 * LP; float* glr = Ot + 64 * LP; float* w2 = glr + 1024; float* bg = w2 + 1024;
    unsigned short* T_QD = (unsigned short*)(bg + 64); unsigned short* T_KI = T_QD + TS; unsigned short* T_KET = T_KI + TS; unsigned short* T_VT = T_KET + TS; unsigned short* T_ATT = T_VT + TS; unsigned short* T_ST = T_ATT + TS;
    const int b = it / 1536, r_ = it % 1536, n = r_ / 6, h = r_ % 6; const size_t tok0 = (size_t)b * SEQ + (size_t)n * 64;
    const bf16* proj = (const bf16*)(F.ws + WS_PROJ); const float* aux = (const float*)(F.ws + WS_AUX);
    float* U = (float*)(F.ws + WS_GLAU) + (size_t)it * 4096; float* DEC = (float*)(F.ws + WS_DEC) + (size_t)it * 64;
    const int tid = F.tid, lane = F.lane, wave = F.wave, r32 = lane & 31, hi = lane >> 5;
    __syncthreads();
    for (int i = tid; i < 1024; i += NTHR) { const int c = i >> 4, r = i & 15; glr[i] = aux[(tok0 + c) * AUX_LD + AC_GLR + r]; }
    for (int i = tid; i < 1024; i += NTHR) { const int r = i >> 6, d = i & 63; w2[i] = A.in[I_WG2][(size_t)l * 16 * 384 + r * 384 + h * 64 + d]; }
    if (tid < 64) bg[tid] = A.in[I_BG][l * 384 + h * 64 + tid];
    __syncthreads();
    { const int d = tid & 63, cg = tid >> 6; float wr[16];
#pragma unroll
      for (int r = 0; r < 16; ++r) wr[r] = w2[r * 64 + d];
      const float bgd = bg[d];
#pragma unroll
      for (int i = 0; i < 8; ++i) { const int c = cg + 8 * i; float z = bgd;
#pragma unroll
          for (int r = 0; r < 16; r += 4) { const f32x4 g4 = *(const f32x4*)(glr + c * 16 + r); z += g4.x * wr[r] + g4.y * wr[r + 1] + g4.z * wr[r + 2] + g4.w * wr[r + 3]; }
          bc[c * LP + d] = (fminf(z, 0.f) - log1pf(expf(-fabsf(z)))) * (1.f / 16.f); } }
    __syncthreads();
#pragma unroll
    for (int j = 0; j < 8; ++j) { const int d = wave * 8 + j; float x = bc[lane * LP + d];
#pragma unroll
        for (int o = 1; o < 64; o <<= 1) { const float y = __shfl_up(x, o); if (lane >= o) x += y; }
        bc[lane * LP + d] = x; }
    __syncthreads();
    for (int e = tid; e < 4096; e += NTHR) { const int c = e >> 6, d = e & 63; const float b_ = bc[c * LP + d], bl = bc[63 * LP + d];
        const bf16* row = proj + (tok0 + c) * PROJ_LD + h * 64 + d;
        const float k = bf2f(row[PC_GK]); T_VT[d * 72 + c] = row[PC_GV];
        if (fin) { const float q = bf2f(row[PC_GQ]); T_QD[c * 72 + d] = (unsigned short)f2bf(q * 0.125f * expf(b_)); T_KI[c * 72 + d] = (unsigned short)f2bf(k * expf(-b_)); T_ST[d * 72 + c] = (unsigned short)f2bf(U[e]); }
        else T_KET[d * 72 + c] = (unsigned short)f2bf(k * expf(bl - b_)); }
    __syncthreads();
    if (!fin) {
        if (wave < 4) { const int dt = wave >> 1, vt = wave & 1; f32x16 acc = {};
#pragma unroll
            for (int ks = 0; ks < 4; ++ks) acc = __builtin_amdgcn_mfma_f32_32x32x16_bf16(gla_frag(T_KET, dt * 32 + r32, ks * 16 + hi * 8), gla_frag(T_VT, vt * 32 + r32, ks * 16 + hi * 8), acc, 0, 0, 0);
#pragma unroll
            for (int r = 0; r < 16; ++r) U[(dt * 32 + (r & 3) + 8 * (r >> 2) + 4 * hi) * 64 + vt * 32 + r32] = acc[r]; }
        if (tid < 64) DEC[tid] = expf(bc[63 * LP + tid]);
    } else {
        f32x16 acc = {};
        if (wave < 4) { const int ct = wave >> 1, st = wave & 1;
#pragma unroll
            for (int ks = 0; ks < 4; ++ks) acc = __builtin_amdgcn_mfma_f32_32x32x16_bf16(gla_frag(T_QD, ct * 32 + r32, ks * 16 + hi * 8), gla_frag(T_KI, st * 32 + r32, ks * 16 + hi * 8), acc, 0, 0, 0);
#pragma unroll
            for (int r = 0; r < 16; ++r) { const int c = ct * 32 + (r & 3) + 8 * (r >> 2) + 4 * hi, s = st * 32 + r32; T_ATT[c * 72 + s] = (unsigned short)f2bf(s <= c ? acc[r] : 0.f); }
        } else { const int ct = (wave >> 1) & 1, vt = wave & 1;
#pragma unroll
            for (int ks = 0; ks < 4; ++ks) acc = __builtin_amdgcn_mfma_f32_32x32x16_bf16(gla_frag(T_QD, ct * 32 + r32, ks * 16 + hi * 8), gla_frag(T_ST, vt * 32 + r32, ks * 16 + hi * 8), acc, 0, 0, 0);
        }
        __syncthreads();
        if (wave >= 4) { const int ct = (wave >> 1) & 1, vt = wave & 1;
#pragma unroll
            for (int ks = 0; ks < 4; ++ks) acc = __builtin_amdgcn_mfma_f32_32x32x16_bf16(gla_frag(T_ATT, ct * 32 + r32, ks * 16 + hi * 8), gla_frag(T_VT, vt * 32 + r32, ks * 16 + hi * 8), acc, 0, 0, 0);
#pragma unroll
            for (int r = 0; r < 16; ++r) Ot[(ct * 32 + (r & 3) + 8 * (r >> 2) + 4 * hi) * LP + vt * 32 + r32] = acc[r]; }
        __syncthreads();
        const int c = tid >> 3, dv0 = (tid & 7) * 8; float o[8];
#pragma unroll
        for (int j = 0; j < 8; ++j) o[j] = Ot[c * LP + dv0 + j];
        float ss = 0.f;
#pragma unroll
        for (int j = 0; j < 8; ++j) ss += o[j] * o[j];
        ss += __shfl_xor(ss, 1); ss += __shfl_xor(ss, 2); ss += __shfl_xor(ss, 4);
        const float rs = 1.f / sqrtf(ss * (1.f / 64.f) + 1e-6f);
        const bf16* grow = proj + (tok0 + c) * PROJ_LD + PC_GG + h * 64 + dv0; const float* ng = A.in[I_NG] + l * 384 + h * 64 + dv0;
        float y[8];
#pragma unroll
        for (int j = 0; j < 8; ++j) { const float g = bf2f(grow[j]); y[j] = o[j] * rs * ng[j] * (g / (1.f + expf(-g))); }
        v4u w; w.x = pk2(y[0], y[1]); w.y = pk2(y[2], y[3]); w.z = pk2(y[4], y[5]); w.w = pk2(y[6], y[7]);
        *(v4u*)((bf16*)(F.ws + WS_Y) + (tok0 + c) * D + YC_GLA + h * 64 + dv0) = w;
    }
}

constexpr size_t WO_LRU = 25 * MiB + 512 * 1024;
__device__ __forceinline__ void lru_item2(Frame& F, const Args& A, int l, int it, bool fin) {
    constexpr int XP = 264;
    float* XC = (float*)(F.lds + RING_OFF);
    float* RG = XC + 32 * 256; float* IG = RG + 32 * 256;
    unsigned short* XB_ = (unsigned short*)(IG + 32 * 256);
    const bf16* proj = (const bf16*)(F.ws + WS_PROJ);
    const int b = it >> 9, t0 = (it & 511) * 32, c = F.tid & 255, half = F.tid >> 8, ts = t0 + half * 16, ck = ts >> 4;
    const int lane = F.lane, wave = F.wave, r32 = lane & 31, hi = lane >> 5;
    const float* cw = A.in[I_CONVW] + (size_t)l * 4 * 256; const float cb = A.in[I_CONVB][l * 256 + c];
    const float w0 = cw[c], w1 = cw[256 + c], w2 = cw[512 + c], w3 = cw[768 + c];
    __syncthreads();
    {
        float xm3 = 0.f, xm2 = 0.f, xm1 = 0.f;
        if (ts >= 3) { xm3 = bf2f(proj[(size_t)(b * SEQ + ts - 3) * PROJ_LD + PC_LX + c]); xm2 = bf2f(proj[(size_t)(b * SEQ + ts - 2) * PROJ_LD + PC_LX + c]); xm1 = bf2f(proj[(size_t)(b * SEQ + ts - 1) * PROJ_LD + PC_LX + c]); }
        float xv[16];
#pragma unroll
        for (int i = 0; i < 16; ++i) xv[i] = bf2f(proj[(size_t)(b * SEQ + ts + i) * PROJ_LD + PC_LX + c]);
#pragma unroll
        for (int i = 0; i < 16; ++i) { const float x0 = xv[i], v = cb + w0 * xm3 + w1 * xm2 + w2 * xm1 + w3 * x0;
            XC[(half * 16 + i) * 256 + c] = v; XB_[(half * 16 + i) * XP + c] = (unsigned short)f2bf(v); xm3 = xm2; xm2 = xm1; xm1 = x0; }
    }
    __syncthreads();
    {
        const unsigned short* WT = (const unsigned short*)w_ptr(F, l, WO_LRU);
#pragma unroll
        for (int u = 0; u < 2; ++u) { const int tI = wave * 2 + u, g = tI >> 3, n = (tI >> 1) & 3, jt = tI & 1;
            const unsigned short* wrow = WT + (size_t)g * 16384 + (size_t)n * 4096 + (size_t)(jt * 32 + r32) * 64 + hi * 8;
            f32x16 acc = {};
#pragma unroll
            for (int ks = 0; ks < 4; ++ks) acc = __builtin_amdgcn_mfma_f32_32x32x16_bf16(*(const gbf16x8*)(XB_ + r32 * XP + n * 64 + ks * 16 + hi * 8), *(const gbf16x8*)(wrow + ks * 16), acc, 0, 0, 0);
            float* G = g ? IG : RG;
#pragma unroll
            for (int r = 0; r < 16; ++r) G[((r & 3) + 8 * (r >> 2) + 4 * hi) * 256 + n * 64 + jt * 32 + r32] = acc[r]; }
    }
    __syncthreads();
    const float ba = A.in[I_BA][l * 256 + c], bx = A.in[I_BX][l * 256 + c], lam = A.in[I_LAM][l * 256 + c];
    const float sp8 = -8.f * log1pf(expf(-lam));
    float h = 0.f, P = 1.f;
    if (fin) h = ((const float*)(F.ws + WS_CARRY))[(size_t)(b * 256 + c) * 1024 + ck];
    bf16* Yp = (bf16*)(F.ws + WS_Y);
    float gv[16];
    if (fin) {
#pragma unroll
        for (int i = 0; i < 16; ++i) gv[i] = bf2f(proj[(size_t)(b * SEQ + ts + i) * PROJ_LD + PC_LG + c]);
    }
#pragma unroll
    for (int i = 0; i < 16; ++i) {
        const int tl = half * 16 + i;
        const float xc = XC[tl * 256 + c];
        const float r = sigmoidf_(RG[tl * 256 + c] + ba), ig = sigmoidf_(IG[tl * 256 + c] + bx);
        const float la = sp8 * r, a = expf(la), u = sqrtf(-expm1f(2.f * la)) * (ig * xc);
        h = a * h + u; P *= a;
        if (fin) { const size_t tok = (size_t)(b * SEQ + ts + i); Yp[tok * D + YC_LRU + c] = (bf16)f2bf(h * gelu_tanh(gv[i])); }
    }
    if (!fin) { float2* S = (float2*)(F.ws + WS_LSUM); S[(size_t)(b * 256 + c) * 1024 + ck] = make_float2(P, h); }
}
__device__ __forceinline__ void lru_weights_prologue(Frame& F, const Args& A) {
    const int gt = blockIdx.x * NTHR + F.tid, NT_ = F.G * NTHR;
    for (int e = gt; e < DEPTH * 2 * 16384; e += NT_) { const int l = e / 32768, g = (e >> 14) & 1, n = (e >> 12) & 3, j = (e >> 6) & 63, k = e & 63;
        const float v = A.in[g ? I_WX : I_WA][(size_t)l * 16384 + n * 4096 + k * 64 + j];
        ((unsigned short*)w_ptr(F, l, WO_LRU))[(size_t)g * 16384 + n * 4096 + j * 64 + k] = (unsigned short)f2bf(v); }
}

__device__ __forceinline__ int wave_suffix_incl(int v, int lane) {
#pragma unroll
    for (int o = 1; o < 64; o <<= 1) { const int t = __shfl_down(v, o); if (lane + o < 64) v += t; }
    return v;
}
template <bool EXACT> __device__ __forceinline__ unsigned dsa_topk_compact(unsigned* cand, unsigned* hist, int n, int lane, int* kept) {
    unsigned e[16];
#pragma unroll
    for (int j = 0; j < 16; ++j) { const int i = j * 64 + lane; e[j] = i < n ? cand[i] : 0u; }
    unsigned prefix = 0u;
#pragma unroll 1
    for (int bit = 31; bit >= (EXACT ? 0 : 16); --bit) { const unsigned cv = prefix | (1u << bit); int c = 0;
#pragma unroll
        for (int j = 0; j < 16; ++j) c += popc64(__ballot(e[j] >= cv));
        if (c >= 256) prefix = cv; }
    const unsigned K = prefix; int outp = 0; const unsigned long long lt = (1ull << lane) - 1ull;
#pragma unroll
    for (int j = 0; j < 16; ++j) { const bool keep = e[j] >= K && e[j] != 0u; const unsigned long long km = __ballot(keep); if (keep) cand[outp + popc64(km & lt)] = e[j]; outp += popc64(km); }
    *kept = outp;
    return K;
}
__device__ __forceinline__ unsigned dsa_kth(const unsigned* cand, int n, int m, int lane) {
    unsigned e[16];
#pragma unroll
    for (int j = 0; j < 16; ++j) { const int i = j * 64 + lane; e[j] = i < n ? cand[i] : 0u; }
    unsigned prefix = 0u; int c_at = n;
#pragma unroll 1
    for (int bit = 31; bit >= 0; --bit) {
        if (bit == 13 && c_at <= m + 4) break;
        const unsigned cv = prefix | (1u << bit); int c = 0;
#pragma unroll
        for (int j = 0; j < 16; ++j) c += popc64(__ballot(e[j] >= cv));
        if (c >= m) { prefix = cv; c_at = c; } }
    return prefix;
}
__device__ __forceinline__ void dsa_scores(const h16x8& ka0, const h16x8& ka1, const h16x8 (&qb)[4][2], const float (&wv)[4], float (&sc)[16]) {
    f32x16 acc[4];
#pragma unroll
    for (int i = 0; i < 4; ++i) { f32x16 z = {}; z = __builtin_amdgcn_mfma_f32_32x32x16_f16(ka0, qb[i][0], z, 0, 0, 0); acc[i] = __builtin_amdgcn_mfma_f32_32x32x16_f16(ka1, qb[i][1], z, 0, 0, 0); }
#pragma unroll
    for (int r = 0; r < 16; ++r) { float s_ = fmaxf(acc[0][r], 0.f) * wv[0]; s_ += fmaxf(acc[1][r], 0.f) * wv[1]; s_ += fmaxf(acc[2][r], 0.f) * wv[2]; s_ += fmaxf(acc[3][r], 0.f) * wv[3]; sc[r] = s_ + 0.f; }
}
constexpr int DSA_M = 36;
__device__ __forceinline__ void dsa_item(Frame& F, const Args& A, int l, int item) {
    const int lane = F.lane, wave = F.wave, qbase = item * 32, b = qbase >> 14, t0 = qbase & (SEQ - 1), r32 = lane & 31, hi = lane >> 5;
    unsigned* cand = (unsigned*)(F.lds + RING_OFF); unsigned* cnt = (unsigned*)(F.lds + LDS_DCNT); float* thr = (float*)(F.lds + LDS_DTHR); unsigned* hist = (unsigned*)(F.lds + LDS_HIST) + wave * 256;
    unsigned* K0a = (unsigned*)(F.lds + LDS_HIST + 8192); unsigned* flag = K0a + 32;
    const float* aux = (const float*)(F.ws + WS_AUX); const _Float16* KI = (const _Float16*)(F.ws + WS_KI) + (size_t)b * SEQ * 32;
    __syncthreads();
    if (F.tid < 32) { cnt[F.tid] = 0u; thr[F.tid] = -INFINITY; }
    if (F.tid == 0) flag[0] = 0u;
    h16x8 qb[4][2]; float wv[4];
    { const float* arow = aux + (size_t)(qbase + r32) * AUX_LD;
#pragma unroll
      for (int i = 0; i < 4; ++i) { wv[i] = arow[AC_IW + i] * (0.5f * 0.17677669529663687f);
#pragma unroll
        for (int kh = 0; kh < 2; ++kh) { const f32x4 a0 = *(const f32x4*)(arow + AC_IQ + i * 32 + kh * 16 + hi * 8), a1 = *(const f32x4*)(arow + AC_IQ + i * 32 + kh * 16 + hi * 8 + 4);
            h16x8 v; v[0] = (_Float16)a0[0]; v[1] = (_Float16)a0[1]; v[2] = (_Float16)a0[2]; v[3] = (_Float16)a0[3]; v[4] = (_Float16)a1[0]; v[5] = (_Float16)a1[1]; v[6] = (_Float16)a1[2]; v[7] = (_Float16)a1[3]; qb[i][kh] = v; } } }
    __syncthreads();
    const int ntile = (t0 >> 5) + 1, nround = (ntile + 7) >> 3;
    unsigned* cq = cand + r32 * 1024;
    bool need_stream = true;
#ifndef DSA_NO_FAST
    if (ntile > 32) {
#pragma unroll 1
        for (int i = wave; 16 * i + 7 < ntile - 1; i += 8) { const int j = 16 * i + 7;
            const _Float16* kp = KI + (size_t)(j * 32 + r32) * 32 + hi * 8; const h16x8 ka0 = *(const h16x8*)kp, ka1 = *(const h16x8*)(kp + 16);
            float sc[16]; dsa_scores(ka0, ka1, qb, wv, sc);
            unsigned slot = atomicAdd(&cnt[r32], 16u);
#pragma unroll
            for (int r = 0; r < 16; ++r) { const int s = j * 32 + 8 * (r >> 2) + 4 * hi + (r & 3); cq[slot + r] = (f2ord(sc[r]) & 0xffffc000u) | (unsigned)(16383 - s); } }
        __syncthreads();
#pragma unroll 1
        for (int qi = 0; qi < 4; ++qi) { const int q = wave * 4 + qi; const int ns = (int)cnt[q]; unsigned K0 = 0u;
            if (ns > DSA_M) K0 = dsa_kth(cand + q * 1024, ns, DSA_M, lane);
            if (lane == 0) { K0a[q] = K0; thr[q] = K0 ? ord2f(K0 & 0xffffc000u) : -INFINITY; } }
        __syncthreads();
        const unsigned K0q = K0a[r32]; const float thf = thr[r32];
        __syncthreads();
        if (F.tid < 32) cnt[F.tid] = 0u;
        __syncthreads();
        h16x8 kn0 = {}, kn1 = {};
        { const _Float16* kp = KI + (size_t)(wave * 32 + r32) * 32 + hi * 8; kn0 = *(const h16x8*)kp; kn1 = *(const h16x8*)(kp + 16); }
#pragma unroll 1
        for (int j = wave; j < ntile; j += 8) {
            const h16x8 ka0 = kn0, ka1 = kn1;
            if (j + 8 < ntile) { const _Float16* kp = KI + (size_t)((j + 8) * 32 + r32) * 32 + hi * 8; kn0 = *(const h16x8*)kp; kn1 = *(const h16x8*)(kp + 16); }
            float sc[16]; dsa_scores(ka0, ka1, qb, wv, sc);
            const bool diag = (j == ntile - 1);
            unsigned pk[16]; int n = 0;
#pragma unroll
            for (int r = 0; r < 16; ++r) { const int krel = 8 * (r >> 2) + 4 * hi + (r & 3); unsigned v = 0u;
                if ((sc[r] >= thf) && (!diag || krel <= r32)) { v = (f2ord(sc[r]) & 0xffffc000u) | (unsigned)(16383 - (j * 32 + krel)); v = v >= K0q ? v : 0u; }
                pk[r] = v; n += v ? 1 : 0; }
            if (n > 0) { unsigned slot = atomicAdd(&cnt[r32], (unsigned)n);
#pragma unroll
                for (int r = 0; r < 16; ++r) if (pk[r]) { if (slot < 1024u) cq[slot] = pk[r]; ++slot; } }
        }
        __syncthreads();
        if (F.tid < 32) { const unsigned n = cnt[F.tid]; const unsigned need = (unsigned)(t0 + F.tid + 1) < 256u ? (unsigned)(t0 + F.tid + 1) : 256u; if (n < need || n > 1024u) atomicOr(flag, 1u); }
        __syncthreads();
        need_stream = flag[0] != 0u;
        __syncthreads();
        if (need_stream && F.tid < 32) { cnt[F.tid] = 0u; thr[F.tid] = -INFINITY; }
        __syncthreads();
    }
#endif
    if (need_stream) {
    float th = -INFINITY;
    h16x8 kn0 = {}, kn1 = {};
    if (wave < ntile) { const _Float16* kp = KI + (size_t)(wave * 32 + r32) * 32 + hi * 8; kn0 = *(const h16x8*)kp; kn1 = *(const h16x8*)(kp + 16); }
    for (int rd = 0; rd < nround; ++rd) {
        const int j = rd * 8 + wave;
        const h16x8 ka0 = kn0, ka1 = kn1;
        if (j + 8 < ntile) { const _Float16* kp = KI + (size_t)((j + 8) * 32 + r32) * 32 + hi * 8; kn0 = *(const h16x8*)kp; kn1 = *(const h16x8*)(kp + 16); }
        if (j < ntile) {
            float sc[16]; dsa_scores(ka0, ka1, qb, wv, sc);
            const bool diag = (j == ntile - 1);
            int n = 0;
#pragma unroll
            for (int r = 0; r < 16; ++r) { const int krel = 8 * (r >> 2) + 4 * hi + (r & 3);
                const bool p = (sc[r] >= th) && (!diag || krel <= r32);
                sc[r] = p ? sc[r] : -INFINITY; n += p ? 1 : 0; }
            if (n > 0) {
                unsigned slot = atomicAdd(&cnt[r32], (unsigned)n);
#pragma unroll
                for (int r = 0; r < 16; ++r) if (sc[r] != -INFINITY) { const int s = j * 32 + 8 * (r >> 2) + 4 * hi + (r & 3); cq[slot] = (f2ord(sc[r]) & 0xffffc000u) | (unsigned)(16383 - s); ++slot; }
            }
        }
        __syncthreads();
#pragma unroll 1
        for (int qi = 0; qi < 4; ++qi) { const int q = wave * 4 + qi; const int n = (int)cnt[q];
            if (n > 768) { int kept; unsigned K = dsa_topk_compact<false>(cand + q * 1024, hist, n, lane, &kept); float th_ = ord2f(K);
                if (kept > 512) { LDS_WAIT(); asm volatile("" ::: "memory"); K = dsa_topk_compact<true>(cand + q * 1024, hist, kept, lane, &kept); th_ = ord2f(((K >> 14) + 1u) << 14); }
                if (lane == 0) { cnt[q] = (unsigned)kept; thr[q] = th_; } } }
        __syncthreads();
        th = thr[r32];
    }
    }
#pragma unroll 1
    for (int qi = 0; qi < 4; ++qi) { const int q = wave * 4 + qi; const int n = (int)cnt[q];
        if (n > 256) { int kept; dsa_topk_compact<true>(cand + q * 1024, hist, n, lane, &kept); if (lane == 0) cnt[q] = 256u; } }
    LDS_WAIT(); asm volatile("" ::: "memory");
#ifndef NO_BMTAIL
#pragma unroll 1
    for (int qi = 0; qi < 4; ++qi) {
        const int q = wave * 4 + qi; const int n = (int)cnt[q]; unsigned* cq = cand + q * 1024; unsigned* bm = cq + 512;
        *(v4u*)(bm + 8 * lane) = (v4u){0u, 0u, 0u, 0u}; *(v4u*)(bm + 8 * lane + 4) = (v4u){0u, 0u, 0u, 0u};
        LDS_WAIT(); asm volatile("" ::: "memory");
#pragma unroll
        for (int j = 0; j < 4; ++j) { const int e = j * 64 + lane; if (e < n) { const unsigned s = 16383u - (cq[e] & 0x3fffu); atomicOr(&bm[s >> 5], 1u << (s & 31u)); } }
    }
    __syncthreads();
    { unsigned* BM = (unsigned*)(F.ws + WS_BM); const int ntp = 2 * ((t0 >> 8) + 1), qbg = qbase >> 8, ql0 = qbase & 255;
      for (int idx = F.tid; idx < ntp * 32; idx += NTHR) { const int q = idx & 31, tp = idx >> 5;
          const v4u w = *(const v4u*)(cand + q * 1024 + 512 + tp * 4);
          *(v4u*)(BM + (((size_t)qbg * 128 + tp) * 256 + ql0 + q) * 4) = w; } }
#endif
}
#include <hip/hip_bf16.h>
#include <cmath>
namespace attn_body {
using bf16=__hip_bfloat16;
using bf16x8=__attribute__((ext_vector_type(8)))short;
using s16x4=__attribute__((ext_vector_type(4)))short;
using f32x16=__attribute__((ext_vector_type(16)))float;
using u32x4=__attribute__((ext_vector_type(4)))unsigned;
constexpr int BATCH=2,NHEAD=6,SEQ=16384,D=64,QP=3328,OP=1024;
constexpr int NW=8,QBLK=32,QB=QBLK*NW,KVBLK=64,NQB=SEQ/QB;
constexpr int ATTN_UNIT_ROWS=QB;
__device__ __forceinline__ int crow(int r,int hi){return (r&3)+8*(r>>2)+4*hi;}
#define SBAR() __builtin_amdgcn_sched_barrier(0)
__device__ __forceinline__ void cmask(f32x16&p0,f32x16&p1,int jb,int qrel,int hi){
  const float NEG=-INFINITY; int kb=64*jb+4*hi;
  #pragma unroll
  for(int r=0;r<16;++r){int kv=kb+(r&3)+8*(r>>2); if(kv>qrel)p0[r]=NEG; if(kv+32>qrel)p1[r]=NEG;}
}

constexpr int NSLOT=3, SLOTB=8192;
constexpr int LDS_K=0, LDS_V=NSLOT*SLOTB, LDS_WS=2*NSLOT*SLOTB, LDS_OST=LDS_WS+NW*64*4, LDS_BT=LDS_OST+NW*4096, LDS_MK=LDS_BT+1024, LDS_BYTES=LDS_MK+2*4096;
constexpr float C2=0.125f*1.4426950408889634f;
__device__ __forceinline__ void glds16(const void*gsrc,unsigned lds_dst){unsigned keep;
  asm volatile("s_mov_b32 %0, m0\n\ts_mov_b32 m0, %2\n\ts_nop 0\n\tglobal_load_lds_dwordx4 %1, off\n\ts_mov_b32 m0, %0":"=&s"(keep):"v"(gsrc),"s"(lds_dst):"memory");}
__device__ __forceinline__ float max3f(float a,float b,float c){float r;asm("v_max3_f32 %0, %1, %2, %3":"=v"(r):"v"(a),"v"(b),"v"(c));return r;}
__device__ __forceinline__ float max2f(float a,float b){float r;asm("v_max_f32_e32 %0, %1, %2":"=v"(r):"v"(a),"v"(b));return r;}
__device__ __forceinline__ float fadd_s(float a,float b){float r;asm("v_add_f32_e32 %0, %1, %2":"=v"(r):"v"(a),"v"(b));return r;}
__device__ __forceinline__ float fsub_s(float a,float b){float r;asm("v_sub_f32_e32 %0, %1, %2":"=v"(r):"v"(a),"v"(b));return r;}
typedef float f32x2_t __attribute__((ext_vector_type(2))); typedef __bf16 bf16x2_t __attribute__((ext_vector_type(2)));
__device__ __forceinline__ unsigned cvtpk_s(float lo,float hi){f32x2_t v={lo,hi};bf16x2_t b=__builtin_convertvector(v,bf16x2_t);return __builtin_bit_cast(unsigned,b);}
__device__ __forceinline__ void glds16s(unsigned voff,const void*sbase,unsigned lds_dst){unsigned keep;
  asm volatile("s_nop 4\n\ts_mov_b32 %0, m0\n\ts_mov_b32 m0, %3\n\ts_nop 0\n\tglobal_load_lds_dwordx4 %1, %2\n\ts_mov_b32 m0, %0":"=&s"(keep):"v"(voff),"s"(sbase),"s"(lds_dst):"memory");}
#define WAIT_BAR(N) asm volatile("s_waitcnt vmcnt(" #N ") lgkmcnt(0)\n\ts_barrier":::"memory")

__device__ __forceinline__ void qkt(f32x16&p0,f32x16&p1,const char*Kslot,const bf16x8*qr,const f32x16&negm,int r32,int hi){
  const char*kb=Kslot+hi*1024+r32*16;
  #pragma unroll
  for(int d0=0;d0<4;++d0){
    const bf16x8 b0=*reinterpret_cast<const bf16x8*>(kb+d0*2048);
    const bf16x8 b1=*reinterpret_cast<const bf16x8*>(kb+d0*2048+512);
    if(d0==0){p0=__builtin_amdgcn_mfma_f32_32x32x16_bf16(b0,qr[0],negm,0,0,0);p1=__builtin_amdgcn_mfma_f32_32x32x16_bf16(b1,qr[0],negm,0,0,0);}
    else{p0=__builtin_amdgcn_mfma_f32_32x32x16_bf16(b0,qr[d0],p0,0,0,0);p1=__builtin_amdgcn_mfma_f32_32x32x16_bf16(b1,qr[d0],p1,0,0,0);}}
}
typedef __attribute__((address_space(3))) const char* lds_cptr;
typedef short v4i16_t __attribute__((ext_vector_type(4)));
__device__ __forceinline__ void kload8(bf16x8*kf,lds_cptr kp){
  kf[0]=*(const __attribute__((address_space(3))) bf16x8*)(kp);      kf[1]=*(const __attribute__((address_space(3))) bf16x8*)(kp+512);
  kf[2]=*(const __attribute__((address_space(3))) bf16x8*)(kp+2048); kf[3]=*(const __attribute__((address_space(3))) bf16x8*)(kp+2560);
  kf[4]=*(const __attribute__((address_space(3))) bf16x8*)(kp+4096); kf[5]=*(const __attribute__((address_space(3))) bf16x8*)(kp+4608);
  kf[6]=*(const __attribute__((address_space(3))) bf16x8*)(kp+6144); kf[7]=*(const __attribute__((address_space(3))) bf16x8*)(kp+6656);
}
__device__ __forceinline__ void kload2(bf16x8*kf,lds_cptr kp,int j){ kf[2*j]=*(const __attribute__((address_space(3))) bf16x8*)(kp+j*2048); kf[2*j+1]=*(const __attribute__((address_space(3))) bf16x8*)(kp+j*2048+512); }
__device__ __forceinline__ s16x4 vtr(lds_cptr p){ return __builtin_bit_cast(s16x4,__builtin_amdgcn_ds_read_tr16_b64_v4i16((__attribute__((address_space(3))) v4i16_t*)p)); }
__device__ __forceinline__ float rowmax(const f32x16&p0,const f32x16&p1){
  float a=max3f(p0[0],p0[1],p1[0]),b=max3f(p0[2],p0[3],p1[1]);a=max3f(a,p1[2],p1[3]);
  #pragma unroll
  for(int r=4;r<16;r+=4){a=max3f(a,p0[r],p0[r+1]);b=max3f(b,p0[r+2],p0[r+3]);a=max3f(a,p1[r],p1[r+1]);b=max3f(b,p1[r+2],p1[r+3]);}
  const float m=max2f(a,b);
  auto rr=__builtin_amdgcn_permlane32_swap(__float_as_uint(m),__float_as_uint(m),false,false);
  return max2f(__uint_as_float(rr[0]),__uint_as_float(rr[1]));
}
__device__ __forceinline__ void pv(f32x16*o,int vb,bf16x8 pa0,bf16x8 pa1,bf16x8 pa2,bf16x8 pa3){
  #pragma unroll
  for(int d0=0;d0<2;++d0){s16x4 lo[4],hi[4];
    #pragma unroll
    for(int ks=0;ks<4;++ks){
      asm volatile("ds_read_b64_tr_b16 %0,%1 offset:%c2":"=&v"(lo[ks]):"v"(vb),"i"(d0*4096+ks*1024):"memory");
      asm volatile("ds_read_b64_tr_b16 %0,%1 offset:%c2":"=&v"(hi[ks]):"v"(vb),"i"(d0*4096+ks*1024+512):"memory");}
    asm volatile("s_waitcnt lgkmcnt(0)":::"memory");SBAR();
    #define PK(k) (bf16x8){lo[k][0],lo[k][1],lo[k][2],lo[k][3],hi[k][0],hi[k][1],hi[k][2],hi[k][3]}
    o[d0]=__builtin_amdgcn_mfma_f32_32x32x16_bf16(pa0,PK(0),o[d0],0,0,0);
    o[d0]=__builtin_amdgcn_mfma_f32_32x32x16_bf16(pa1,PK(1),o[d0],0,0,0);
    o[d0]=__builtin_amdgcn_mfma_f32_32x32x16_bf16(pa2,PK(2),o[d0],0,0,0);
    o[d0]=__builtin_amdgcn_mfma_f32_32x32x16_bf16(pa3,PK(3),o[d0],0,0,0);
    #undef PK
  }
}

#ifndef ATTN_STORE16
#define ATTN_STORE16(p,v) (*(u32x4*)(p)=(v))
#endif
template<int THRL> __device__ __forceinline__ void attn_unit(int wave_id,int b,int h,int qb,const bf16*Q,const bf16*__restrict__ K,const bf16*__restrict__ V,bf16*O,const unsigned*__restrict__ BM,const float*__restrict__ rb,char*shm){
  int lane_=(int)__builtin_amdgcn_mbcnt_hi(~0u,__builtin_amdgcn_mbcnt_lo(~0u,0u)); asm volatile("":"+v"(lane_)); const int wid=wave_id,lane=lane_,tid=wid*64+lane,r32=lane&31,hi=lane>>5;
  const long rowbase=(long)b*SEQ; const int q0=qb*QB;
  const bf16*Qw=Q+(rowbase+q0+wid*QBLK)*QP+h*D;
  const bf16*Kh=K+rowbase*QP+h*D,*Vh=V+rowbase*QP+h*D;
  const unsigned lds0=(unsigned)(uintptr_t)shm;
  float*wsf=(float*)(shm+LDS_WS)+wid*64;
  const unsigned koff=(unsigned)(lane*QP+wid*8)*2u;
  const unsigned voff=(unsigned)((16*(wid&3)+(lane>>2))*QP+(wid>>2)*32+(lane&3)*8)*2u;
  const unsigned kdst=lds0+LDS_K+wid*1024, vdst=lds0+LDS_V+wid*1024;
  #define DMA_K(t,slot) glds16s(koff,Kh+(long)(t)*KVBLK*QP,(unsigned)__builtin_amdgcn_readfirstlane(kdst+(slot)))
  #define DMA_V(t,slot) glds16s(voff,Vh+(long)(t)*KVBLK*QP,(unsigned)__builtin_amdgcn_readfirstlane(vdst+(slot)))
  const int vb0=(int)(lds0+LDS_V)+((lane>>4)&1)*32+(lane&3)*8+(4*hi+((lane&15)>>2))*64;
  const char*Kbase=shm+LDS_K; bf16x8 kf[8];
  const lds_cptr shm3=(lds_cptr)shm; const lds_cptr kp0=shm3+LDS_K+hi*1024+r32*16; const lds_cptr vp0=shm3+LDS_V+((lane>>4)&1)*32+(lane&3)*8+(4*hi+((lane&15)>>2))*64;
  const int NT=(q0+QB)/KVBLK;
  const unsigned* mbase=BM+((size_t)(b*(SEQ/QB)+qb)*(SEQ/128))*QB*4;
  const unsigned mdst=lds0+LDS_MK+(wid&3)*1024;
  #define DMA_M(e) do{ if(wid<4) glds16s((unsigned)(((wid&3)*64+lane)*16),mbase+(size_t)((e)>>1)*QB*4,(unsigned)__builtin_amdgcn_readfirstlane(mdst+(((e)>>1)&1)*4096)); }while(0)
  const float cfar=rb[31*NHEAD+h]*1.4426950408889634f;
  { float*bt=(float*)(shm+LDS_BT); if(tid<128){ int n=tid; int bk=n<16?n:(16+(int)(__log2f((float)n*(1.f/16.f))*(16.f/3.f))); bk=bk<31?bk:31; bt[tid]=rb[bk*NHEAD+h]*1.4426950408889634f-cfar; } if(tid==128)bt[128]=0.f; }
  DMA_M(0); if(NT>2){DMA_M(2);}
  DMA_K(0,0);DMA_V(0,0);DMA_K(1,SLOTB);
  bf16x8 qr[4];
  #pragma unroll
  for(int d0=0;d0<4;++d0)qr[d0]=*reinterpret_cast<const bf16x8*>(&Qw[(long)r32*QP+d0*16+hi*8]);
  float mhat=0.f,l_reg=0.f;f32x16 o[2];o[0]=f32x16{};o[1]=f32x16{};float cm=cfar; const f32x16 zc=f32x16{};
  const int qrel=wid*QBLK+r32;
  const __attribute__((address_space(3))) float*btab=(const __attribute__((address_space(3))) float*)((lds_cptr)shm+LDS_BT);
  #define MASKB(P0,P1,t) do{ const lds_cptr mp_=(lds_cptr)shm+(LDS_MK+(wid*QBLK+r32)*16+(((t)>>1)&1)*4096+((t)&1)*8); const unsigned mx_=*(const __attribute__((address_space(3))) unsigned*)(mp_)>>(4*hi), my_=*(const __attribute__((address_space(3))) unsigned*)(mp_+4)>>(4*hi); \
      _Pragma("unroll") for(int r=0;r<16;++r){ const int cb_=(r&3)+8*(r>>2); const unsigned s0_=(unsigned)__builtin_amdgcn_sbfe((int)mx_,cb_,1), s1_=(unsigned)__builtin_amdgcn_sbfe((int)my_,cb_,1); \
        P0[r]=__uint_as_float((__float_as_uint(P0[r]+cm)&s0_)|(~s0_&0xff800000u)); P1[r]=__uint_as_float((__float_as_uint(P1[r]+cm)&s1_)|(~s1_&0xff800000u)); } }while(0)
  #define CMASK(P0,P1,t) do{ if((t)>=NT-6){ const int db_=q0+qrel-64*(t)-4*hi; \
      _Pragma("unroll") for(int r=0;r<16;++r){ const int d0_=db_-((r&3)+8*(r>>2)); const int i0_=d0_<0?0:(d0_>128?128:d0_); const int d1_=d0_-32; const int i1_=d1_<0?0:(d1_>128?128:d1_); P0[r]+=btab[i0_]; P1[r]+=btab[i1_]; } } }while(0)
  bool resc=false;
  #define START(P0,P1) do{ const float rm=rowmax(P0,P1); resc=false; \
    { const float dl=__builtin_fmaxf(rm,0.f); mhat=fadd_s(mhat,dl); \
      _Pragma("unroll") for(int r=0;r<16;++r){P0[r]=fsub_s(P0[r],dl);P1[r]=fsub_s(P1[r],dl);} \
      cm=cfar-mhat; } \
    _Pragma("unroll") for(int r=0;r<16;++r)P0[r]=__builtin_amdgcn_exp2f(P0[r]); }while(0)
  #define RESC() do{ if(resc){ asm volatile("s_waitcnt lgkmcnt(0)":::"memory"); \
      _Pragma("unroll") for(int d_=0;d_<2;++d_) _Pragma("unroll") for(int r=0;r<16;++r)o[d_][r]*=wsf[crow(r,hi)]; } }while(0)
  f32x16 pA0,pA1,pB0,pB1;
  int sl_prev=0,sl_cur=0,sl_next=SLOTB;
  #define ROT() do{sl_prev=sl_cur;sl_cur=sl_next;sl_next=(sl_next==(NSLOT-1)*SLOTB)?0:sl_next+SLOTB;}while(0)
  DMA_K(2,2*SLOTB);
  WAIT_BAR(3);
  qkt(pA0,pA1,Kbase,qr,zc,r32,hi);asm volatile("s_nop 15\n\ts_nop 7":"+v"(pA0),"+v"(pA1));MASKB(pA0,pA1,0);CMASK(pA0,pA1,0);
  START(pA0,pA1);
  _Pragma("unroll") for(int r=0;r<16;++r)pA1[r]=__builtin_amdgcn_exp2f(pA1[r]);
  WAIT_BAR(0);
  DMA_K(3,0);DMA_V(1,SLOTB);
  ROT();
  kload8(kf,kp0+sl_cur);
  WAIT_BAR(2);
  s16x4 vlo[8],vhi[8]; u32x4 pw0,pw1,pw2,pw3;
  #define PKW(P,B) cvtpk_s(P[B],P[B+1])
  #define PAF(k) __builtin_bit_cast(bf16x8,pw##k)
  #define VFR(i) (bf16x8){vlo[i][0],vlo[i][1],vlo[i][2],vlo[i][3],vhi[i][0],vhi[i][1],vhi[i][2],vhi[i][3]}
  #define PIN(x) asm volatile("":"+v"(x))
  #define MX3(a,b,c) __builtin_fmaxf(__builtin_fmaxf((a),(b)),(c))
  #define GAPA(MF,A0,A1,A2,A3,W0,W1,PW) do{ MF; sacc+=A0; sacc+=A1; sacc+=A2; sacc+=A3; PIN(sacc); W0; W1; PIN(PW); SBAR(); }while(0)
  #define EX(v) __builtin_amdgcn_exp2f(v)
  #define GAPB(MF,X,B) do{ MF; X[B]=EX(X[B]); X[B+1]=EX(X[B+1]); X[B+2]=EX(X[B+2]); X[B+3]=EX(X[B+3]); PIN(X); SBAR(); }while(0)
  #define VRD(i) do{ vlo[i]=vtr(vp_+(((i)>>2)*4096+((i)&3)*1024)); vhi[i]=vtr(vp_+(((i)>>2)*4096+((i)&3)*1024+512)); }while(0)
  #define KRD(G,j) do{ if(G){ kload2(kf,kp0+sl_next,j); SBAR(); } }while(0)
  #define STEP(C0,C1,P0,P1,t,GK,GV,GL) do{ SBAR(); \
    const lds_cptr vp_=vp0+sl_prev; \
    VRD(0); SBAR(); float sacc=(P0[0]+P0[1]); \
    GAPA(C0=__builtin_amdgcn_mfma_f32_32x32x16_bf16(kf[0],qr[0],zc,0,0,0), P0[2],P0[3],P0[4],P0[5],     pw0[0]=PKW(P0,0), pw0[1]=PKW(P0,2), pw0); \
    VRD(4); SBAR(); GAPA(C1=__builtin_amdgcn_mfma_f32_32x32x16_bf16(kf[1],qr[0],zc,0,0,0), P0[6],P0[7],P0[8],P0[9],     pw0[2]=PKW(P0,4), pw0[3]=PKW(P0,6), pw0); \
    VRD(1); SBAR(); GAPA(C0=__builtin_amdgcn_mfma_f32_32x32x16_bf16(kf[2],qr[1],C0,0,0,0),   P0[10],P0[11],P0[12],P0[13], pw1[0]=PKW(P0,8), pw1[1]=PKW(P0,10), pw1); \
    VRD(5); SBAR(); GAPA(C1=__builtin_amdgcn_mfma_f32_32x32x16_bf16(kf[3],qr[1],C1,0,0,0),   P0[14],P0[15],P1[0],P1[1],   pw1[2]=PKW(P0,12),pw1[3]=PKW(P0,14), pw1); \
    VRD(2); SBAR(); GAPA(C0=__builtin_amdgcn_mfma_f32_32x32x16_bf16(kf[4],qr[2],C0,0,0,0),   P1[2],P1[3],P1[4],P1[5],     pw2[0]=PKW(P1,0), pw2[1]=PKW(P1,2), pw2); \
    VRD(6); SBAR(); GAPA(C1=__builtin_amdgcn_mfma_f32_32x32x16_bf16(kf[5],qr[2],C1,0,0,0),   P1[6],P1[7],P1[8],P1[9],     pw2[2]=PKW(P1,4), pw2[3]=PKW(P1,6), pw2); \
    VRD(3); SBAR(); GAPA(C0=__builtin_amdgcn_mfma_f32_32x32x16_bf16(kf[6],qr[3],C0,0,0,0),   P1[10],P1[11],P1[12],P1[13], pw3[0]=PKW(P1,8), pw3[1]=PKW(P1,10), pw3); \
    VRD(7); SBAR(); GAPA(C1=__builtin_amdgcn_mfma_f32_32x32x16_bf16(kf[7],qr[3],C1,0,0,0),   P1[14],P1[15],0.f,0.f,       pw3[2]=PKW(P1,12),pw3[3]=PKW(P1,14), pw3); \
    l_reg+=sacc; \
    if((((t)&1)==0)&&((t)+2<NT)){DMA_M((t)+2);} if(GK){DMA_K((t)+3,sl_cur);} if(GV){DMA_V((t)+1,sl_next);} \
    MASKB(C0,C1,t); CMASK(C0,C1,t); \
    { float a=MX3(C0[0],C0[1],C1[0]),b=MX3(C0[2],C0[3],C1[1]); a=MX3(a,C1[2],C1[3]); \
      _Pragma("unroll") for(int r=4;r<16;r+=4){a=MX3(a,C0[r],C0[r+1]);b=MX3(b,C0[r+2],C0[r+3]);a=MX3(a,C1[r],C1[r+1]);b=MX3(b,C1[r+2],C1[r+3]);} \
      float rm=__builtin_fmaxf(a,b); { auto rr=__builtin_amdgcn_permlane32_swap(__float_as_uint(rm),__float_as_uint(rm),false,false); rm=__builtin_fmaxf(__uint_as_float(rr[0]),__uint_as_float(rr[1])); } \
      resc=false; \
      if(__builtin_expect(__any(rm>(float)THRL),0)){ const float dl=__builtin_fmaxf(rm,0.f); mhat+=dl; \
        _Pragma("unroll") for(int r=0;r<16;++r){C0[r]-=dl;C1[r]-=dl;} \
        cm=cfar-mhat; \
        const float f=__builtin_amdgcn_exp2f(-dl); l_reg*=f; if(hi==0)wsf[r32]=f; resc=true; } } \
    SBAR(); \
    GAPB(o[0]=__builtin_amdgcn_mfma_f32_32x32x16_bf16(PAF(0),VFR(0),o[0],0,0,0), C0,0); \
    GAPB(o[1]=__builtin_amdgcn_mfma_f32_32x32x16_bf16(PAF(0),VFR(4),o[1],0,0,0), C0,4); \
    KRD(GL,0); GAPB(o[0]=__builtin_amdgcn_mfma_f32_32x32x16_bf16(PAF(1),VFR(1),o[0],0,0,0), C0,8); \
    KRD(GL,1); GAPB(o[1]=__builtin_amdgcn_mfma_f32_32x32x16_bf16(PAF(1),VFR(5),o[1],0,0,0), C0,12); \
    KRD(GL,2); GAPB(o[0]=__builtin_amdgcn_mfma_f32_32x32x16_bf16(PAF(2),VFR(2),o[0],0,0,0), C1,0); \
    KRD(GL,3); GAPB(o[1]=__builtin_amdgcn_mfma_f32_32x32x16_bf16(PAF(2),VFR(6),o[1],0,0,0), C1,4); \
    GAPB(o[0]=__builtin_amdgcn_mfma_f32_32x32x16_bf16(PAF(3),VFR(3),o[0],0,0,0), C1,8); \
    GAPB(o[1]=__builtin_amdgcn_mfma_f32_32x32x16_bf16(PAF(3),VFR(7),o[1],0,0,0), C1,12); \
    }while(0)
  int t=1;
  #undef CMASK
  #define CMASK(P0,P1,t) do{}while(0)
  for(;t+7<NT;t+=2){
    STEP(pB0,pB1,pA0,pA1,t,true,true,true);     WAIT_BAR(2); RESC(); ROT();
    STEP(pA0,pA1,pB0,pB1,t+1,true,true,true);   WAIT_BAR(2); RESC(); ROT();
  }
  #undef CMASK
  #define CMASK(P0,P1,t) do{ if((t)>=NT-6){ const int db_=q0+qrel-64*(t)-4*hi; \
      _Pragma("unroll") for(int r=0;r<16;++r){ const int d0_=db_-((r&3)+8*(r>>2)); const int i0_=d0_<0?0:(d0_>128?128:d0_); const int d1_=d0_-32; const int i1_=d1_<0?0:(d1_>128?128:d1_); P0[r]+=btab[i0_]; P1[r]+=btab[i1_]; } } }while(0)
  #define ENDW(tt) do{ if((tt)+3<NT){WAIT_BAR(2);} else if((tt)+2<NT){WAIT_BAR(1);} else {WAIT_BAR(0);} }while(0)
  for(;t+1<NT;t+=2){
    STEP(pB0,pB1,pA0,pA1,t,(t+3<NT),(t+1<NT),(t+1<NT));       ENDW(t);   RESC(); ROT();
    STEP(pA0,pA1,pB0,pB1,t+1,(t+4<NT),(t+2<NT),(t+2<NT));     ENDW(t+1); RESC(); ROT();
  }
  STEP(pB0,pB1,pA0,pA1,NT-1,false,false,false); RESC();
  { float sacc=pB0[0]+pB0[1]; _Pragma("unroll") for(int r=2;r<16;++r)sacc+=pB0[r]; _Pragma("unroll") for(int r=0;r<16;++r)sacc+=pB1[r]; l_reg+=sacc;
    pw0=(u32x4){PKW(pB0,0),PKW(pB0,2),PKW(pB0,4),PKW(pB0,6)};pw1=(u32x4){PKW(pB0,8),PKW(pB0,10),PKW(pB0,12),PKW(pB0,14)};pw2=(u32x4){PKW(pB1,0),PKW(pB1,2),PKW(pB1,4),PKW(pB1,6)};pw3=(u32x4){PKW(pB1,8),PKW(pB1,10),PKW(pB1,12),PKW(pB1,14)};
    SBAR(); pv(o,vb0+sl_cur,PAF(0),PAF(1),PAF(2),PAF(3)); }
  #undef PKW
  #undef PAF
  #undef VFR
  #undef PIN
  #undef MX3
  #undef GAPA
  #undef GAPB
  #undef EX
  #undef VRD
  #undef KRD
  #undef STEP
  #undef ENDW
  {auto rr=__builtin_amdgcn_permlane32_swap(__float_as_uint(l_reg),__float_as_uint(l_reg),false,false);l_reg=__uint_as_float(rr[0])+__uint_as_float(rr[1]);}
  if(hi==0)wsf[32+r32]=l_reg;asm volatile("s_waitcnt lgkmcnt(0)":::"memory");
  float rli[16];
  #pragma unroll
  for(int r=0;r<16;++r)rli[r]=__builtin_amdgcn_rcpf(wsf[32+crow(r,hi)]);
  bf16*Ow=O+(rowbase+q0+wid*QBLK)*OP+h*D;
  { bf16*stg=(bf16*)(shm+LDS_OST)+wid*2048;
    #pragma unroll
    for(int r=0;r<16;++r){const int orow=crow(r,hi);
      #pragma unroll
      for(int d0=0;d0<2;++d0)stg[orow*64+d0*32+r32]=__float2bfloat16(o[d0][r]*rli[r]);}
    asm volatile("s_waitcnt lgkmcnt(0)":::"memory");
    #pragma unroll
    for(int i=0;i<4;++i){const int row=i*8+(lane>>3),ch=lane&7; const u32x4 v=*(const u32x4*)(stg+row*64+ch*8); ATTN_STORE16(Ow+(long)row*OP+ch*8,v);} }
  asm volatile("s_waitcnt lgkmcnt(0)\n\ts_barrier":::"memory");
  #undef DMA_K
  #undef DMA_V
  #undef DMA_M
  #undef MASKB
  #undef CMASK
  #undef START
  #undef RESC
  #undef ROT
}
constexpr int ATTN_LDS_BYTES=LDS_BYTES;
#undef SBAR
#undef WAIT_BAR
}

constexpr int CW_QUEUE = 8192;
__device__ __forceinline__ void dsa_attn_phase(Frame& F, const Args& A, int l, int rep = 0) {
    unsigned* ctr = (unsigned*)(F.ws + WS_CTL) + CW_QUEUE + 64 * l + 256 * rep;
    volatile unsigned* slot = (volatile unsigned*)(F.lds + LDSCTL_OFF + 512);
    const attn_body::bf16* proj = (const attn_body::bf16*)(F.ws + WS_PROJ);
    for (;;) {
        if (F.tid == 0) *slot = atomicAdd(ctr, 1u);
        __syncthreads();
        const unsigned u = (unsigned)__builtin_amdgcn_readfirstlane((int)*slot);
        __syncthreads();
        if (u >= 768u) break;
        const int qb = 63 - (int)(u / 12u), bh = (int)(u % 12u), b = bh / 6, h = bh % 6;
        attn_body::attn_unit<8>(F.wave, b, h, qb, proj + PC_DQ, proj + PC_DK, proj + PC_DV, (attn_body::bf16*)(F.ws + WS_Y) + YC_DSA, (const unsigned*)(F.ws + WS_BM), A.in[I_RB], (char*)(F.lds + RING_OFF));
    }
}

constexpr int PH_PER_LAYER = 9, N_PHASES = 1 + DEPTH * PH_PER_LAYER;
__global__ void __launch_bounds__(NTHR, 2) fwd(const Args A) {
    extern __shared__ __attribute__((aligned(16))) unsigned char lds[];
    Frame F;
    F.lds = lds; F.tid = threadIdx.x; F.lane = F.tid & 63; F.wave = __builtin_amdgcn_readfirstlane(F.tid >> 6); F.G = gridDim.x; const int wave0 = F.wave;
    F.out = A.out; F.ws = A.ws;
    LAS unsigned char* lds3 = (LAS unsigned char*)lds;
    for (int u = F.tid; u < (LDS_BYTES - LDSCTL_OFF) / 4; u += NTHR) ((LAS unsigned*)(lds3 + LDSCTL_OFF))[u] = 0u;
    __syncthreads();
    const int lo = A.ph_lo, hi = A.ph_hi;
    XcdBarrier bar; bar.bar = (unsigned*)(F.ws + WS_CTL) + CW_BAR; bar.x = 0; bar.st = nullptr; bar.wave = F.wave;
    if (hi - lo > 1) bar = xcd_barrier_post((unsigned*)(F.ws + WS_CTL) + CW_BAR, (volatile LAS unsigned*)(lds3 + MISC_OFF) + 8, F.wave);
#define IN(k) (lo <= (k) && (k) < hi)
#define LAUNDER() do { int lane_ = (int)__builtin_amdgcn_mbcnt_hi(~0u, __builtin_amdgcn_mbcnt_lo(~0u, 0u)); asm volatile("" : "+v"(lane_)); F.lane = lane_; { int wv_ = wave0; asm volatile("" : "+s"(wv_)); F.wave = wv_; } F.tid = F.wave * 64 + lane_; \
    LAS unsigned char* l3_ = (LAS unsigned char*)lds; asm volatile("" : "+s"(l3_)); lds3 = l3_; F.lds = (unsigned char*)l3_; unsigned char* w_ = A.ws; asm volatile("" : "+s"(w_)); F.ws = w_; } while (0)
#ifndef REPMASK
#define REPMASK 0
#endif
#define REPS(j) (((REPMASK >> (j)) & 1) + 1)
#define SEAM(k) do { if (IN(k) && IN((k) + 1)) xcd_barrier(bar); } while (0)
#define gw (blockIdx.x * NWAVES + F.wave)
#define NGW (F.G * NWAVES)
#define XB ((bf16*)(F.ws + WS_XB))
#define PROJ ((bf16*)(F.ws + WS_PROJ))
#define AUX ((float*)(F.ws + WS_AUX))
#define Y ((bf16*)(F.ws + WS_Y))
#define H ((bf16*)(F.ws + WS_H))
#define V1 ((float*)(F.ws + WS_V1))
#define V2 ((float*)(F.ws + WS_V2))

    if (IN(0)) { LAUNDER(); for (int rep = 0; rep < REPS(5); ++rep) { p0_prologue(F, A); lru_weights_prologue(F, A); } } SEAM(0);

    for (int l = 0; l < DEPTH; ++l) {
        const int pb = 1 + l * PH_PER_LAYER;
        if (IN(pb + 0)) { LAUNDER();
            pg8::Gemm g{XB, w_ptr(F, l, WO_IN), T, NIN, D}; pg8::StaticOrder S; S.init(T, NIN, F.G, (int)blockIdx.x);
            pg8::EpiInProj E{PROJ, AUX, (_Float16*)(F.ws + WS_KI)};
            for (int rep = 0; rep < REPS(3); ++rep) {
            pg8::gemm_phase<pg8::EpiInProj, pg8::StaticOrder, true, true>(lds3 + RING_OFF, g, S, E, F.wave); }
        } SEAM(pb + 0);
        if (IN(pb + 1)) { LAUNDER();
            for (int rep = 0; rep < REPS(0); ++rep) for (int it = blockIdx.x; it < T / 32; it += F.G) dsa_item(F, A, l, T / 32 - 1 - it);
            for (int rep = 0; rep < REPS(1); ++rep) for (int it = blockIdx.x; it < 1024; it += F.G) lru_item2(F, A, l, it, false);
            for (int rep = 0; rep < REPS(2); ++rep) for (int it = blockIdx.x; it < 3072; it += F.G) gla_item2(F, A, l, it, false);
        } SEAM(pb + 1);
        if (IN(pb + 2)) { LAUNDER();
            if (blockIdx.x < 96) gla_scan(F, blockIdx.x * NTHR + F.tid);
            for (int row = gw; row < 512; row += NGW) lru_scan_row(F, row);
#ifndef NO_ATTN
            for (int rep = 0; rep < REPS(6); ++rep) dsa_attn_phase(F, A, l, rep);
#endif
        } SEAM(pb + 2);
        if (IN(pb + 3)) { LAUNDER();
            for (int rep = 0; rep < REPS(1); ++rep) for (int it = blockIdx.x; it < 1024; it += F.G) lru_item2(F, A, l, it, true);
            for (int rep = 0; rep < REPS(2); ++rep) for (int it = blockIdx.x; it < 3072; it += F.G) gla_item2(F, A, l, it, true);
            __syncthreads();
        } SEAM(pb + 3);
        if (IN(pb + 4)) { LAUNDER();
            pg8::Gemm g{Y, w_ptr(F, l, WO_OUT), T, D, D}; pg8::StaticOrder S; S.init(T, D, F.G, (int)blockIdx.x);
            pg8::EpiRes E{l == 0 ? A.in[I_X] : F.out, V1, DN_ALPHA};
            for (int rep = 0; rep < REPS(3); ++rep) {
            pg8::gemm_phase<pg8::EpiRes, pg8::StaticOrder, true, true>(lds3 + RING_OFF, g, S, E, F.wave); }
        } SEAM(pb + 4);
        if (IN(pb + 5)) { LAUNDER(); for (int rep = 0; rep < REPS(4); ++rep) ln_phase(F, V1, A.in[I_LN1G] + l * D, A.in[I_LN1B] + l * D, F.out, XB); } SEAM(pb + 5);
        if (IN(pb + 6)) { LAUNDER();
            pg8::Gemm g{XB, w_ptr(F, l, WO_GU), T, NGU, D}; pg8::StaticOrder S; S.init(T, NGU, F.G, (int)blockIdx.x);
            pg8::EpiFfnUp E{H};
            for (int rep = 0; rep < REPS(3); ++rep) {
            pg8::gemm_phase<pg8::EpiFfnUp, pg8::StaticOrder, true, true>(lds3 + RING_OFF, g, S, E, F.wave); }
        } SEAM(pb + 6);
        if (IN(pb + 7)) { LAUNDER();
            pg8::Gemm g{H, w_ptr(F, l, WO_D), T, D, DFF}; pg8::StaticOrder S; S.init(T, D, F.G, (int)blockIdx.x);
            pg8::EpiRes E{F.out, V2, DN_ALPHA};
            for (int rep = 0; rep < REPS(3); ++rep) {
            pg8::gemm_phase<pg8::EpiRes, pg8::StaticOrder, true, true>(lds3 + RING_OFF, g, S, E, F.wave); }
        } SEAM(pb + 7);
        if (IN(pb + 8)) { LAUNDER(); for (int rep = 0; rep < REPS(4); ++rep) ln_phase(F, V2, A.in[I_LN2G] + l * D, A.in[I_LN2B] + l * D, F.out, XB); } SEAM(pb + 8);
    }
#undef IN
#undef SEAM
#undef gw
#undef NGW
#undef XB
#undef PROJ
#undef AUX
#undef Y
#undef H
#undef V1
#undef V2
}

extern "C" void kernel_launch(void* const* d_in, const int* in_sizes, int n_in, void* d_out, int out_size, void* d_ws, size_t ws_size, hipStream_t stream) {
    static int grid = 0;
    if (grid == 0) {
        if (n_in != N_INPUTS || in_sizes[0] != T * D || out_size != T * D || ws_size < WS_END) { fprintf(stderr, "kernel_launch: unexpected shapes (n_in %d, in0 %d, out %d, ws %zu, need %zu)\n", n_in, n_in > 0 ? in_sizes[0] : -1, out_size, ws_size, (size_t)WS_END); grid = -1; return; }
        int dev = 0, cus = 0, per_cu = 0;
        if (hipGetDevice(&dev) != hipSuccess || hipDeviceGetAttribute(&cus, hipDeviceAttributeMultiprocessorCount, dev) != hipSuccess) { grid = -1; return; }
        if (hipFuncSetAttribute((const void*)fwd, hipFuncAttributeMaxDynamicSharedMemorySize, LDS_BYTES) != hipSuccess) { fprintf(stderr, "kernel_launch: hipFuncSetAttribute failed\n"); grid = -1; return; }
        if (hipOccupancyMaxActiveBlocksPerMultiprocessor(&per_cu, (const void*)fwd, NTHR, LDS_BYTES) != hipSuccess || per_cu < 1) fprintf(stderr, "kernel_launch: occupancy query reports %d per CU\n", per_cu);
        (void)hipGetLastError();
        grid = cus;
        if (grid != 256) fprintf(stderr, "kernel_launch: %d CUs (expected 256)\n", grid);
    }
    if (grid < 0) return;
    (void)hipMemsetAsync((char*)d_ws + WS_CTL, 0, CTL_ZERO_BYTES, stream);
    Args a{};
    for (int i = 0; i < N_INPUTS; ++i) a.in[i] = (const float*)d_in[i];
    a.out = (float*)d_out; a.ws = (unsigned char*)d_ws;
#if MK_N_LAUNCHES == 1
    a.ph_lo = 0; a.ph_hi = N_PHASES;
    hipLaunchKernelGGL(fwd, dim3(grid), dim3(NTHR), LDS_BYTES, stream, a);
#else
    for (int ph = 0; ph < N_PHASES; ++ph) { a.ph_lo = ph; a.ph_hi = ph + 1; hipLaunchKernelGGL(fwd, dim3(grid), dim3(NTHR), LDS_BYTES, stream, a); }
#endif
}
```

```cpp
#define MK_N_LAUNCHES 1
#include <hip/hip_runtime.h>
#include <cstdio>
#include <cstdint>
#include <cmath>
namespace pg8 {
#define PG8_LAS __attribute__((address_space(3)))
typedef unsigned short bf16_t;
typedef short bf16x8 __attribute__((ext_vector_type(8)));
typedef float f32x4 __attribute__((ext_vector_type(4)));
typedef unsigned u32x4 __attribute__((ext_vector_type(4)));
constexpr int BM = 256, BK = 64, HALF = 128, HTB = HALF * BK * 2  , STAGE_BYTES = 8 * HTB, NXCD = 8, WGM = 8;

__host__ __device__ __forceinline__ int lds_byte(int r, int c) { const int st = (r >> 4) * 2 + (c >> 5), rr = r & 15, cc = c & 31, ob = rr * 64 + cc * 2; return st * 1024 + (ob ^ (((ob >> 9) & 1) << 5)); }
__host__ __device__ __forceinline__ void stage_rc(int b, int& R, int& C) { const int st = b / 1024, sb = b % 1024, swz = sb ^ (((sb >> 9) & 1) << 5); R = (st >> 1) * 16 + swz / 64; C = (st & 1) * 32 + (swz % 64) / 2; }
__host__ __device__ __forceinline__ int perm32(int rho) { const int n = rho >> 4, i = rho & 15; return 8 * (i >> 2) + 4 * n + (i & 3); }

struct Unit { int pm, pn; };
struct Gemm { const bf16_t* A; const bf16_t* Bt; int M, N, K; };

struct StaticOrder {
    int nM, nN, nwg, G, c;
    __host__ __device__ void init(int M, int N, int G_, int c_) { nM = M / BM; nN = N / BM; nwg = nM * nN; G = G_; c = c_; }
    __host__ __device__ bool next(int i, Unit& u) const {
        const long L = (long)i * G + c; if (L >= nwg) return false;
        int wgid = (int)L; { const int q = nwg / NXCD, r = nwg % NXCD, xcd = wgid % NXCD, off = wgid / NXCD; wgid = (xcd < r ? xcd * (q + 1) : r * (q + 1) + (xcd - r) * q) + off; }
        const int nig = WGM * nN, gid = wgid / nig, fm = gid * WGM, gsz = (nM - fm) < WGM ? (nM - fm) : WGM;
        u.pm = fm + ((wgid % nig) % gsz); u.pn = (wgid % nig) / gsz; return true;
    }
    __device__ __forceinline__ void a_ready(const Unit&) const {}
    __device__ __forceinline__ void done(const Unit&) const {}
};

__device__ __forceinline__ unsigned cvt_pk_bf16(float lo, float hi) { unsigned r; asm volatile("v_cvt_pk_bf16_f32 %0, %1, %2" : "=v"(r) : "v"(lo), "v"(hi)); return r; }
typedef float f32x2 __attribute__((ext_vector_type(2)));
constexpr int PROJ_LD = 3328, AUX_LD = 256, DFF = 2816, DM = 1024;
typedef _Float16 h16x8 __attribute__((ext_vector_type(8)));
struct EpiInProj {
    static constexpr bool PERM = true, AFTER_DRAIN = false;
    bf16_t* proj; float* aux; _Float16* ki;
    __device__ __forceinline__ void operator()(const f32x4 (&acc)[2][2][4][2], const Unit& u, int wr, int wc, int fr, int fq) const {
        const int row0 = u.pm * BM + wr * 64 + fr;
        if (u.pn < 13) {
            const int col0 = u.pn * BM + wc * 32 + 8 * fq;
#pragma unroll
            for (int ai = 0; ai < 2; ++ai)
#pragma unroll
                for (int m = 0; m < 4; ++m) { bf16_t* rowp = proj + (size_t)(row0 + ai * HALF + m * 16) * PROJ_LD + col0;
#pragma unroll
                    for (int bj = 0; bj < 2; ++bj) { const f32x4 v0 = acc[ai][bj][m][0], v1 = acc[ai][bj][m][1];
                        u32x4 w; w.x = cvt_pk_bf16(v0[0], v0[1]); w.y = cvt_pk_bf16(v0[2], v0[3]); w.z = cvt_pk_bf16(v1[0], v1[1]); w.w = cvt_pk_bf16(v1[2], v1[3]);
                        *(u32x4*)(rowp + bj * HALF) = w; } }
        } else {
            const int col0 = wc * 32 + 8 * fq;
#pragma unroll
            for (int ai = 0; ai < 2; ++ai)
#pragma unroll
                for (int m = 0; m < 4; ++m) { float* rowp = aux + (size_t)(row0 + ai * HALF + m * 16) * AUX_LD + col0;
#pragma unroll
                    for (int bj = 0; bj < 2; ++bj) { *(f32x4*)(rowp + bj * HALF) = acc[ai][bj][m][0]; *(f32x4*)(rowp + bj * HALF + 4) = acc[ai][bj][m][1];
                        const int cg = col0 + bj * HALF;
                        if (cg >= 144 && cg < 176) { const f32x4 v0 = acc[ai][bj][m][0], v1 = acc[ai][bj][m][1]; h16x8 hv;
                            hv[0] = (_Float16)v0[0]; hv[1] = (_Float16)v0[1]; hv[2] = (_Float16)v0[2]; hv[3] = (_Float16)v0[3]; hv[4] = (_Float16)v1[0]; hv[5] = (_Float16)v1[1]; hv[6] = (_Float16)v1[2]; hv[7] = (_Float16)v1[3];
                            *(h16x8*)(ki + (size_t)(row0 + ai * HALF + m * 16) * 32 + (cg - 144)) = hv; } } }
        }
    }
};
struct EpiFfnUp {
    static constexpr bool PERM = true, AFTER_DRAIN = false;
    bf16_t* H;
    __device__ __forceinline__ void operator()(const f32x4 (&acc)[2][2][4][2], const Unit& u, int wr, int wc, int fr, int fq) const {
        const int row0 = u.pm * BM + wr * 64 + fr, col0 = u.pn * HALF + wc * 32 + 8 * fq;
#pragma unroll
        for (int ai = 0; ai < 2; ++ai)
#pragma unroll
            for (int m = 0; m < 4; ++m) { bf16_t* rowp = H + (size_t)(row0 + ai * HALF + m * 16) * DFF + col0;
                float o[8];
#pragma unroll
                for (int n = 0; n < 2; ++n)
#pragma unroll
                    for (int j = 0; j < 4; ++j) { const float g = acc[ai][0][m][n][j], up = acc[ai][1][m][n][j];
                        const float sg = g * __builtin_amdgcn_rcpf(1.0f + __builtin_amdgcn_exp2f(-1.44269504089f * g)); o[n * 4 + j] = sg * up; }
                u32x4 w; w.x = cvt_pk_bf16(o[0], o[1]); w.y = cvt_pk_bf16(o[2], o[3]); w.z = cvt_pk_bf16(o[4], o[5]); w.w = cvt_pk_bf16(o[6], o[7]);
                *(u32x4*)rowp = w; }
    }
};
struct EpiRes {
    static constexpr bool PERM = false, AFTER_DRAIN = false;
    const float* base; float* out; float alpha;
    __device__ __forceinline__ void operator()(const f32x4 (&acc)[2][2][4][2], const Unit& u, int wr, int wc, int fr, int fq) const {
        const int row0 = u.pm * BM + wr * 64 + fr, col0 = u.pn * BM + wc * 32 + 4 * fq;
#pragma unroll
        for (int ai = 0; ai < 2; ++ai)
#pragma unroll
            for (int m = 0; m < 4; ++m) { const size_t off = (size_t)(row0 + ai * HALF + m * 16) * DM + col0;
#pragma unroll
                for (int bj = 0; bj < 2; ++bj)
#pragma unroll
                    for (int n = 0; n < 2; ++n) { const f32x4 b = *(const f32x4*)(base + off + bj * HALF + n * 16);
                        *(f32x4*)(out + off + bj * HALF + n * 16) = b * alpha + acc[ai][bj][m][n]; } }
    }
};
template <class Epi, class Sched, bool ALIGN_EPI = false, bool SP2 = false>
__device__ __forceinline__ void gemm_phase(PG8_LAS unsigned char* lds, const Gemm g, const Sched& S, const Epi& E, int wave_id) {
    int lane_ = (int)__builtin_amdgcn_mbcnt_hi(~0u, __builtin_amdgcn_mbcnt_lo(~0u, 0u)); asm volatile("" : "+v"(lane_));
    const int wid = wave_id, lane = lane_, tid = wid * 64 + lane, wr = wid >> 2, wc = wid & 3, fr = lane & 15, fq = lane >> 4;
    const int K = g.K, nt = K / BK;
    unsigned voffA[2], voffB[2];
#pragma unroll
    for (int i = 0; i < 2; ++i) { int R, C; stage_rc(tid * 16 + i * 8192, R, C); const int Rb = Epi::PERM ? ((R & ~31) + perm32(R & 31)) : R;
        voffA[i] = (unsigned)(R * K + C) * 2u; voffB[i] = (unsigned)(Rb * K + C) * 2u; }
    const size_t kstep = (size_t)(BK * 2);
    const size_t hstep = (size_t)HALF * K * 2;
    const size_t tstep = 2 * hstep;
    const unsigned ldsw = (unsigned)wid * 1024u;
    const int aoff = lds_byte(wr * 64 + fr, fq * 8), boff = lds_byte(wc * 32 + fr, fq * 8);
#define PG8_SA(b, h) (((b) * 2 + (h)) * HTB)
#define PG8_SB(b, h) ((4 + (b) * 2 + (h)) * HTB)
#define PG8_STAGE(bufoff, gbase, voff) do { _Pragma("unroll") for (int _i = 0; _i < 2; ++_i) \
        __builtin_amdgcn_global_load_lds((const unsigned*)((const char*)(gbase) + (voff)[_i]), (PG8_LAS unsigned*)(lds + (bufoff) + ldsw + _i * 8192), 16, 0, 0); } while (0)
#define PG8_LDA(dst, b, h) do { _Pragma("unroll") for (int m = 0; m < 4; ++m) _Pragma("unroll") for (int k = 0; k < 2; ++k) dst[m][k] = *(const PG8_LAS bf16x8*)(lds + PG8_SA(b, h) + aoff + m * 2048 + k * 1024); } while (0)
#define PG8_LDB(dst, b, h) do { _Pragma("unroll") for (int n = 0; n < 2; ++n) _Pragma("unroll") for (int k = 0; k < 2; ++k) dst[n][k] = *(const PG8_LAS bf16x8*)(lds + PG8_SB(b, h) + boff + n * 2048 + k * 1024); } while (0)
#define PG8_MMA(ai, bj, At, Bt) do { __builtin_amdgcn_s_setprio(1); _Pragma("unroll") for (int m = 0; m < 4; ++m) _Pragma("unroll") for (int n = 0; n < 2; ++n) _Pragma("unroll") for (int k = 0; k < 2; ++k) \
        acc[ai][bj][m][n] = __builtin_amdgcn_mfma_f32_16x16x32_bf16(Bt[n][k], At[m][k], acc[ai][bj][m][n], 0, 0, 0); __builtin_amdgcn_s_setprio(0); } while (0)
#define PG8_WAIT_V(n) asm volatile("s_waitcnt vmcnt(" #n ")" ::: "memory")
#define PG8_WAIT_L(n) asm volatile("s_waitcnt lgkmcnt(" #n ")" ::: "memory")
#define PG8_BAR __builtin_amdgcn_s_barrier()
#define PG8_SCHED __builtin_amdgcn_sched_barrier(0)
    Unit cur, nxt; int ui = 0;
    if (!S.next(0, cur)) return;
    f32x4 acc[2][2][4][2];
#pragma unroll
    for (int a = 0; a < 2; ++a)
#pragma unroll
        for (int b = 0; b < 2; ++b)
#pragma unroll
            for (int m = 0; m < 4; ++m)
#pragma unroll
                for (int n = 0; n < 2; ++n) acc[a][b][m][n] = (f32x4){0.f, 0.f, 0.f, 0.f};
    bf16x8 At[4][2], B0[2][2], B1[2][2];
    const char* cA = (const char*)g.A + (size_t)cur.pm * tstep; const char* cB = (const char*)g.Bt + (size_t)cur.pn * tstep;
    S.a_ready(cur);
    if constexpr (SP2) {
        PG8_STAGE(PG8_SB(0, 0), cB, voffB); PG8_STAGE(PG8_SB(0, 1), cB + hstep, voffB); PG8_STAGE(PG8_SA(0, 0), cA, voffA); PG8_STAGE(PG8_SA(0, 1), cA + hstep, voffA);
        if (wr == 1) PG8_BAR;
        PG8_WAIT_V(2); PG8_BAR;
        PG8_STAGE(PG8_SB(1, 0), cB + kstep, voffB); PG8_STAGE(PG8_SA(1, 0), cA + kstep, voffA); PG8_STAGE(PG8_SB(1, 1), cB + hstep + kstep, voffB);
        PG8_WAIT_V(6); PG8_BAR;
    } else {
        PG8_STAGE(PG8_SB(0, 0), cB, voffB); PG8_STAGE(PG8_SA(0, 0), cA, voffA); PG8_STAGE(PG8_SB(0, 1), cB + hstep, voffB); PG8_STAGE(PG8_SA(0, 1), cA + hstep, voffA);
        if (wr == 1) PG8_BAR;
        PG8_WAIT_V(4); PG8_BAR;
        PG8_STAGE(PG8_SB(1, 0), cB + kstep, voffB); PG8_STAGE(PG8_SA(1, 0), cA + kstep, voffA); PG8_STAGE(PG8_SB(1, 1), cB + hstep + kstep, voffB);
        PG8_WAIT_V(6); PG8_BAR;
    }
    for (;;) {
        const bool has_next = S.next(ui + 1, nxt);
        const char* nA = has_next ? (const char*)g.A + (size_t)nxt.pm * tstep : cA; const char* nB = has_next ? (const char*)g.Bt + (size_t)nxt.pn * tstep : cB;
        for (int t = 0; t < nt; t += 2) {
            const bool last = (t == nt - 2);
            const char* a1 = cA + (size_t)(t + 1) * kstep;
            const char* a2 = last ? nA : cA + (size_t)(t + 2) * kstep; const char* b2 = last ? nB : cB + (size_t)(t + 2) * kstep;
            const char* a3 = a2 + kstep; const char* b3 = b2 + kstep;
            if (last && has_next) S.a_ready(nxt);
            if constexpr (SP2) {
            PG8_LDB(B0, 0, 0); PG8_LDB(B1, 0, 1); PG8_SCHED; PG8_LDA(At, 0, 0); PG8_STAGE(PG8_SA(1, 1), a1 + hstep, voffA);
            PG8_WAIT_V(8); PG8_WAIT_L(0); PG8_BAR; PG8_MMA(0, 0, At, B0); PG8_MMA(0, 1, At, B1); PG8_BAR; PG8_SCHED;
            PG8_LDA(At, 0, 1); PG8_STAGE(PG8_SB(0, 0), b2, voffB); PG8_STAGE(PG8_SB(0, 1), b2 + hstep, voffB); PG8_STAGE(PG8_SA(0, 0), a2, voffA);
            PG8_WAIT_V(8); PG8_WAIT_L(0); PG8_BAR; PG8_MMA(1, 0, At, B0); PG8_MMA(1, 1, At, B1); PG8_BAR; PG8_SCHED;
            PG8_LDB(B0, 1, 0); PG8_LDB(B1, 1, 1); PG8_SCHED; PG8_LDA(At, 1, 0); PG8_STAGE(PG8_SA(0, 1), a2 + hstep, voffA);
            PG8_WAIT_V(8); PG8_WAIT_L(0); PG8_BAR; PG8_MMA(0, 0, At, B0); PG8_MMA(0, 1, At, B1); PG8_BAR; PG8_SCHED;
            PG8_LDA(At, 1, 1); PG8_STAGE(PG8_SB(1, 0), b3, voffB); PG8_STAGE(PG8_SB(1, 1), b3 + hstep, voffB); PG8_STAGE(PG8_SA(1, 0), a3, voffA);
            PG8_WAIT_V(8); PG8_WAIT_L(0); PG8_BAR; PG8_MMA(1, 0, At, B0); PG8_MMA(1, 1, At, B1); PG8_BAR; PG8_SCHED;
            } else {
            PG8_LDB(B0, 0, 0); PG8_SCHED; PG8_LDA(At, 0, 0); PG8_STAGE(PG8_SA(1, 1), a1 + hstep, voffA);
            PG8_WAIT_L(8); PG8_BAR; PG8_WAIT_L(0); PG8_MMA(0, 0, At, B0); PG8_BAR; PG8_SCHED;
            PG8_LDB(B1, 0, 1); PG8_STAGE(PG8_SB(0, 0), b2, voffB);
            PG8_BAR; PG8_WAIT_L(0); PG8_MMA(0, 1, At, B1); PG8_BAR;
            PG8_LDA(At, 0, 1); PG8_STAGE(PG8_SA(0, 0), a2, voffA);
            PG8_BAR; PG8_WAIT_L(0); PG8_MMA(1, 0, At, B0); PG8_BAR; PG8_SCHED;
            PG8_STAGE(PG8_SB(0, 1), b2 + hstep, voffB);
            PG8_WAIT_V(6); PG8_BAR; PG8_MMA(1, 1, At, B1); PG8_BAR;
            PG8_LDB(B0, 1, 0); PG8_SCHED; PG8_LDA(At, 1, 0); PG8_STAGE(PG8_SA(0, 1), a2 + hstep, voffA);
            PG8_WAIT_L(8); PG8_BAR; PG8_WAIT_L(0); PG8_MMA(0, 0, At, B0); PG8_BAR; PG8_SCHED;
            PG8_LDB(B1, 1, 1); PG8_STAGE(PG8_SB(1, 0), b3, voffB);
            PG8_BAR; PG8_WAIT_L(0); PG8_MMA(0, 1, At, B1); PG8_BAR;
            PG8_LDA(At, 1, 1); PG8_STAGE(PG8_SA(1, 0), a3, voffA);
            PG8_BAR; PG8_WAIT_L(0); PG8_MMA(1, 0, At, B0); PG8_BAR; PG8_SCHED;
            PG8_STAGE(PG8_SB(1, 1), b3 + hstep, voffB);
            PG8_WAIT_V(6); PG8_BAR; PG8_MMA(1, 1, At, B1); PG8_BAR;
            }
        }
        if constexpr (ALIGN_EPI) { if (wr == 0) PG8_BAR; }
        if constexpr (!Epi::AFTER_DRAIN) { E(acc, cur, wr, wc, fr, fq); S.done(cur); }
        if (!has_next) break;
#pragma unroll
        for (int a = 0; a < 2; ++a)
#pragma unroll
            for (int b = 0; b < 2; ++b)
#pragma unroll
                for (int m = 0; m < 4; ++m)
#pragma unroll
                    for (int n = 0; n < 2; ++n) acc[a][b][m][n] = (f32x4){0.f, 0.f, 0.f, 0.f};
        cur = nxt; cA = nA; cB = nB; ++ui;
        if constexpr (ALIGN_EPI) { if (wr == 1) PG8_BAR; }
    }
    PG8_WAIT_V(0);
    if constexpr (!ALIGN_EPI) { if (wr == 0) PG8_BAR; }
    PG8_BAR;
    if constexpr (Epi::AFTER_DRAIN) { E.fused(acc, cur, wr, wc, fr, fq, lds, wid, lane); S.done(cur); }
#undef PG8_SA
#undef PG8_SB
#undef PG8_STAGE
#undef PG8_LDA
#undef PG8_LDB
#undef PG8_MMA
#undef PG8_WAIT_V
#undef PG8_WAIT_L
#undef PG8_BAR
#undef PG8_SCHED
}
}

#ifndef MK_N_LAUNCHES
#define MK_N_LAUNCHES 1
#endif
constexpr int NWAVES = 8, NTHR = 512;
constexpr int BATCH = 2, SEQ = 16384, T = BATCH * SEQ, D = 1024, DEPTH = 2, DFF = 2816;
constexpr int NIN = 3584, NGU = 5632, PROJ_LD = 3328, AUX_LD = 256;
constexpr float DN_ALPHA = 1.41421356237309515f, LN_EPS = 1e-5f;
constexpr int PC_LX = 0, PC_LG = 256, PC_GQ = 512, PC_GK = 896, PC_GV = 1280, PC_GG = 1664, PC_DQ = 2048, PC_DK = 2432, PC_DV = 2816;
constexpr int AC_GLR = 0, AC_IQ = 16, AC_IK = 144, AC_IW = 176;
constexpr int YC_LRU = 0, YC_GLA = 256, YC_DSA = 640;
enum { I_X = 0, I_WIN, I_CONVW, I_CONVB, I_WA, I_BA, I_WX, I_BX, I_LAM, I_WG2, I_BG, I_NG, I_RB, I_WOUT, I_LN1G, I_LN1B, I_WFG, I_WFU, I_WFD, I_LN2G, I_LN2B, N_INPUTS };

constexpr size_t MiB = 1u << 20;
constexpr size_t WS_CTL = 0, CTL_ZERO_BYTES = 1 * MiB;
constexpr size_t WS_W = 1 * MiB, W_LAYER = 26 * MiB, WO_IN = 0, WO_OUT = 7 * MiB, WO_GU = 9 * MiB, WO_D = 20 * MiB;
constexpr size_t WS_XB = 54 * MiB, WS_PROJ = 118 * MiB, WS_AUX = 326 * MiB, WS_R2 = 358 * MiB, WS_SEL = 486 * MiB, WS_KI = 502 * MiB, WS_END = 504 * MiB;
constexpr size_t WS_V1 = WS_PROJ, WS_H = WS_PROJ, WS_Y = WS_R2, WS_GLAU = WS_R2 + 64 * MiB, WS_DEC = WS_R2 + 112 * MiB, WS_LSUM = WS_R2 + 113 * MiB, WS_CARRY = WS_R2 + 117 * MiB, WS_V2 = WS_R2, WS_BM = WS_XB;
static_assert(WO_IN + (size_t)NIN * D * 2 <= WO_OUT && WO_OUT + (size_t)D * D * 2 <= WO_GU && WO_GU + (size_t)NGU * D * 2 <= WO_D && WO_D + (size_t)D * DFF * 2 <= W_LAYER, "weight map");
static_assert(WS_W + 2 * W_LAYER <= WS_XB && WS_XB + (size_t)T * D * 2 <= WS_PROJ && WS_PROJ + (size_t)T * PROJ_LD * 2 <= WS_AUX && WS_AUX + (size_t)T * AUX_LD * 4 <= WS_R2, "ws map");
static_assert((size_t)T * DFF * 2 <= WS_AUX - WS_PROJ && (size_t)T * D * 4 <= WS_AUX - WS_PROJ && WS_CARRY + 2 * MiB <= WS_END && (size_t)T * D * 4 <= WS_END - WS_R2, "ws overlays");
constexpr int CW_BAR = 4096;

constexpr int RING_OFF = 0, RING_BYTES = 131072;
constexpr int LDSCTL_OFF = RING_BYTES, MISC_OFF = LDSCTL_OFF + 320;
constexpr int LDS_BYTES = 147456;
constexpr int LDS_DCNT = LDSCTL_OFF + 1024, LDS_DTHR = LDS_DCNT + 128, LDS_HIST = LDSCTL_OFF + 2048;

#define GAS __attribute__((address_space(1)))
#define LAS __attribute__((address_space(3)))
typedef unsigned short bf16;
typedef unsigned v4u __attribute__((ext_vector_type(4)));
typedef unsigned v2u __attribute__((ext_vector_type(2)));
typedef float f32x4 __attribute__((ext_vector_type(4)));
typedef GAS unsigned gu32;
typedef _Float16 h16x8 __attribute__((ext_vector_type(8)));
typedef float f32x16 __attribute__((ext_vector_type(16)));
#define RLX_AGENT __ATOMIC_RELAXED, __HIP_MEMORY_SCOPE_AGENT
#define LDS_WAIT() asm volatile("s_waitcnt lgkmcnt(0)" ::: "memory")
#define VM_WAIT() asm volatile("s_waitcnt vmcnt(0)" ::: "memory")
__device__ __forceinline__ unsigned f2bf(float f) { unsigned u = __builtin_bit_cast(unsigned, f); return (u + 0x7fffu + ((u >> 16) & 1u)) >> 16; }
__device__ __forceinline__ unsigned pk2(float lo, float hi) { return f2bf(lo) | (f2bf(hi) << 16); }
__device__ __forceinline__ float bf2f(unsigned short h) { return __builtin_bit_cast(float, (unsigned)h << 16); }
__device__ __forceinline__ float bflo(unsigned w) { return __builtin_bit_cast(float, w << 16); }
__device__ __forceinline__ float bfhi(unsigned w) { return __builtin_bit_cast(float, w & 0xffff0000u); }

#define XB_TMO      128
#define XB_XCNT(j)  (256  + 64 * (j))
#define XB_XSUB(j)  (1280 + 64 * (j))
#define XB_XGEN(j)  (2304 + 64 * (j))
#define XB_TOP      3328
#define XB_TOPGEN   3392
#define XCD_BAR_WORDS 3456
#define XB_SPIN_CAP (1u << 18)

__device__ __forceinline__ unsigned xb_ld(unsigned* p)              { return __hip_atomic_load(p, __ATOMIC_RELAXED, __HIP_MEMORY_SCOPE_AGENT); }
__device__ __forceinline__ unsigned xb_add(unsigned* p, unsigned v) { return __hip_atomic_fetch_add(p, v, __ATOMIC_RELAXED, __HIP_MEMORY_SCOPE_AGENT); }
__device__ __forceinline__ unsigned xb_xcc_id() { return (unsigned)__builtin_amdgcn_s_getreg((3 << 11) | 20) & 0xFu; }
#define XB_SPIN(cond, bar) do { unsigned _sp = 0; while (cond) { __builtin_amdgcn_s_sleep(1); \
    if ((++_sp & 255u) == 0u) { if (xb_ld(&(bar)[XB_TMO])) break; if (_sp > XB_SPIN_CAP) { atomicAdd(&(bar)[XB_TMO], 1u); break; } } } } while (0)

struct XcdBarrier {
    unsigned* bar; unsigned x; int wave;
    volatile LAS unsigned* st;
};

__device__ __forceinline__ XcdBarrier xcd_barrier_post(unsigned* bar, volatile LAS unsigned* st, int wave) {
    XcdBarrier b; b.bar = bar; b.x = xb_xcc_id(); b.st = st; b.wave = wave;
    if (wave == 0 && __builtin_amdgcn_mbcnt_hi(~0u, __builtin_amdgcn_mbcnt_lo(~0u, 0u)) == 0u) (void)xb_add(&bar[XB_XCNT(b.x)], 1u);
    return b;
}
__device__ __forceinline__ void xcd_barrier_complete(unsigned* bar, unsigned x, unsigned& nloc, unsigned& nx) {
    const unsigned G = gridDim.x * gridDim.y * gridDim.z;
    unsigned sum, cnt, mine, sp = 0u;
    for (;;) {
        sum = 0u; cnt = 0u; mine = 0u;
#pragma unroll
        for (unsigned j = 0; j < 16; ++j) { const unsigned c = xb_ld(&bar[XB_XCNT(j)]); sum += c; cnt += (c > 0u) ? 1u : 0u; mine = (j == x) ? c : mine; }
        if (sum == G) break;
        __builtin_amdgcn_s_sleep(1);
        if ((++sp & 255u) == 0u) { if (xb_ld(&bar[XB_TMO])) break; if (sp > XB_SPIN_CAP) { atomicAdd(&bar[XB_TMO], 1u); break; } }
    }
    nloc = mine > 0u ? mine : 1u; nx = cnt > 0u ? cnt : 1u;
}

__device__ __forceinline__ void xcd_barrier(const XcdBarrier& b) {
    asm volatile("s_waitcnt vmcnt(0)" ::: "memory");
    __syncthreads();
    if (b.wave == 0 && __builtin_amdgcn_mbcnt_hi(~0u, __builtin_amdgcn_mbcnt_lo(~0u, 0u)) == 0u) {
        unsigned* bar = b.bar;
        __builtin_amdgcn_s_waitcnt(0);
        unsigned nloc = b.st[0], nx = b.st[1];
        if (nloc == 0u) { xcd_barrier_complete(bar, b.x, nloc, nx); b.st[0] = nloc; b.st[1] = nx; }
        const unsigned old = xb_add(&bar[XB_XSUB(b.x)], 1u);
        const unsigned gen = old / nloc;
        if (old + 1u == (gen + 1u) * nloc) {
            __builtin_amdgcn_fence(__ATOMIC_RELEASE, "agent");
            asm volatile("s_waitcnt vmcnt(0)" ::: "memory");
            const unsigned og = xb_add(&bar[XB_TOP], 1u);
            const unsigned tg = og / nx;
            if (og + 1u == (tg + 1u) * nx) xb_add(&bar[XB_TOPGEN], 1u);
            else XB_SPIN(xb_ld(&bar[XB_TOPGEN]) == tg, bar);
            __builtin_amdgcn_fence(__ATOMIC_ACQUIRE, "agent");
            xb_add(&bar[XB_XGEN(b.x)], 1u);
            asm volatile("s_waitcnt vmcnt(0)" ::: "memory");
        } else {
            XB_SPIN(xb_ld(&bar[XB_XGEN(b.x)]) == gen, bar);
            __builtin_amdgcn_fence(__ATOMIC_ACQUIRE, "agent");
            asm volatile("s_waitcnt vmcnt(0)" ::: "memory");
        }
    }
    __syncthreads();
}


struct Args { const float* in[N_INPUTS]; float* out; unsigned char* ws; int ph_lo, ph_hi; };
struct Frame {
    unsigned char* lds;
    int tid, lane, wave, G;
    float* out; unsigned char* ws;
};
__device__ __forceinline__ bf16* w_ptr(const Frame& F, int l, size_t off) { return (bf16*)(F.ws + WS_W + (size_t)l * W_LAYER + off); }

__device__ __forceinline__ float wave_sum(float v) {
#pragma unroll
    for (int o = 1; o < 64; o <<= 1) v += __shfl_xor(v, o);
    return v;
}

__device__ __forceinline__ void transpose_item(const float* W, int K, int N, bf16* Wt, float* scr, int kb, int rb, int lane, int sc, float scale = 1.f) {
    const int k0 = 64 * kb, r0 = 32 * rb, rl = lane & 31;
#pragma unroll 8
    for (int i = 0; i < 32; ++i) { const int kk = 2 * i + (lane >> 5); scr[kk * 33 + rl] = sc >= 0 ? W[(size_t)(k0 + kk) * N + sc] * scale : 0.f; }
    LDS_WAIT(); asm volatile("" ::: "memory");
    const int c = lane & 7;
#pragma unroll
    for (int j = 0; j < 4; ++j) { const int n = (lane >> 3) + 8 * j; const float* s = scr + (8 * c) * 33 + n;
        v4u o; o.x = pk2(s[0 * 33], s[1 * 33]); o.y = pk2(s[2 * 33], s[3 * 33]); o.z = pk2(s[4 * 33], s[5 * 33]); o.w = pk2(s[6 * 33], s[7 * 33]);
        *(v4u*)(Wt + (size_t)(r0 + n) * K + k0 + 8 * c) = o; }
    LDS_WAIT(); asm volatile("" ::: "memory");
}
__device__ __forceinline__ int win_src(int r) {
    if (r < 2048) return r;
    if (r < 3200) return r + 16;
    if (r < 3328) return -1;
    if (r < 3344) return 2048 + (r - 3328);
    if (r < 3508) return 3216 + (r - 3344);
    return -1;
}
__device__ __forceinline__ void p0_prologue(Frame& F, const Args& A) {
    float* scr = (float*)(F.lds + RING_OFF + F.wave * 16384);
    const int gw = blockIdx.x * NWAVES + F.wave, NGW = F.G * NWAVES;
    constexpr int I_IN = 16 * (NIN / 32), I_OUT = 16 * (D / 32), I_GU = 16 * (NGU / 32), I_D = (DFF / 64) * (D / 32), I_L = I_IN + I_OUT + I_GU + I_D;
    for (int it = gw; it < DEPTH * I_L; it += NGW) {
        const int l = it / I_L; int r = it % I_L;
        if (r < I_IN) { const int kb = r / (NIN / 32), rb = r % (NIN / 32); const int row_ = rb * 32 + (F.lane & 31);
            transpose_item(A.in[I_WIN] + (size_t)l * D * 3380, D, 3380, w_ptr(F, l, WO_IN), scr, kb, rb, F.lane, win_src(row_), (row_ >= PC_DQ && row_ < PC_DQ + 384) ? 0.125f * 1.4426950408889634f : 1.f); continue; } r -= I_IN;
        if (r < I_OUT) { const int kb = r / (D / 32), rb = r % (D / 32); transpose_item(A.in[I_WOUT] + (size_t)l * D * D, D, D, w_ptr(F, l, WO_OUT), scr, kb, rb, F.lane, rb * 32 + (F.lane & 31)); continue; } r -= I_OUT;
        if (r < I_GU) { const int kb = r / (NGU / 32), rb = r % (NGU / 32); const int row = rb * 32 + (F.lane & 31), tile = row >> 8, w = row & 255; const bool up = w >= 128;
            transpose_item(A.in[up ? I_WFU : I_WFG] + (size_t)l * D * DFF, D, DFF, w_ptr(F, l, WO_GU), scr, kb, rb, F.lane, tile * 128 + (w & 127)); continue; } r -= I_GU;
        { const int kb = r / (D / 32), rb = r % (D / 32); transpose_item(A.in[I_WFD] + (size_t)l * DFF * D, DFF, D, w_ptr(F, l, WO_D), scr, kb, rb, F.lane, rb * 32 + (F.lane & 31)); }
    }
    const float* x = A.in[I_X]; bf16* xb = (bf16*)(F.ws + WS_XB);
    for (int m = gw; m < T; m += NGW) {
        const f32x4* xr = (const f32x4*)(x + (size_t)m * D) + F.lane; unsigned long long* o8 = (unsigned long long*)(xb + (size_t)m * D) + F.lane;
#pragma unroll
        for (int j = 0; j < 4; ++j) { const f32x4 v = xr[64 * j]; o8[64 * j] = (unsigned long long)pk2(v.x, v.y) | ((unsigned long long)pk2(v.z, v.w) << 32); }
    }
}

__device__ __forceinline__ void ln_phase(Frame& F, const float* V, const float* g, const float* b, float* xf, bf16* xb) {
    const int gw = blockIdx.x * NWAVES + F.wave, NGW = F.G * NWAVES;
    f32x4 gv[4], bv[4];
#pragma unroll
    for (int j = 0; j < 4; ++j) { gv[j] = ((const f32x4*)g)[F.lane + 64 * j]; bv[j] = ((const f32x4*)b)[F.lane + 64 * j]; }
    for (int m = gw; m < T; m += NGW) {
        const f32x4* xr = (const f32x4*)(V + (size_t)m * D) + F.lane;
        f32x4 v[4]; float s = 0.f;
#pragma unroll
        for (int j = 0; j < 4; ++j) { v[j] = xr[64 * j]; s += (v[j].x + v[j].y) + (v[j].z + v[j].w); }
        const float mean = wave_sum(s) * (1.f / D); float s2 = 0.f;
#pragma unroll
        for (int j = 0; j < 4; ++j) { v[j] = v[j] - mean; s2 += (v[j].x * v[j].x + v[j].y * v[j].y) + (v[j].z * v[j].z + v[j].w * v[j].w); }
        const float rstd = 1.f / sqrtf(wave_sum(s2) * (1.f / D) + LN_EPS);
        f32x4* of = (f32x4*)(xf + (size_t)m * D) + F.lane; unsigned long long* o8 = (unsigned long long*)(xb + (size_t)m * D) + F.lane;
#pragma unroll
        for (int j = 0; j < 4; ++j) { const f32x4 o = v[j] * rstd * gv[j] + bv[j]; of[64 * j] = o; o8[64 * j] = (unsigned long long)pk2(o.x, o.y) | ((unsigned long long)pk2(o.z, o.w) << 32); }
    }
}

__device__ __forceinline__ float sigmoidf_(float x) { return 1.f / (1.f + expf(-x)); }
__device__ __forceinline__ float gelu_tanh(float x) { const float u = 0.7978845608028654f * (x + 0.044715f * x * x * x); return 0.5f * x * (1.f + tanhf(u)); }
__device__ __forceinline__ void lru_item(Frame& F, const Args& A, int l, int it, bool fin) {
    float* XC = (float*)(F.lds + RING_OFF);
    const bf16* proj = (const bf16*)(F.ws + WS_PROJ);
    const int b = it >> 9, t0 = (it & 511) * 32, c = F.tid & 255, half = F.tid >> 8, ts = t0 + half * 16, ck = ts >> 4;
    const float* cw = A.in[I_CONVW] + (size_t)l * 4 * 256; const float cb = A.in[I_CONVB][l * 256 + c];
    const float w0 = cw[c], w1 = cw[256 + c], w2 = cw[512 + c], w3 = cw[768 + c];
    __syncthreads();
    {
        float xm3 = 0.f, xm2 = 0.f, xm1 = 0.f;
        if (ts >= 3) { xm3 = bf2f(proj[(size_t)(b * SEQ + ts - 3) * PROJ_LD + PC_LX + c]); xm2 = bf2f(proj[(size_t)(b * SEQ + ts - 2) * PROJ_LD + PC_LX + c]); xm1 = bf2f(proj[(size_t)(b * SEQ + ts - 1) * PROJ_LD + PC_LX + c]); }
#pragma unroll 4
        for (int i = 0; i < 16; ++i) { const float x0 = bf2f(proj[(size_t)(b * SEQ + ts + i) * PROJ_LD + PC_LX + c]);
            XC[(half * 16 + i) * 256 + c] = cb + w0 * xm3 + w1 * xm2 + w2 * xm1 + w3 * x0; xm3 = xm2; xm2 = xm1; xm1 = x0; }
    }
    __syncthreads();
    const int n = c >> 6, j = c & 63;
    const float* wa = A.in[I_WA] + (size_t)l * 4 * 64 * 64 + (size_t)n * 64 * 64 + j; const float* wx = A.in[I_WX] + (size_t)l * 4 * 64 * 64 + (size_t)n * 64 * 64 + j;
    const float ba = A.in[I_BA][l * 256 + c], bx = A.in[I_BX][l * 256 + c], lam = A.in[I_LAM][l * 256 + c];
    const float sp8 = -8.f * log1pf(expf(-lam));
    float h = 0.f, P = 1.f;
    if (fin) h = ((const float*)(F.ws + WS_CARRY))[(size_t)(b * 256 + c) * 1024 + ck];
    float rp[16], ip[16];
#pragma unroll
    for (int i = 0; i < 16; ++i) { rp[i] = ba; ip[i] = bx; }
    for (int k = 0; k < 64; ++k) { const float a_ = wa[k * 64], x_ = wx[k * 64];
#pragma unroll
        for (int i = 0; i < 16; ++i) { const float xv = XC[(half * 16 + i) * 256 + n * 64 + k]; rp[i] += xv * a_; ip[i] += xv * x_; } }
    bf16* Y = (bf16*)(F.ws + WS_Y);
#pragma unroll
    for (int i = 0; i < 16; ++i) {
        const float xc = XC[(half * 16 + i) * 256 + c];
        const float r = sigmoidf_(rp[i]), ig = sigmoidf_(ip[i]);
        const float la = sp8 * r, a = expf(la), u = sqrtf(-expm1f(2.f * la)) * (ig * xc);
        h = a * h + u; P *= a;
        if (fin) { const size_t tok = (size_t)(b * SEQ + ts + i); const float g = bf2f(proj[tok * PROJ_LD + PC_LG + c]); Y[tok * D + YC_LRU + c] = (bf16)f2bf(h * gelu_tanh(g)); }
    }
    if (!fin) { float2* S = (float2*)(F.ws + WS_LSUM); S[(size_t)(b * 256 + c) * 1024 + ck] = make_float2(P, h); }
}
__device__ __forceinline__ void lru_scan_row(Frame& F, int row) {
    const float2* S = (const float2*)(F.ws + WS_LSUM) + (size_t)row * 1024 + F.lane * 16; float* C = (float*)(F.ws + WS_CARRY) + (size_t)row * 1024 + F.lane * 16;
    float2 e[16];
#pragma unroll
    for (int i = 0; i < 16; ++i) e[i] = S[i];
    float P = 1.f, h = 0.f;
#pragma unroll
    for (int i = 0; i < 16; ++i) { h = e[i].x * h + e[i].y; P *= e[i].x; }
#pragma unroll
    for (int o = 1; o < 64; o <<= 1) { const float Pp = __shfl_up(P, o), hp = __shfl_up(h, o); if (F.lane >= o) { h = P * hp + h; P = Pp * P; } }
    float hc = __shfl_up(h, 1); if (F.lane == 0) hc = 0.f;
#pragma unroll
    for (int i = 0; i < 16; ++i) { C[i] = hc; hc = e[i].x * hc + e[i].y; }
}

__device__ __forceinline__ void gla_item(Frame& F, const Args& A, int l, int it, bool fin) {
    constexpr int LP = 65;
    float* bc = (float*)(F.lds + RING_OFF); float* qd = bc + 64 * LP; float* ki = qd + 64 * LP; float* ke = ki + 64 * LP; float* vv = ke + 64 * LP; float* att = vv + 64 * LP;
    float* glr = att + 64 * LP; float* w2 = glr + 1024; float* bg = w2 + 1024;
    const int b = it / 1536, r_ = it % 1536, n = r_ / 6, h = r_ % 6; const size_t tok0 = (size_t)b * SEQ + (size_t)n * 64;
    const bf16* proj = (const bf16*)(F.ws + WS_PROJ); const float* aux = (const float*)(F.ws + WS_AUX);
    float* U = (float*)(F.ws + WS_GLAU) + (size_t)it * 4096; float* DEC = (float*)(F.ws + WS_DEC) + (size_t)it * 64;
    const int tid = F.tid;
    __syncthreads();
    for (int i = tid; i < 1024; i += NTHR) { const int c = i >> 4, r = i & 15; glr[i] = aux[(tok0 + c) * AUX_LD + AC_GLR + r]; }
    for (int i = tid; i < 1024; i += NTHR) { const int r = i >> 6, d = i & 63; w2[i] = A.in[I_WG2][(size_t)l * 16 * 384 + r * 384 + h * 64 + d]; }
    if (tid < 64) bg[tid] = A.in[I_BG][l * 384 + h * 64 + tid];
    __syncthreads();
    for (int e = tid; e < 4096; e += NTHR) { const int c = e >> 6, d = e & 63; float z = bg[d];
#pragma unroll
        for (int r = 0; r < 16; ++r) z += glr[c * 16 + r] * w2[r * 64 + d];
        bc[c * LP + d] = (fminf(z, 0.f) - log1pf(expf(-fabsf(z)))) * (1.f / 16.f); }
    __syncthreads();
    if (tid < 64) { float s = 0.f; for (int c = 0; c < 64; ++c) { s += bc[c * LP + tid]; bc[c * LP + tid] = s; } }
    __syncthreads();
    for (int e = tid; e < 4096; e += NTHR) { const int c = e >> 6, d = e & 63; const float b_ = bc[c * LP + d], bl = bc[63 * LP + d];
        const bf16* row = proj + (tok0 + c) * PROJ_LD + h * 64 + d;
        const float q = bf2f(row[PC_GQ]), k = bf2f(row[PC_GK]), v = bf2f(row[PC_GV]);
        qd[c * LP + d] = q * 0.125f * expf(b_); ki[c * LP + d] = k * expf(-b_); ke[c * LP + d] = k * expf(bl - b_); vv[c * LP + d] = v; }
    __syncthreads();
    if (!fin) {
        const int d = tid >> 3, dv0 = (tid & 7) * 8; float acc[8];
#pragma unroll
        for (int j = 0; j < 8; ++j) acc[j] = 0.f;
        for (int c = 0; c < 64; ++c) { const float kd = ke[c * LP + d];
#pragma unroll
            for (int j = 0; j < 8; ++j) acc[j] += kd * vv[c * LP + dv0 + j]; }
#pragma unroll
        for (int j = 0; j < 8; ++j) U[d * 64 + dv0 + j] = acc[j];
        if (tid < 64) DEC[tid] = expf(bc[63 * LP + tid]);
    } else {
        const int c = tid >> 3, s0 = (tid & 7) * 8, dv0 = s0; float a[8];
#pragma unroll
        for (int j = 0; j < 8; ++j) a[j] = 0.f;
        for (int d = 0; d < 64; ++d) { const float qv = qd[c * LP + d];
#pragma unroll
            for (int j = 0; j < 8; ++j) a[j] += qv * ki[(s0 + j) * LP + d]; }
#pragma unroll
        for (int j = 0; j < 8; ++j) att[c * LP + s0 + j] = (s0 + j <= c) ? a[j] : 0.f;
        for (int e = tid; e < 4096; e += NTHR) ke[(e >> 6) * LP + (e & 63)] = U[e];
        __syncthreads();
        float o[8];
#pragma unroll
        for (int j = 0; j < 8; ++j) o[j] = 0.f;
        for (int s = 0; s < 64; ++s) { const float av = att[c * LP + s];
#pragma unroll
            for (int j = 0; j < 8; ++j) o[j] += av * vv[s * LP + dv0 + j]; }
        for (int d = 0; d < 64; ++d) { const float qv = qd[c * LP + d];
#pragma unroll
            for (int j = 0; j < 8; ++j) o[j] += qv * ke[d * LP + dv0 + j]; }
        float ss = 0.f;
#pragma unroll
        for (int j = 0; j < 8; ++j) ss += o[j] * o[j];
        ss += __shfl_xor(ss, 1); ss += __shfl_xor(ss, 2); ss += __shfl_xor(ss, 4);
        const float rs = 1.f / sqrtf(ss * (1.f / 64.f) + 1e-6f);
        const bf16* grow = proj + (tok0 + c) * PROJ_LD + PC_GG + h * 64 + dv0; const float* ng = A.in[I_NG] + l * 384 + h * 64 + dv0;
        float y[8];
#pragma unroll
        for (int j = 0; j < 8; ++j) { const float g = bf2f(grow[j]); y[j] = o[j] * rs * ng[j] * (g / (1.f + expf(-g))); }
        v4u w; w.x = pk2(y[0], y[1]); w.y = pk2(y[2], y[3]); w.z = pk2(y[4], y[5]); w.w = pk2(y[6], y[7]);
        *(v4u*)((bf16*)(F.ws + WS_Y) + (tok0 + c) * D + YC_GLA + h * 64 + dv0) = w;
    }
}
__device__ __forceinline__ void gla_scan(Frame& F, int e) {
    const int bh = e >> 12, idx = e & 4095, d = idx >> 6, b = bh / 6, h = bh % 6;
    float* U = (float*)(F.ws + WS_GLAU); const float* DEC = (const float*)(F.ws + WS_DEC);
    float S = 0.f;
    for (int n0 = 0; n0 < 256; n0 += 8) {
        float u[8], dc[8];
#pragma unroll
        for (int i = 0; i < 8; ++i) { const size_t it = (size_t)b * 1536 + (size_t)(n0 + i) * 6 + h; u[i] = U[it * 4096 + idx]; dc[i] = DEC[it * 64 + d]; }
#pragma unroll
        for (int i = 0; i < 8; ++i) { const size_t it = (size_t)b * 1536 + (size_t)(n0 + i) * 6 + h; U[it * 4096 + idx] = S; S = dc[i] * S + u[i]; }
    }
}

__device__ __forceinline__ unsigned f2ord(float f) { const unsigned u = __builtin_bit_cast(unsigned, f); return u ^ ((u >> 31) ? 0xffffffffu : 0x80000000u); }
__device__ __forceinline__ float ord2f(unsigned v) { const unsigned u = (v & 0x80000000u) ? (v ^ 0x80000000u) : ~v; return __builtin_bit_cast(float, u); }
__device__ __forceinline__ int popc64(unsigned long long m) { return __builtin_popcountll(m); }
__device__ __forceinline__ int t5_bucket(int n) { if (n < 16) return n; const int v = 16 + (int)(__log2f((float)n * (1.f / 16.f)) * (16.f / 3.f)); return v < 31 ? v : 31; }
__device__ __forceinline__ unsigned dsa_compact(v2u* buf, int n, int lane) {
    unsigned o[8], id[8];
#pragma unroll
    for (int j = 0; j < 8; ++j) { const int e = j * 64 + lane; if (e < n) { const v2u x = buf[e]; o[j] = x.x; id[j] = x.y; } else { o[j] = 0u; id[j] = 0u; } }
    unsigned v = 0u;
    for (int bit = 31; bit >= 0; --bit) { const unsigned cand = v | (1u << bit); int c = 0;
#pragma unroll
        for (int j = 0; j < 8; ++j) c += popc64(__ballot(o[j] >= cand));
        if (c >= 256) v = cand; }
    int ngt = 0;
#pragma unroll
    for (int j = 0; j < 8; ++j) ngt += popc64(__ballot(o[j] > v));
    const int need = 256 - ngt; int outp = 0, tie_seen = 0;
    const unsigned long long lt = (1ull << lane) - 1ull;
#pragma unroll
    for (int j = 0; j < 8; ++j) {
        const bool isgt = o[j] > v, iseq = o[j] == v;
        const unsigned long long eqm = __ballot(iseq);
        const bool keep = isgt || (iseq && (tie_seen + popc64(eqm & lt)) < need);
        const unsigned long long km = __ballot(keep);
        if (keep) { v2u x; x.x = o[j]; x.y = id[j]; buf[outp + popc64(km & lt)] = x; }
        outp += popc64(km); tie_seen += popc64(eqm);
    }
    return v;
}
__device__ __forceinline__ void dsa_query(Frame& F, const Args& A, int l, int qg) {
    const int lane = F.lane, b = qg >> 14, t = qg & (SEQ - 1);
    float* qs = (float*)(F.lds + RING_OFF + F.wave * 5120); v2u* buf = (v2u*)(F.lds + RING_OFF + F.wave * 5120 + 512 + 512);
    const float* aux = (const float*)(F.ws + WS_AUX); const bf16* proj = (const bf16*)(F.ws + WS_PROJ);
    const float* arow = aux + (size_t)qg * AUX_LD;
    qs[lane] = arow[AC_IQ + lane]; qs[64 + lane] = arow[AC_IQ + 64 + lane];
    float wv[4];
#pragma unroll
    for (int i = 0; i < 4; ++i) wv[i] = arow[AC_IW + i] * 0.5f;
    LDS_WAIT(); asm volatile("" ::: "memory");
    int cnt = 0; float thr = -INFINITY;
    const int ntile = (t >> 6) + 1;
    const unsigned long long lt = (1ull << lane) - 1ull;
    for (int tile = 0; tile < ntile; ++tile) {
        const int s = tile * 64 + lane; const bool valid = s <= t; const int sc = valid ? s : t;
        const f32x4* kp = (const f32x4*)(aux + ((size_t)b * SEQ + sc) * AUX_LD + AC_IK);
        f32x4 k[8];
#pragma unroll
        for (int j = 0; j < 8; ++j) k[j] = kp[j];
        float score = 0.f;
#pragma unroll
        for (int i = 0; i < 4; ++i) { float d = 0.f;
#pragma unroll
            for (int j = 0; j < 8; ++j) { const f32x4 q4 = *(const f32x4*)(qs + i * 32 + j * 4); d += q4.x * k[j].x; d += q4.y * k[j].y; d += q4.z * k[j].z; d += q4.w * k[j].w; }
            score += fmaxf(d, 0.f) * 0.17677669529663687f * wv[i]; }
        score += 0.f;
        const bool pass = valid && (score > thr);
        const unsigned long long pm = __ballot(pass);
        if (pass) { v2u x; x.x = f2ord(score); x.y = (unsigned)s; buf[cnt + popc64(pm & lt)] = x; }
        cnt += popc64(pm);
        if (cnt > 512 - 64) { LDS_WAIT(); asm volatile("" ::: "memory"); thr = ord2f(dsa_compact(buf, cnt, lane)); cnt = 256; LDS_WAIT(); asm volatile("" ::: "memory"); }
    }
    LDS_WAIT(); asm volatile("" ::: "memory");
    if (cnt > 256) { dsa_compact(buf, cnt, lane); cnt = 256; LDS_WAIT(); asm volatile("" ::: "memory"); }
    const int hh = lane >> 3, h = hh < 6 ? hh : 5, dp = lane & 7;
    float q8[8];
    { const v4u qw = *(const v4u*)(proj + (size_t)qg * PROJ_LD + PC_DQ + h * 64 + dp * 8);
      q8[0] = bflo(qw.x) * 0.125f; q8[1] = bfhi(qw.x) * 0.125f; q8[2] = bflo(qw.y) * 0.125f; q8[3] = bfhi(qw.y) * 0.125f; q8[4] = bflo(qw.z) * 0.125f; q8[5] = bfhi(qw.z) * 0.125f; q8[6] = bflo(qw.w) * 0.125f; q8[7] = bfhi(qw.w) * 0.125f; }
    const float* rb = A.in[I_RB];
    float m = -INFINITY, lsum = 0.f, o[8];
#pragma unroll
    for (int i = 0; i < 8; ++i) o[i] = 0.f;
    const bf16* kvbase = proj + (size_t)b * SEQ * PROJ_LD + PC_DK + h * 64 + dp * 8;
    for (int j0 = 0; j0 < cnt; j0 += 8) {
        v4u kw[8], vw[8]; int ss[8];
#pragma unroll
        for (int u = 0; u < 8; ++u) { const int j = (j0 + u < cnt) ? j0 + u : cnt - 1; ss[u] = (int)buf[j].y; const bf16* kr = kvbase + (size_t)ss[u] * PROJ_LD; kw[u] = *(const v4u*)kr; vw[u] = *(const v4u*)(kr + 384); }
#pragma unroll
        for (int u = 0; u < 8; ++u) if (j0 + u < cnt) {
            float dot = q8[0] * bflo(kw[u].x) + q8[1] * bfhi(kw[u].x) + q8[2] * bflo(kw[u].y) + q8[3] * bfhi(kw[u].y) + q8[4] * bflo(kw[u].z) + q8[5] * bfhi(kw[u].z) + q8[6] * bflo(kw[u].w) + q8[7] * bfhi(kw[u].w);
            dot += __shfl_xor(dot, 1); dot += __shfl_xor(dot, 2); dot += __shfl_xor(dot, 4);
            const float logit = dot + rb[t5_bucket(t - ss[u]) * 6 + h];
            const float mn = fmaxf(m, logit), sc = expf(m - mn), p = expf(logit - mn);
            lsum = lsum * sc + p; m = mn;
            o[0] = o[0] * sc + p * bflo(vw[u].x); o[1] = o[1] * sc + p * bfhi(vw[u].x); o[2] = o[2] * sc + p * bflo(vw[u].y); o[3] = o[3] * sc + p * bfhi(vw[u].y);
            o[4] = o[4] * sc + p * bflo(vw[u].z); o[5] = o[5] * sc + p * bfhi(vw[u].z); o[6] = o[6] * sc + p * bflo(vw[u].w); o[7] = o[7] * sc + p * bfhi(vw[u].w);
        }
    }
    const float inv = 1.f / lsum;
    if (hh < 6) { v4u w; w.x = pk2(o[0] * inv, o[1] * inv); w.y = pk2(o[2] * inv, o[3] * inv); w.z = pk2(o[4] * inv, o[5] * inv); w.w = pk2(o[6] * inv, o[7] * inv);
        *(v4u*)((bf16*)(F.ws + WS_Y) + (size_t)qg * D + YC_DSA + h * 64 + dp * 8) = w; }
}

typedef short gbf16x8 __attribute__((ext_vector_type(8)));
__device__ __forceinline__ gbf16x8 gla_frag(const unsigned short* tile, int row, int k0) { return *(const gbf16x8*)(tile + row * 72 + k0); }
__device__ __forceinline__ void gla_item2(Frame& F, const Args& A, int l, int it, bool fin) {
    constexpr int LP = 65, TS = 64 * 72;
    float* bc = (float*)(F.lds + RING_OFF); float* Ot = bc + 64 * LP; float* glr = Ot + 64 * LP; float* w2 = glr + 1024; float* bg = w2 + 1024;
    unsigned short* T_QD = (unsigned short*)(bg + 64); unsigned short* T_KI = T_QD + TS; unsigned short* T_KET = T_KI + TS; unsigned short* T_VT = T_KET + TS; unsigned short* T_ATT = T_VT + TS; unsigned short* T_ST = T_ATT + TS;
    const int b = it / 1536, r_ = it % 1536, n = r_ / 6, h = r_ % 6; const size_t tok0 = (size_t)b * SEQ + (size_t)n * 64;
    const bf16* proj = (const bf16*)(F.ws + WS_PROJ); const float* aux = (const float*)(F.ws + WS_AUX);
    float* U = (float*)(F.ws + WS_GLAU) + (size_t)it * 4096; float* DEC = (float*)(F.ws + WS_DEC) + (size_t)it * 64;
    const int tid = F.tid, lane = F.lane, wave = F.wave, r32 = lane & 31, hi = lane >> 5;
    unsigned short rq[8], rk[8], rv[8]; float ru[8];
#pragma unroll
    for (int i = 0; i < 8; ++i) { const int e = tid + NTHR * i, c = e >> 6, d = e & 63; const bf16* row = proj + (tok0 + c) * PROJ_LD + h * 64 + d;
        rk[i] = row[PC_GK]; rv[i] = row[PC_GV]; rq[i] = fin ? row[PC_GQ] : (unsigned short)0; ru[i] = fin ? U[e] : 0.f; }
    v4u rgg = {}; f32x4 rng0 = {}, rng1 = {};
    if (fin) { const int c = tid >> 3, dv0 = (tid & 7) * 8; rgg = *(const v4u*)(proj + (tok0 + c) * PROJ_LD + PC_GG + h * 64 + dv0); const float* ng = A.in[I_NG] + l * 384 + h * 64 + dv0; rng0 = *(const f32x4*)ng; rng1 = *(const f32x4*)(ng + 4); }
    __syncthreads();
    for (int i = tid; i < 1024; i += NTHR) { const int c = i >> 4, r = i & 15; glr[i] = aux[(tok0 + c) * AUX_LD + AC_GLR + r]; }
    for (int i = tid; i < 1024; i += NTHR) { const int r = i >> 6, d = i & 63; w2[i] = A.in[I_WG2][(size_t)l * 16 * 384 + r * 384 + h * 64 + d]; }
    if (tid < 64) bg[tid] = A.in[I_BG][l * 384 + h * 64 + tid];
    __syncthreads();
    { const int d = tid & 63, cg = tid >> 6; float wr[16];
#pragma unroll
      for (int r = 0; r < 16; ++r) wr[r] = w2[r * 64 + d];
      const float bgd = bg[d];
#pragma unroll
      for (int i = 0; i < 8; ++i) { const int c = cg + 8 * i; float z = bgd;
#pragma unroll
          for (int r = 0; r < 16; r += 4) { const f32x4 g4 = *(const f32x4*)(glr + c * 16 + r); z += g4.x * wr[r] + g4.y * wr[r + 1] + g4.z * wr[r + 2] + g4.w * wr[r + 3]; }
          const float ez = __builtin_amdgcn_exp2f(-1.44269504089f * fabsf(z));
          bc[c * LP + d] = (fminf(z, 0.f) - 0.69314718056f * __builtin_amdgcn_logf(1.f + ez)) * (1.f / 16.f); } }
    __syncthreads();
#pragma unroll
    for (int j = 0; j < 8; ++j) { const int d = wave * 8 + j; float x = bc[lane * LP + d];
#pragma unroll
        for (int o = 1; o < 64; o <<= 1) { const float y = __shfl_up(x, o); if (lane >= o) x += y; }
        bc[lane * LP + d] = x; }
    __syncthreads();
#pragma unroll
    for (int i = 0; i < 8; ++i) { const int e = tid + NTHR * i, c = e >> 6, d = e & 63; const float b_ = bc[c * LP + d] * 1.44269504089f, bl = bc[63 * LP + d] * 1.44269504089f;
        const float k = bf2f(rk[i]); T_VT[d * 72 + c] = rv[i];
        if (fin) { const float q = bf2f(rq[i]); T_QD[c * 72 + d] = (unsigned short)f2bf(q * 0.125f * __builtin_amdgcn_exp2f(b_)); T_KI[c * 72 + d] = (unsigned short)f2bf(k * __builtin_amdgcn_exp2f(-b_)); T_ST[d * 72 + c] = (unsigned short)f2bf(ru[i]); }
        else T_KET[d * 72 + c] = (unsigned short)f2bf(k * __builtin_amdgcn_exp2f(bl - b_)); }
    __syncthreads();
    if (!fin) {
        if (wave < 4) { const int dt = wave >> 1, vt = wave & 1; f32x16 acc = {};
#pragma unroll
            for (int ks = 0; ks < 4; ++ks) acc = __builtin_amdgcn_mfma_f32_32x32x16_bf16(gla_frag(T_KET, dt * 32 + r32, ks * 16 + hi * 8), gla_frag(T_VT, vt * 32 + r32, ks * 16 + hi * 8), acc, 0, 0, 0);
#pragma unroll
            for (int r = 0; r < 16; ++r) U[(dt * 32 + (r & 3) + 8 * (r >> 2) + 4 * hi) * 64 + vt * 32 + r32] = acc[r]; }
        if (tid < 64) DEC[tid] = __builtin_amdgcn_exp2f(1.44269504089f * bc[63 * LP + tid]);
    } else {
        f32x16 acc = {};
        if (wave < 4) { const int ct = wave >> 1, st = wave & 1;
#pragma unroll
            for (int ks = 0; ks < 4; ++ks) acc = __builtin_amdgcn_mfma_f32_32x32x16_bf16(gla_frag(T_QD, ct * 32 + r32, ks * 16 + hi * 8), gla_frag(T_KI, st * 32 + r32, ks * 16 + hi * 8), acc, 0, 0, 0);
#pragma unroll
            for (int r = 0; r < 16; ++r) { const int c = ct * 32 + (r & 3) + 8 * (r >> 2) + 4 * hi, s = st * 32 + r32; T_ATT[c * 72 + s] = (unsigned short)f2bf(s <= c ? acc[r] : 0.f); }
        } else { const int ct = (wave >> 1) & 1, vt = wave & 1;
#pragma unroll
            for (int ks = 0; ks < 4; ++ks) acc = __builtin_amdgcn_mfma_f32_32x32x16_bf16(gla_frag(T_QD, ct * 32 + r32, ks * 16 + hi * 8), gla_frag(T_ST, vt * 32 + r32, ks * 16 + hi * 8), acc, 0, 0, 0);
        }
        __syncthreads();
        if (wave >= 4) { const int ct = (wave >> 1) & 1, vt = wave & 1;
#pragma unroll
            for (int ks = 0; ks < 4; ++ks) acc = __builtin_amdgcn_mfma_f32_32x32x16_bf16(gla_frag(T_ATT, ct * 32 + r32, ks * 16 + hi * 8), gla_frag(T_VT, vt * 32 + r32, ks * 16 + hi * 8), acc, 0, 0, 0);
#pragma unroll
            for (int r = 0; r < 16; ++r) Ot[(ct * 32 + (r & 3) + 8 * (r >> 2) + 4 * hi) * LP + vt * 32 + r32] = acc[r]; }
        __syncthreads();
        const int c = tid >> 3, dv0 = (tid & 7) * 8; float o[8];
#pragma unroll
        for (int j = 0; j < 8; ++j) o[j] = Ot[c * LP + dv0 + j];
        float ss = 0.f;
#pragma unroll
        for (int j = 0; j < 8; ++j) ss += o[j] * o[j];
        ss += __shfl_xor(ss, 1); ss += __shfl_xor(ss, 2); ss += __shfl_xor(ss, 4);
        const float rs = 1.f / sqrtf(ss * (1.f / 64.f) + 1e-6f);
        const float gg8[8] = {bflo(rgg.x), bfhi(rgg.x), bflo(rgg.y), bfhi(rgg.y), bflo(rgg.z), bfhi(rgg.z), bflo(rgg.w), bfhi(rgg.w)};
        const float ng8[8] = {rng0[0], rng0[1], rng0[2], rng0[3], rng1[0], rng1[1], rng1[2], rng1[3]};
        float y[8];
#pragma unroll
        for (int j = 0; j < 8; ++j) { const float g = gg8[j]; y[j] = o[j] * rs * ng8[j] * (g * __builtin_amdgcn_rcpf(1.f + __builtin_amdgcn_exp2f(-1.44269504089f * g))); }
        v4u w; w.x = pk2(y[0], y[1]); w.y = pk2(y[2], y[3]); w.z = pk2(y[4], y[5]); w.w = pk2(y[6], y[7]);
        *(v4u*)((bf16*)(F.ws + WS_Y) + (tok0 + c) * D + YC_GLA + h * 64 + dv0) = w;
    }
}

constexpr size_t WO_LRU = 25 * MiB + 512 * 1024;
__device__ __forceinline__ void lru_item2(Frame& F, const Args& A, int l, int it, bool fin) {
    constexpr int XP = 264;
    float* XC = (float*)(F.lds + RING_OFF);
    float* RG = XC + 32 * 256; float* IG = RG + 32 * 256;
    unsigned short* XB_ = (unsigned short*)(IG + 32 * 256);
    const bf16* proj = (const bf16*)(F.ws + WS_PROJ);
    const int b = it >> 9, t0 = (it & 511) * 32, c = F.tid & 255, half = F.tid >> 8, ts = t0 + half * 16, ck = ts >> 4;
    const int lane = F.lane, wave = F.wave, r32 = lane & 31, hi = lane >> 5;
    const float* cw = A.in[I_CONVW] + (size_t)l * 4 * 256; const float cb = A.in[I_CONVB][l * 256 + c];
    const float w0 = cw[c], w1 = cw[256 + c], w2 = cw[512 + c], w3 = cw[768 + c];
    const unsigned short* WT = (const unsigned short*)w_ptr(F, l, WO_LRU);
    gbf16x8 wf[2][4];
#pragma unroll
    for (int u = 0; u < 2; ++u) { const int tI = wave * 2 + u, g = tI >> 3, n = (tI >> 1) & 3, jt = tI & 1;
        const unsigned short* wrow = WT + (size_t)g * 16384 + (size_t)n * 4096 + (size_t)(jt * 32 + r32) * 64 + hi * 8;
#pragma unroll
        for (int ks = 0; ks < 4; ++ks) wf[u][ks] = *(const gbf16x8*)(wrow + ks * 16); }
    float xm3 = 0.f, xm2 = 0.f, xm1 = 0.f;
    if (ts >= 3) { xm3 = bf2f(proj[(size_t)(b * SEQ + ts - 3) * PROJ_LD + PC_LX + c]); xm2 = bf2f(proj[(size_t)(b * SEQ + ts - 2) * PROJ_LD + PC_LX + c]); xm1 = bf2f(proj[(size_t)(b * SEQ + ts - 1) * PROJ_LD + PC_LX + c]); }
    float xv[16], gv[16];
#pragma unroll
    for (int i = 0; i < 16; ++i) xv[i] = bf2f(proj[(size_t)(b * SEQ + ts + i) * PROJ_LD + PC_LX + c]);
#pragma unroll
    for (int i = 0; i < 16; ++i) gv[i] = fin ? bf2f(proj[(size_t)(b * SEQ + ts + i) * PROJ_LD + PC_LG + c]) : 0.f;
    const float ba = A.in[I_BA][l * 256 + c], bx = A.in[I_BX][l * 256 + c], lam = A.in[I_LAM][l * 256 + c];
    float h = 0.f, P = 1.f;
    if (fin) h = ((const float*)(F.ws + WS_CARRY))[(size_t)(b * 256 + c) * 1024 + ck];
    __syncthreads();
#pragma unroll
    for (int i = 0; i < 16; ++i) { const float x0 = xv[i], v = cb + w0 * xm3 + w1 * xm2 + w2 * xm1 + w3 * x0;
        XC[(half * 16 + i) * 256 + c] = v; XB_[(half * 16 + i) * XP + c] = (unsigned short)f2bf(v); xm3 = xm2; xm2 = xm1; xm1 = x0; }
    __syncthreads();
#pragma unroll
    for (int u = 0; u < 2; ++u) { const int tI = wave * 2 + u, g = tI >> 3, n = (tI >> 1) & 3, jt = tI & 1;
        f32x16 acc = {};
#pragma unroll
        for (int ks = 0; ks < 4; ++ks) acc = __builtin_amdgcn_mfma_f32_32x32x16_bf16(*(const gbf16x8*)(XB_ + r32 * XP + n * 64 + ks * 16 + hi * 8), wf[u][ks], acc, 0, 0, 0);
        float* G = g ? IG : RG;
#pragma unroll
        for (int r = 0; r < 16; ++r) G[((r & 3) + 8 * (r >> 2) + 4 * hi) * 256 + n * 64 + jt * 32 + r32] = acc[r]; }
    __syncthreads();
    const float sp8 = -8.f * log1pf(expf(-lam));
    bf16* Yp = (bf16*)(F.ws + WS_Y);
#pragma unroll
    for (int i = 0; i < 16; ++i) {
        const int tl = half * 16 + i;
        const float xc = XC[tl * 256 + c];
        const float r = __builtin_amdgcn_rcpf(1.f + __builtin_amdgcn_exp2f(-1.44269504089f * (RG[tl * 256 + c] + ba))), ig = __builtin_amdgcn_rcpf(1.f + __builtin_amdgcn_exp2f(-1.44269504089f * (IG[tl * 256 + c] + bx)));
        const float la = sp8 * r, a = __builtin_amdgcn_exp2f(1.44269504089f * la), x2 = 2.f * la;
        const float om = x2 > -0.1f ? -x2 * (1.f + x2 * (0.5f + x2 * (0.16666667f + x2 * 0.041666668f))) : 1.f - a * a;
        const float u = __builtin_amdgcn_sqrtf(om) * (ig * xc);
        h = a * h + u; P *= a;
        if (fin) { const size_t tok = (size_t)(b * SEQ + ts + i); const float g = gv[i], t2 = 1.5957691216057308f * (g + 0.044715f * g * g * g);
            Yp[tok * D + YC_LRU + c] = (bf16)f2bf(h * g * __builtin_amdgcn_rcpf(1.f + __builtin_amdgcn_exp2f(-1.44269504089f * t2))); }
    }
    if (!fin) { float2* S = (float2*)(F.ws + WS_LSUM); S[(size_t)(b * 256 + c) * 1024 + ck] = make_float2(P, h); }
}
__device__ __forceinline__ void lru_weights_prologue(Frame& F, const Args& A) {
    const int gt = blockIdx.x * NTHR + F.tid, NT_ = F.G * NTHR;
    for (int e = gt; e < DEPTH * 2 * 16384; e += NT_) { const int l = e / 32768, g = (e >> 14) & 1, n = (e >> 12) & 3, j = (e >> 6) & 63, k = e & 63;
        const float v = A.in[g ? I_WX : I_WA][(size_t)l * 16384 + n * 4096 + k * 64 + j];
        ((unsigned short*)w_ptr(F, l, WO_LRU))[(size_t)g * 16384 + n * 4096 + j * 64 + k] = (unsigned short)f2bf(v); }
}

__device__ __forceinline__ int wave_suffix_incl(int v, int lane) {
#pragma unroll
    for (int o = 1; o < 64; o <<= 1) { const int t = __shfl_down(v, o); if (lane + o < 64) v += t; }
    return v;
}
template <bool EXACT> __device__ __forceinline__ unsigned dsa_topk_compact(unsigned* cand, unsigned* hist, int n, int lane, int* kept) {
    unsigned e[16];
#pragma unroll
    for (int j = 0; j < 16; ++j) { const int i = j * 64 + lane; e[j] = i < n ? cand[i] : 0u; }
    unsigned prefix = 0u;
    int c_at = n;
#pragma unroll 1
    for (int bit = 31; bit >= (EXACT ? 0 : 16); --bit) {
        if (EXACT && c_at == 256) break;
        const unsigned cv = prefix | (1u << bit); int c = 0;
#pragma unroll
        for (int j = 0; j < 16; ++j) c += popc64(__ballot(e[j] >= cv));
        if (c >= 256) { prefix = cv; c_at = c; } }
    const unsigned K = prefix; int outp = 0; const unsigned long long lt = (1ull << lane) - 1ull;
#pragma unroll
    for (int j = 0; j < 16; ++j) { const bool keep = e[j] >= K && e[j] != 0u; const unsigned long long km = __ballot(keep); if (keep) cand[outp + popc64(km & lt)] = e[j]; outp += popc64(km); }
    *kept = outp;
    return K;
}
__device__ __forceinline__ unsigned dsa_kth(const unsigned* cand, int n, int m, int lane) {
    unsigned e[16];
#pragma unroll
    for (int j = 0; j < 16; ++j) { const int i = j * 64 + lane; e[j] = i < n ? cand[i] : 0u; }
    unsigned prefix = 0u; int c_at = n;
#pragma unroll 1
    for (int bit = 31; bit >= 0; --bit) {
        if (bit == 13 && c_at <= m + 4) break;
        const unsigned cv = prefix | (1u << bit); int c = 0;
#pragma unroll
        for (int j = 0; j < 16; ++j) c += popc64(__ballot(e[j] >= cv));
        if (c >= m) { prefix = cv; c_at = c; } }
    return prefix;
}
__device__ __forceinline__ float relu_(float x) { const int b = __builtin_bit_cast(int, x); return __builtin_bit_cast(float, b > 0 ? b : 0); }
__device__ __forceinline__ void dsa_scores(const h16x8& ka0, const h16x8& ka1, const h16x8 (&qb)[4][2], const float (&wv)[4], float (&sc)[16]) {
    f32x16 acc[4];
#pragma unroll
    for (int i = 0; i < 4; ++i) { f32x16 z = {}; z = __builtin_amdgcn_mfma_f32_32x32x16_f16(ka0, qb[i][0], z, 0, 0, 0); acc[i] = __builtin_amdgcn_mfma_f32_32x32x16_f16(ka1, qb[i][1], z, 0, 0, 0); }
#pragma unroll
    for (int r = 0; r < 16; ++r) { float s_ = relu_(acc[0][r]) * wv[0]; s_ += relu_(acc[1][r]) * wv[1]; s_ += relu_(acc[2][r]) * wv[2]; s_ += relu_(acc[3][r]) * wv[3]; sc[r] = s_ + 0.f; }
}
constexpr int DSA_M = 36;
__device__ __forceinline__ void dsa_item(Frame& F, const Args& A, int l, int item) {
    const int lane = F.lane, wave = F.wave, qbase = item * 32, b = qbase >> 14, t0 = qbase & (SEQ - 1), r32 = lane & 31, hi = lane >> 5;
    unsigned* cand = (unsigned*)(F.lds + RING_OFF); unsigned* cnt = (unsigned*)(F.lds + LDS_DCNT); float* thr = (float*)(F.lds + LDS_DTHR); unsigned* hist = (unsigned*)(F.lds + LDS_HIST) + wave * 256;
    unsigned* K0a = (unsigned*)(F.lds + LDS_HIST + 8192); unsigned* flag = K0a + 32;
    const float* aux = (const float*)(F.ws + WS_AUX); const _Float16* KI = (const _Float16*)(F.ws + WS_KI) + (size_t)b * SEQ * 32;
    __syncthreads();
    if (F.tid < 32) { cnt[F.tid] = 0u; thr[F.tid] = -INFINITY; }
    if (F.tid == 0) flag[0] = 0u;
    h16x8 qb[4][2]; float wv[4];
    { const float* arow = aux + (size_t)(qbase + r32) * AUX_LD;
#pragma unroll
      for (int i = 0; i < 4; ++i) { wv[i] = arow[AC_IW + i] * (0.5f * 0.17677669529663687f);
#pragma unroll
        for (int kh = 0; kh < 2; ++kh) { const f32x4 a0 = *(const f32x4*)(arow + AC_IQ + i * 32 + kh * 16 + hi * 8), a1 = *(const f32x4*)(arow + AC_IQ + i * 32 + kh * 16 + hi * 8 + 4);
            h16x8 v; v[0] = (_Float16)a0[0]; v[1] = (_Float16)a0[1]; v[2] = (_Float16)a0[2]; v[3] = (_Float16)a0[3]; v[4] = (_Float16)a1[0]; v[5] = (_Float16)a1[1]; v[6] = (_Float16)a1[2]; v[7] = (_Float16)a1[3]; qb[i][kh] = v; } } }
    __syncthreads();
    const int ntile = (t0 >> 5) + 1, nround = (ntile + 7) >> 3;
    unsigned* cq = cand + r32 * 1024;
    bool need_stream = true;
#ifndef DSA_NO_FAST
    if (ntile > 32) {
#pragma unroll 1
        for (int i = wave; 16 * i + 7 < ntile - 1; i += 8) { const int j = 16 * i + 7;
            const _Float16* kp = KI + (size_t)(j * 32 + r32) * 32 + hi * 8; const h16x8 ka0 = *(const h16x8*)kp, ka1 = *(const h16x8*)(kp + 16);
            float sc[16]; dsa_scores(ka0, ka1, qb, wv, sc);
            unsigned slot = atomicAdd(&cnt[r32], 16u);
#pragma unroll
            for (int r = 0; r < 16; ++r) { const int s = j * 32 + 8 * (r >> 2) + 4 * hi + (r & 3); cq[slot + r] = (f2ord(sc[r]) & 0xffffc000u) | (unsigned)(16383 - s); } }
        __syncthreads();
#pragma unroll 1
        for (int qi = 0; qi < 4; ++qi) { const int q = wave * 4 + qi; const int ns = (int)cnt[q]; unsigned K0 = 0u;
            if (ns > DSA_M) K0 = dsa_kth(cand + q * 1024, ns, DSA_M, lane);
            if (lane == 0) { K0a[q] = K0; thr[q] = K0 ? ord2f(K0 & 0xffffc000u) : -INFINITY; } }
        __syncthreads();
        const unsigned K0q = K0a[r32]; const float thf = thr[r32];
        __syncthreads();
        if (F.tid < 32) cnt[F.tid] = 0u;
        __syncthreads();
        h16x8 kn0 = {}, kn1 = {};
        { const _Float16* kp = KI + (size_t)(wave * 32 + r32) * 32 + hi * 8; kn0 = *(const h16x8*)kp; kn1 = *(const h16x8*)(kp + 16); }
#pragma unroll 1
        for (int j = wave; j < ntile; j += 8) {
            const h16x8 ka0 = kn0, ka1 = kn1;
            if (j + 8 < ntile) { const _Float16* kp = KI + (size_t)((j + 8) * 32 + r32) * 32 + hi * 8; kn0 = *(const h16x8*)kp; kn1 = *(const h16x8*)(kp + 16); }
            float sc[16]; dsa_scores(ka0, ka1, qb, wv, sc);
            const bool diag = (j == ntile - 1);
            unsigned pk[16]; int n = 0;
#pragma unroll
            for (int r = 0; r < 16; ++r) { const int krel = 8 * (r >> 2) + 4 * hi + (r & 3); unsigned v = 0u;
                if ((sc[r] >= thf) && (!diag || krel <= r32)) { v = (f2ord(sc[r]) & 0xffffc000u) | (unsigned)(16383 - (j * 32 + krel)); v = v >= K0q ? v : 0u; }
                pk[r] = v; n += v ? 1 : 0; }
            if (n > 0) { unsigned slot = atomicAdd(&cnt[r32], (unsigned)n);
#pragma unroll
                for (int r = 0; r < 16; ++r) if (pk[r]) { if (slot < 1024u) cq[slot] = pk[r]; ++slot; } }
        }
        __syncthreads();
        if (F.tid < 32) { const unsigned n = cnt[F.tid]; const unsigned need = (unsigned)(t0 + F.tid + 1) < 256u ? (unsigned)(t0 + F.tid + 1) : 256u; if (n < need || n > 1024u) atomicOr(flag, 1u); }
        __syncthreads();
        need_stream = flag[0] != 0u;
        __syncthreads();
        if (need_stream && F.tid < 32) { cnt[F.tid] = 0u; thr[F.tid] = -INFINITY; }
        __syncthreads();
    }
#endif
    if (need_stream) {
    float th = -INFINITY;
    h16x8 kn0 = {}, kn1 = {};
    if (wave < ntile) { const _Float16* kp = KI + (size_t)(wave * 32 + r32) * 32 + hi * 8; kn0 = *(const h16x8*)kp; kn1 = *(const h16x8*)(kp + 16); }
    for (int rd = 0; rd < nround; ++rd) {
        const int j = rd * 8 + wave;
        const h16x8 ka0 = kn0, ka1 = kn1;
        if (j + 8 < ntile) { const _Float16* kp = KI + (size_t)((j + 8) * 32 + r32) * 32 + hi * 8; kn0 = *(const h16x8*)kp; kn1 = *(const h16x8*)(kp + 16); }
        if (j < ntile) {
            float sc[16]; dsa_scores(ka0, ka1, qb, wv, sc);
            const bool diag = (j == ntile - 1);
            int n = 0;
#pragma unroll
            for (int r = 0; r < 16; ++r) { const int krel = 8 * (r >> 2) + 4 * hi + (r & 3);
                const bool p = (sc[r] >= th) && (!diag || krel <= r32);
                sc[r] = p ? sc[r] : -INFINITY; n += p ? 1 : 0; }
            if (n > 0) {
                unsigned slot = atomicAdd(&cnt[r32], (unsigned)n);
#pragma unroll
                for (int r = 0; r < 16; ++r) if (sc[r] != -INFINITY) { const int s = j * 32 + 8 * (r >> 2) + 4 * hi + (r & 3); cq[slot] = (f2ord(sc[r]) & 0xffffc000u) | (unsigned)(16383 - s); ++slot; }
            }
        }
        __syncthreads();
#pragma unroll 1
        for (int qi = 0; qi < 4; ++qi) { const int q = wave * 4 + qi; const int n = (int)cnt[q];
            if (n > 768) { int kept; unsigned K = dsa_topk_compact<false>(cand + q * 1024, hist, n, lane, &kept); float th_ = ord2f(K);
                if (kept > 512) { LDS_WAIT(); asm volatile("" ::: "memory"); K = dsa_topk_compact<true>(cand + q * 1024, hist, kept, lane, &kept); th_ = ord2f(((K >> 14) + 1u) << 14); }
                if (lane == 0) { cnt[q] = (unsigned)kept; thr[q] = th_; } } }
        __syncthreads();
        th = thr[r32];
    }
    }
#pragma unroll 1
    for (int qi = 0; qi < 4; ++qi) { const int q = wave * 4 + qi; const int n = (int)cnt[q];
        if (n > 256) { int kept; dsa_topk_compact<true>(cand + q * 1024, hist, n, lane, &kept); if (lane == 0) cnt[q] = 256u; } }
    LDS_WAIT(); asm volatile("" ::: "memory");
#ifndef NO_BMTAIL
#pragma unroll 1
    for (int qi = 0; qi < 4; ++qi) {
        const int q = wave * 4 + qi; const int n = (int)cnt[q]; unsigned* cq = cand + q * 1024; unsigned* bm = cq + 512;
        *(v4u*)(bm + 8 * lane) = (v4u){0u, 0u, 0u, 0u}; *(v4u*)(bm + 8 * lane + 4) = (v4u){0u, 0u, 0u, 0u};
        LDS_WAIT(); asm volatile("" ::: "memory");
#pragma unroll
        for (int j = 0; j < 4; ++j) { const int e = j * 64 + lane; if (e < n) { const unsigned s = 16383u - (cq[e] & 0x3fffu); atomicOr(&bm[s >> 5], 1u << (s & 31u)); } }
    }
    __syncthreads();
    { unsigned* BM = (unsigned*)(F.ws + WS_BM); const int ntp = 2 * ((t0 >> 8) + 1), qbg = qbase >> 8, ql0 = qbase & 255;
      for (int idx = F.tid; idx < ntp * 32; idx += NTHR) { const int q = idx & 31, tp = idx >> 5;
          const v4u w = *(const v4u*)(cand + q * 1024 + 512 + tp * 4);
          *(v4u*)(BM + (((size_t)qbg * 128 + tp) * 256 + ql0 + q) * 4) = w; } }
#endif
}
#include <hip/hip_bf16.h>
#include <cmath>
namespace attn_body {
using bf16=__hip_bfloat16;
using bf16x8=__attribute__((ext_vector_type(8)))short;
using s16x4=__attribute__((ext_vector_type(4)))short;
using f32x16=__attribute__((ext_vector_type(16)))float;
using u32x4=__attribute__((ext_vector_type(4)))unsigned;
constexpr int BATCH=2,NHEAD=6,SEQ=16384,D=64,QP=3328,OP=1024;
constexpr int NW=8,QBLK=32,QB=QBLK*NW,KVBLK=64,NQB=SEQ/QB;
constexpr int ATTN_UNIT_ROWS=QB;
__device__ __forceinline__ int crow(int r,int hi){return (r&3)+8*(r>>2)+4*hi;}
#define SBAR() __builtin_amdgcn_sched_barrier(0)
__device__ __forceinline__ void cmask(f32x16&p0,f32x16&p1,int jb,int qrel,int hi){
  const float NEG=-INFINITY; int kb=64*jb+4*hi;
  #pragma unroll
  for(int r=0;r<16;++r){int kv=kb+(r&3)+8*(r>>2); if(kv>qrel)p0[r]=NEG; if(kv+32>qrel)p1[r]=NEG;}
}

constexpr int NSLOT=3, SLOTB=8192;
constexpr int LDS_K=0, LDS_V=NSLOT*SLOTB, LDS_WS=2*NSLOT*SLOTB, LDS_OST=LDS_WS+NW*64*4, LDS_BT=LDS_OST+NW*4096, LDS_MK=LDS_BT+1024, LDS_BYTES=LDS_MK+2*4096;
constexpr float C2=0.125f*1.4426950408889634f;
__device__ __forceinline__ void glds16(const void*gsrc,unsigned lds_dst){unsigned keep;
  asm volatile("s_mov_b32 %0, m0\n\ts_mov_b32 m0, %2\n\ts_nop 0\n\tglobal_load_lds_dwordx4 %1, off\n\ts_mov_b32 m0, %0":"=&s"(keep):"v"(gsrc),"s"(lds_dst):"memory");}
__device__ __forceinline__ float max3f(float a,float b,float c){float r;asm("v_max3_f32 %0, %1, %2, %3":"=v"(r):"v"(a),"v"(b),"v"(c));return r;}
__device__ __forceinline__ float max2f(float a,float b){float r;asm("v_max_f32_e32 %0, %1, %2":"=v"(r):"v"(a),"v"(b));return r;}
__device__ __forceinline__ float fadd_s(float a,float b){float r;asm("v_add_f32_e32 %0, %1, %2":"=v"(r):"v"(a),"v"(b));return r;}
__device__ __forceinline__ float fsub_s(float a,float b){float r;asm("v_sub_f32_e32 %0, %1, %2":"=v"(r):"v"(a),"v"(b));return r;}
typedef float f32x2_t __attribute__((ext_vector_type(2))); typedef __bf16 bf16x2_t __attribute__((ext_vector_type(2)));
__device__ __forceinline__ unsigned cvtpk_s(float lo,float hi){f32x2_t v={lo,hi};bf16x2_t b=__builtin_convertvector(v,bf16x2_t);return __builtin_bit_cast(unsigned,b);}
__device__ __forceinline__ void glds16s(unsigned voff,const void*sbase,unsigned lds_dst){unsigned keep;
  asm volatile("s_nop 4\n\ts_mov_b32 %0, m0\n\ts_mov_b32 m0, %3\n\ts_nop 0\n\tglobal_load_lds_dwordx4 %1, %2\n\ts_mov_b32 m0, %0":"=&s"(keep):"v"(voff),"s"(sbase),"s"(lds_dst):"memory");}
#define WAIT_BAR(N) asm volatile("s_waitcnt vmcnt(" #N ") lgkmcnt(0)\n\ts_barrier":::"memory")

__device__ __forceinline__ void qkt(f32x16&p0,f32x16&p1,const char*Kslot,const bf16x8*qr,const f32x16&negm,int r32,int hi){
  const char*kb=Kslot+hi*1024+r32*16;
  #pragma unroll
  for(int d0=0;d0<4;++d0){
    const bf16x8 b0=*reinterpret_cast<const bf16x8*>(kb+d0*2048);
    const bf16x8 b1=*reinterpret_cast<const bf16x8*>(kb+d0*2048+512);
    if(d0==0){p0=__builtin_amdgcn_mfma_f32_32x32x16_bf16(b0,qr[0],negm,0,0,0);p1=__builtin_amdgcn_mfma_f32_32x32x16_bf16(b1,qr[0],negm,0,0,0);}
    else{p0=__builtin_amdgcn_mfma_f32_32x32x16_bf16(b0,qr[d0],p0,0,0,0);p1=__builtin_amdgcn_mfma_f32_32x32x16_bf16(b1,qr[d0],p1,0,0,0);}}
}
typedef __attribute__((address_space(3))) const char* lds_cptr;
typedef short v4i16_t __attribute__((ext_vector_type(4)));
__device__ __forceinline__ void kload8(bf16x8*kf,lds_cptr kp){
  kf[0]=*(const __attribute__((address_space(3))) bf16x8*)(kp);      kf[1]=*(const __attribute__((address_space(3))) bf16x8*)(kp+512);
  kf[2]=*(const __attribute__((address_space(3))) bf16x8*)(kp+2048); kf[3]=*(const __attribute__((address_space(3))) bf16x8*)(kp+2560);
  kf[4]=*(const __attribute__((address_space(3))) bf16x8*)(kp+4096); kf[5]=*(const __attribute__((address_space(3))) bf16x8*)(kp+4608);
  kf[6]=*(const __attribute__((address_space(3))) bf16x8*)(kp+6144); kf[7]=*(const __attribute__((address_space(3))) bf16x8*)(kp+6656);
}
__device__ __forceinline__ void kload2(bf16x8*kf,lds_cptr kp,int j){ kf[2*j]=*(const __attribute__((address_space(3))) bf16x8*)(kp+j*2048); kf[2*j+1]=*(const __attribute__((address_space(3))) bf16x8*)(kp+j*2048+512); }
__device__ __forceinline__ s16x4 vtr(lds_cptr p){ return __builtin_bit_cast(s16x4,__builtin_amdgcn_ds_read_tr16_b64_v4i16((__attribute__((address_space(3))) v4i16_t*)p)); }
__device__ __forceinline__ float rowmax(const f32x16&p0,const f32x16&p1){
  float a=max3f(p0[0],p0[1],p1[0]),b=max3f(p0[2],p0[3],p1[1]);a=max3f(a,p1[2],p1[3]);
  #pragma unroll
  for(int r=4;r<16;r+=4){a=max3f(a,p0[r],p0[r+1]);b=max3f(b,p0[r+2],p0[r+3]);a=max3f(a,p1[r],p1[r+1]);b=max3f(b,p1[r+2],p1[r+3]);}
  const float m=max2f(a,b);
  auto rr=__builtin_amdgcn_permlane32_swap(__float_as_uint(m),__float_as_uint(m),false,false);
  return max2f(__uint_as_float(rr[0]),__uint_as_float(rr[1]));
}
__device__ __forceinline__ void pv(f32x16*o,int vb,bf16x8 pa0,bf16x8 pa1,bf16x8 pa2,bf16x8 pa3){
  #pragma unroll
  for(int d0=0;d0<2;++d0){s16x4 lo[4],hi[4];
    #pragma unroll
    for(int ks=0;ks<4;++ks){
      asm volatile("ds_read_b64_tr_b16 %0,%1 offset:%c2":"=&v"(lo[ks]):"v"(vb),"i"(d0*4096+ks*1024):"memory");
      asm volatile("ds_read_b64_tr_b16 %0,%1 offset:%c2":"=&v"(hi[ks]):"v"(vb),"i"(d0*4096+ks*1024+512):"memory");}
    asm volatile("s_waitcnt lgkmcnt(0)":::"memory");SBAR();
    #define PK(k) (bf16x8){lo[k][0],lo[k][1],lo[k][2],lo[k][3],hi[k][0],hi[k][1],hi[k][2],hi[k][3]}
    o[d0]=__builtin_amdgcn_mfma_f32_32x32x16_bf16(pa0,PK(0),o[d0],0,0,0);
    o[d0]=__builtin_amdgcn_mfma_f32_32x32x16_bf16(pa1,PK(1),o[d0],0,0,0);
    o[d0]=__builtin_amdgcn_mfma_f32_32x32x16_bf16(pa2,PK(2),o[d0],0,0,0);
    o[d0]=__builtin_amdgcn_mfma_f32_32x32x16_bf16(pa3,PK(3),o[d0],0,0,0);
    #undef PK
  }
}

#ifndef ATTN_STORE16
#define ATTN_STORE16(p,v) (*(u32x4*)(p)=(v))
#endif
template<int THRL> __device__ __forceinline__ void attn_unit(int wave_id,int b,int h,int qb,const bf16*Q,const bf16*__restrict__ K,const bf16*__restrict__ V,bf16*O,const unsigned*__restrict__ BM,const float*__restrict__ rb,char*shm){
  int lane_=(int)__builtin_amdgcn_mbcnt_hi(~0u,__builtin_amdgcn_mbcnt_lo(~0u,0u)); asm volatile("":"+v"(lane_)); const int wid=wave_id,lane=lane_,tid=wid*64+lane,r32=lane&31,hi=lane>>5;
  const long rowbase=(long)b*SEQ; const int q0=qb*QB;
  const bf16*Qw=Q+(rowbase+q0+wid*QBLK)*QP+h*D;
  const bf16*Kh=K+rowbase*QP+h*D,*Vh=V+rowbase*QP+h*D;
  const unsigned lds0=(unsigned)(uintptr_t)shm;
  float*wsf=(float*)(shm+LDS_WS)+wid*64;
  const unsigned koff=(unsigned)(lane*QP+wid*8)*2u;
  const unsigned voff=(unsigned)((16*(wid&3)+(lane>>2))*QP+(wid>>2)*32+(lane&3)*8)*2u;
  const unsigned kdst=lds0+LDS_K+wid*1024, vdst=lds0+LDS_V+wid*1024;
  #define DMA_K(t,slot) glds16s(koff,Kh+(long)(t)*KVBLK*QP,(unsigned)__builtin_amdgcn_readfirstlane(kdst+(slot)))
  #define DMA_V(t,slot) glds16s(voff,Vh+(long)(t)*KVBLK*QP,(unsigned)__builtin_amdgcn_readfirstlane(vdst+(slot)))
  const int vb0=(int)(lds0+LDS_V)+((lane>>4)&1)*32+(lane&3)*8+(4*hi+((lane&15)>>2))*64;
  const char*Kbase=shm+LDS_K; bf16x8 kf[8];
  const lds_cptr shm3=(lds_cptr)shm; const lds_cptr kp0=shm3+LDS_K+hi*1024+r32*16; const lds_cptr vp0=shm3+LDS_V+((lane>>4)&1)*32+(lane&3)*8+(4*hi+((lane&15)>>2))*64;
  const int NT=(q0+QB)/KVBLK;
  const unsigned* mbase=BM+((size_t)(b*(SEQ/QB)+qb)*(SEQ/128))*QB*4;
  const unsigned mdst=lds0+LDS_MK+(wid&3)*1024;
  #define DMA_M(e) do{ if(wid<4) glds16s((unsigned)(((wid&3)*64+lane)*16),mbase+(size_t)((e)>>1)*QB*4,(unsigned)__builtin_amdgcn_readfirstlane(mdst+(((e)>>1)&1)*4096)); }while(0)
  const float cfar=rb[31*NHEAD+h]*1.4426950408889634f;
  { float*bt=(float*)(shm+LDS_BT); if(tid<128){ int n=tid; int bk=n<16?n:(16+(int)(__log2f((float)n*(1.f/16.f))*(16.f/3.f))); bk=bk<31?bk:31; bt[tid]=rb[bk*NHEAD+h]*1.4426950408889634f-cfar; } if(tid==128)bt[128]=0.f; }
  DMA_M(0); if(NT>2){DMA_M(2);}
  DMA_K(0,0);DMA_V(0,0);DMA_K(1,SLOTB);
  bf16x8 qr[4];
  #pragma unroll
  for(int d0=0;d0<4;++d0)qr[d0]=*reinterpret_cast<const bf16x8*>(&Qw[(long)r32*QP+d0*16+hi*8]);
  float mhat=0.f,l_reg=0.f;f32x16 o[2];o[0]=f32x16{};o[1]=f32x16{};float cm=cfar; const f32x16 zc=f32x16{};
  const int qrel=wid*QBLK+r32;
  const __attribute__((address_space(3))) float*btab=(const __attribute__((address_space(3))) float*)((lds_cptr)shm+LDS_BT);
  #define MASKB(P0,P1,t) do{ const lds_cptr mp_=(lds_cptr)shm+(LDS_MK+(wid*QBLK+r32)*16+(((t)>>1)&1)*4096+((t)&1)*8); const unsigned mx_=*(const __attribute__((address_space(3))) unsigned*)(mp_)>>(4*hi), my_=*(const __attribute__((address_space(3))) unsigned*)(mp_+4)>>(4*hi); \
      _Pragma("unroll") for(int r=0;r<16;++r){ const int cb_=(r&3)+8*(r>>2); const unsigned s0_=(unsigned)__builtin_amdgcn_sbfe((int)mx_,cb_,1), s1_=(unsigned)__builtin_amdgcn_sbfe((int)my_,cb_,1); \
        P0[r]=__uint_as_float((__float_as_uint(P0[r]+cm)&s0_)|(~s0_&0xff800000u)); P1[r]=__uint_as_float((__float_as_uint(P1[r]+cm)&s1_)|(~s1_&0xff800000u)); } }while(0)
  #define CMASK(P0,P1,t) do{ if((t)>=NT-6){ const int db_=q0+qrel-64*(t)-4*hi; \
      _Pragma("unroll") for(int r=0;r<16;++r){ const int d0_=db_-((r&3)+8*(r>>2)); const int i0_=d0_<0?0:(d0_>128?128:d0_); const int d1_=d0_-32; const int i1_=d1_<0?0:(d1_>128?128:d1_); P0[r]+=btab[i0_]; P1[r]+=btab[i1_]; } } }while(0)
  bool resc=false;
  #define START(P0,P1) do{ const float rm=rowmax(P0,P1); resc=false; \
    { const float dl=__builtin_fmaxf(rm,0.f); mhat=fadd_s(mhat,dl); \
      _Pragma("unroll") for(int r=0;r<16;++r){P0[r]=fsub_s(P0[r],dl);P1[r]=fsub_s(P1[r],dl);} \
      cm=cfar-mhat; } \
    _Pragma("unroll") for(int r=0;r<16;++r)P0[r]=__builtin_amdgcn_exp2f(P0[r]); }while(0)
  #define RESC() do{ if(resc){ asm volatile("s_waitcnt lgkmcnt(0)":::"memory"); \
      _Pragma("unroll") for(int d_=0;d_<2;++d_) _Pragma("unroll") for(int r=0;r<16;++r)o[d_][r]*=wsf[crow(r,hi)]; } }while(0)
  f32x16 pA0,pA1,pB0,pB1;
  int sl_prev=0,sl_cur=0,sl_next=SLOTB;
  #define ROT() do{sl_prev=sl_cur;sl_cur=sl_next;sl_next=(sl_next==(NSLOT-1)*SLOTB)?0:sl_next+SLOTB;}while(0)
  DMA_K(2,2*SLOTB);
  WAIT_BAR(3);
  qkt(pA0,pA1,Kbase,qr,zc,r32,hi);asm volatile("s_nop 15\n\ts_nop 7":"+v"(pA0),"+v"(pA1));MASKB(pA0,pA1,0);CMASK(pA0,pA1,0);
  START(pA0,pA1);
  _Pragma("unroll") for(int r=0;r<16;++r)pA1[r]=__builtin_amdgcn_exp2f(pA1[r]);
  WAIT_BAR(0);
  DMA_K(3,0);DMA_V(1,SLOTB);
  ROT();
  kload8(kf,kp0+sl_cur);
  WAIT_BAR(2);
  s16x4 vlo[8],vhi[8]; u32x4 pw0,pw1,pw2,pw3;
  #define PKW(P,B) cvtpk_s(P[B],P[B+1])
  #define PAF(k) __builtin_bit_cast(bf16x8,pw##k)
  #define VFR(i) (bf16x8){vlo[i][0],vlo[i][1],vlo[i][2],vlo[i][3],vhi[i][0],vhi[i][1],vhi[i][2],vhi[i][3]}
  #define PIN(x) asm volatile("":"+v"(x))
  #define MX3(a,b,c) __builtin_fmaxf(__builtin_fmaxf((a),(b)),(c))
  #define GAPA(MF,A0,A1,A2,A3,W0,W1,PW) do{ MF; sacc+=A0; sacc+=A1; sacc+=A2; sacc+=A3; PIN(sacc); W0; W1; PIN(PW); SBAR(); }while(0)
  #define EX(v) __builtin_amdgcn_exp2f(v)
  #define GAPB(MF,X,B) do{ MF; X[B]=EX(X[B]); X[B+1]=EX(X[B+1]); X[B+2]=EX(X[B+2]); X[B+3]=EX(X[B+3]); PIN(X); SBAR(); }while(0)
  #define VRD(i) do{ vlo[i]=vtr(vp_+(((i)>>2)*4096+((i)&3)*1024)); vhi[i]=vtr(vp_+(((i)>>2)*4096+((i)&3)*1024+512)); }while(0)
  #define KRD(G,j) do{ if(G){ kload2(kf,kp0+sl_next,j); SBAR(); } }while(0)
  #define STEP(C0,C1,P0,P1,t,GK,GV,GL) do{ SBAR(); \
    const lds_cptr vp_=vp0+sl_prev; \
    VRD(0); SBAR(); float sacc=(P0[0]+P0[1]); \
    GAPA(C0=__builtin_amdgcn_mfma_f32_32x32x16_bf16(kf[0],qr[0],zc,0,0,0), P0[2],P0[3],P0[4],P0[5],     pw0[0]=PKW(P0,0), pw0[1]=PKW(P0,2), pw0); \
    VRD(4); SBAR(); GAPA(C1=__builtin_amdgcn_mfma_f32_32x32x16_bf16(kf[1],qr[0],zc,0,0,0), P0[6],P0[7],P0[8],P0[9],     pw0[2]=PKW(P0,4), pw0[3]=PKW(P0,6), pw0); \
    VRD(1); SBAR(); GAPA(C0=__builtin_amdgcn_mfma_f32_32x32x16_bf16(kf[2],qr[1],C0,0,0,0),   P0[10],P0[11],P0[12],P0[13], pw1[0]=PKW(P0,8), pw1[1]=PKW(P0,10), pw1); \
    VRD(5); SBAR(); GAPA(C1=__builtin_amdgcn_mfma_f32_32x32x16_bf16(kf[3],qr[1],C1,0,0,0),   P0[14],P0[15],P1[0],P1[1],   pw1[2]=PKW(P0,12),pw1[3]=PKW(P0,14), pw1); \
    VRD(2); SBAR(); GAPA(C0=__builtin_amdgcn_mfma_f32_32x32x16_bf16(kf[4],qr[2],C0,0,0,0),   P1[2],P1[3],P1[4],P1[5],     pw2[0]=PKW(P1,0), pw2[1]=PKW(P1,2), pw2); \
    VRD(6); SBAR(); GAPA(C1=__builtin_amdgcn_mfma_f32_32x32x16_bf16(kf[5],qr[2],C1,0,0,0),   P1[6],P1[7],P1[8],P1[9],     pw2[2]=PKW(P1,4), pw2[3]=PKW(P1,6), pw2); \
    VRD(3); SBAR(); GAPA(C0=__builtin_amdgcn_mfma_f32_32x32x16_bf16(kf[6],qr[3],C0,0,0,0),   P1[10],P1[11],P1[12],P1[13], pw3[0]=PKW(P1,8), pw3[1]=PKW(P1,10), pw3); \
    VRD(7); SBAR(); GAPA(C1=__builtin_amdgcn_mfma_f32_32x32x16_bf16(kf[7],qr[3],C1,0,0,0),   P1[14],P1[15],0.f,0.f,       pw3[2]=PKW(P1,12),pw3[3]=PKW(P1,14), pw3); \
    l_reg+=sacc; \
    if((((t)&1)==0)&&((t)+2<NT)){DMA_M((t)+2);} if(GK){DMA_K((t)+3,sl_cur);} if(GV){DMA_V((t)+1,sl_next);} \
    MASKB(C0,C1,t); CMASK(C0,C1,t); \
    { float a=MX3(C0[0],C0[1],C1[0]),b=MX3(C0[2],C0[3],C1[1]); a=MX3(a,C1[2],C1[3]); \
      _Pragma("unroll") for(int r=4;r<16;r+=4){a=MX3(a,C0[r],C0[r+1]);b=MX3(b,C0[r+2],C0[r+3]);a=MX3(a,C1[r],C1[r+1]);b=MX3(b,C1[r+2],C1[r+3]);} \
      float rm=__builtin_fmaxf(a,b); { auto rr=__builtin_amdgcn_permlane32_swap(__float_as_uint(rm),__float_as_uint(rm),false,false); rm=__builtin_fmaxf(__uint_as_float(rr[0]),__uint_as_float(rr[1])); } \
      resc=false; \
      if(__builtin_expect(__any(rm>(float)THRL),0)){ const float dl=__builtin_fmaxf(rm,0.f); mhat+=dl; \
        _Pragma("unroll") for(int r=0;r<16;++r){C0[r]-=dl;C1[r]-=dl;} \
        cm=cfar-mhat; \
        const float f=__builtin_amdgcn_exp2f(-dl); l_reg*=f; if(hi==0)wsf[r32]=f; resc=true; } } \
    SBAR(); \
    GAPB(o[0]=__builtin_amdgcn_mfma_f32_32x32x16_bf16(PAF(0),VFR(0),o[0],0,0,0), C0,0); \
    GAPB(o[1]=__builtin_amdgcn_mfma_f32_32x32x16_bf16(PAF(0),VFR(4),o[1],0,0,0), C0,4); \
    KRD(GL,0); GAPB(o[0]=__builtin_amdgcn_mfma_f32_32x32x16_bf16(PAF(1),VFR(1),o[0],0,0,0), C0,8); \
    KRD(GL,1); GAPB(o[1]=__builtin_amdgcn_mfma_f32_32x32x16_bf16(PAF(1),VFR(5),o[1],0,0,0), C0,12); \
    KRD(GL,2); GAPB(o[0]=__builtin_amdgcn_mfma_f32_32x32x16_bf16(PAF(2),VFR(2),o[0],0,0,0), C1,0); \
    KRD(GL,3); GAPB(o[1]=__builtin_amdgcn_mfma_f32_32x32x16_bf16(PAF(2),VFR(6),o[1],0,0,0), C1,4); \
    GAPB(o[0]=__builtin_amdgcn_mfma_f32_32x32x16_bf16(PAF(3),VFR(3),o[0],0,0,0), C1,8); \
    GAPB(o[1]=__builtin_amdgcn_mfma_f32_32x32x16_bf16(PAF(3),VFR(7),o[1],0,0,0), C1,12); \
    }while(0)
  int t=1;
  #undef CMASK
  #define CMASK(P0,P1,t) do{}while(0)
  for(;t+7<NT;t+=2){
    STEP(pB0,pB1,pA0,pA1,t,true,true,true);     WAIT_BAR(2); RESC(); ROT();
    STEP(pA0,pA1,pB0,pB1,t+1,true,true,true);   WAIT_BAR(2); RESC(); ROT();
  }
  #undef CMASK
  #define CMASK(P0,P1,t) do{ if((t)>=NT-6){ const int db_=q0+qrel-64*(t)-4*hi; \
      _Pragma("unroll") for(int r=0;r<16;++r){ const int d0_=db_-((r&3)+8*(r>>2)); const int i0_=d0_<0?0:(d0_>128?128:d0_); const int d1_=d0_-32; const int i1_=d1_<0?0:(d1_>128?128:d1_); P0[r]+=btab[i0_]; P1[r]+=btab[i1_]; } } }while(0)
  #define ENDW(tt) do{ if((tt)+3<NT){WAIT_BAR(2);} else if((tt)+2<NT){WAIT_BAR(1);} else {WAIT_BAR(0);} }while(0)
  for(;t+1<NT;t+=2){
    STEP(pB0,pB1,pA0,pA1,t,(t+3<NT),(t+1<NT),(t+1<NT));       ENDW(t);   RESC(); ROT();
    STEP(pA0,pA1,pB0,pB1,t+1,(t+4<NT),(t+2<NT),(t+2<NT));     ENDW(t+1); RESC(); ROT();
  }
  STEP(pB0,pB1,pA0,pA1,NT-1,false,false,false); RESC();
  { float sacc=pB0[0]+pB0[1]; _Pragma("unroll") for(int r=2;r<16;++r)sacc+=pB0[r]; _Pragma("unroll") for(int r=0;r<16;++r)sacc+=pB1[r]; l_reg+=sacc;
    pw0=(u32x4){PKW(pB0,0),PKW(pB0,2),PKW(pB0,4),PKW(pB0,6)};pw1=(u32x4){PKW(pB0,8),PKW(pB0,10),PKW(pB0,12),PKW(pB0,14)};pw2=(u32x4){PKW(pB1,0),PKW(pB1,2),PKW(pB1,4),PKW(pB1,6)};pw3=(u32x4){PKW(pB1,8),PKW(pB1,10),PKW(pB1,12),PKW(pB1,14)};
    SBAR(); pv(o,vb0+sl_cur,PAF(0),PAF(1),PAF(2),PAF(3)); }
  #undef PKW
  #undef PAF
  #undef VFR
  #undef PIN
  #undef MX3
  #undef GAPA
  #undef GAPB
  #undef EX
  #undef VRD
  #undef KRD
  #undef STEP
  #undef ENDW
  {auto rr=__builtin_amdgcn_permlane32_swap(__float_as_uint(l_reg),__float_as_uint(l_reg),false,false);l_reg=__uint_as_float(rr[0])+__uint_as_float(rr[1]);}
  if(hi==0)wsf[32+r32]=l_reg;asm volatile("s_waitcnt lgkmcnt(0)":::"memory");
  float rli[16];
  #pragma unroll
  for(int r=0;r<16;++r)rli[r]=__builtin_amdgcn_rcpf(wsf[32+crow(r,hi)]);
  bf16*Ow=O+(rowbase+q0+wid*QBLK)*OP+h*D;
  { bf16*stg=(bf16*)(shm+LDS_OST)+wid*2048;
    #pragma unroll
    for(int r=0;r<16;++r){const int orow=crow(r,hi);
      #pragma unroll
      for(int d0=0;d0<2;++d0)stg[orow*64+d0*32+r32]=__float2bfloat16(o[d0][r]*rli[r]);}
    asm volatile("s_waitcnt lgkmcnt(0)":::"memory");
    #pragma unroll
    for(int i=0;i<4;++i){const int row=i*8+(lane>>3),ch=lane&7; const u32x4 v=*(const u32x4*)(stg+row*64+ch*8); ATTN_STORE16(Ow+(long)row*OP+ch*8,v);} }
  asm volatile("s_waitcnt lgkmcnt(0)\n\ts_barrier":::"memory");
  #undef DMA_K
  #undef DMA_V
  #undef DMA_M
  #undef MASKB
  #undef CMASK
  #undef START
  #undef RESC
  #undef ROT
}
constexpr int ATTN_LDS_BYTES=LDS_BYTES;
#undef SBAR
#undef WAIT_BAR
}

constexpr int CW_QUEUE = 8192;
__device__ __forceinline__ void dsa_attn_phase(Frame& F, const Args& A, int l, int rep = 0) {
    unsigned* ctr = (unsigned*)(F.ws + WS_CTL) + CW_QUEUE + 64 * l + 256 * rep;
    volatile unsigned* slot = (volatile unsigned*)(F.lds + LDSCTL_OFF + 512);
    const attn_body::bf16* proj = (const attn_body::bf16*)(F.ws + WS_PROJ);
    for (;;) {
        if (F.tid == 0) *slot = atomicAdd(ctr, 1u);
        __syncthreads();
        const unsigned u = (unsigned)__builtin_amdgcn_readfirstlane((int)*slot);
        __syncthreads();
        if (u >= 768u) break;
        const int qb = 63 - (int)(u / 12u), bh = (int)(u % 12u), b = bh / 6, h = bh % 6;
        attn_body::attn_unit<8>(F.wave, b, h, qb, proj + PC_DQ, proj + PC_DK, proj + PC_DV, (attn_body::bf16*)(F.ws + WS_Y) + YC_DSA, (const unsigned*)(F.ws + WS_BM), A.in[I_RB], (char*)(F.lds + RING_OFF));
    }
}

constexpr int PH_PER_LAYER = 9, N_PHASES = 1 + DEPTH * PH_PER_LAYER;
__global__ void __launch_bounds__(NTHR, 2) fwd(const Args A) {
    extern __shared__ __attribute__((aligned(16))) unsigned char lds[];
    Frame F;
    F.lds = lds; F.tid = threadIdx.x; F.lane = F.tid & 63; F.wave = __builtin_amdgcn_readfirstlane(F.tid >> 6); F.G = gridDim.x; const int wave0 = F.wave;
    F.out = A.out; F.ws = A.ws;
    LAS unsigned char* lds3 = (LAS unsigned char*)lds;
    for (int u = F.tid; u < (LDS_BYTES - LDSCTL_OFF) / 4; u += NTHR) ((LAS unsigned*)(lds3 + LDSCTL_OFF))[u] = 0u;
    __syncthreads();
    const int lo = A.ph_lo, hi = A.ph_hi;
    XcdBarrier bar; bar.bar = (unsigned*)(F.ws + WS_CTL) + CW_BAR; bar.x = 0; bar.st = nullptr; bar.wave = F.wave;
    if (hi - lo > 1) bar = xcd_barrier_post((unsigned*)(F.ws + WS_CTL) + CW_BAR, (volatile LAS unsigned*)(lds3 + MISC_OFF) + 8, F.wave);
#define IN(k) (lo <= (k) && (k) < hi)
#define LAUNDER() do { int lane_ = (int)__builtin_amdgcn_mbcnt_hi(~0u, __builtin_amdgcn_mbcnt_lo(~0u, 0u)); asm volatile("" : "+v"(lane_)); F.lane = lane_; { int wv_ = wave0; asm volatile("" : "+s"(wv_)); F.wave = wv_; } F.tid = F.wave * 64 + lane_; \
    LAS unsigned char* l3_ = (LAS unsigned char*)lds; asm volatile("" : "+s"(l3_)); lds3 = l3_; F.lds = (unsigned char*)l3_; unsigned char* w_ = A.ws; asm volatile("" : "+s"(w_)); F.ws = w_; } while (0)
#ifndef REPMASK
#define REPMASK 0
#endif
#define REPS(j) (((REPMASK >> (j)) & 1) + 1)
#define SEAM(k) do { if (IN(k) && IN((k) + 1)) xcd_barrier(bar); } while (0)
#define gw (blockIdx.x * NWAVES + F.wave)
#define NGW (F.G * NWAVES)
#define XB ((bf16*)(F.ws + WS_XB))
#define PROJ ((bf16*)(F.ws + WS_PROJ))
#define AUX ((float*)(F.ws + WS_AUX))
#define Y ((bf16*)(F.ws + WS_Y))
#define H ((bf16*)(F.ws + WS_H))
#define V1 ((float*)(F.ws + WS_V1))
#define V2 ((float*)(F.ws + WS_V2))

    if (IN(0)) { LAUNDER(); for (int rep = 0; rep < REPS(5); ++rep) { p0_prologue(F, A); lru_weights_prologue(F, A); } } SEAM(0);

    for (int l = 0; l < DEPTH; ++l) {
        const int pb = 1 + l * PH_PER_LAYER;
        if (IN(pb + 0)) { LAUNDER();
            pg8::Gemm g{XB, w_ptr(F, l, WO_IN), T, NIN, D}; pg8::StaticOrder S; S.init(T, NIN, F.G, (int)blockIdx.x);
            pg8::EpiInProj E{PROJ, AUX, (_Float16*)(F.ws + WS_KI)};
            for (int rep = 0; rep < REPS(3); ++rep) {
            pg8::gemm_phase<pg8::EpiInProj, pg8::StaticOrder, true, true>(lds3 + RING_OFF, g, S, E, F.wave); }
        } SEAM(pb + 0);
        if (IN(pb + 1)) { LAUNDER();
            for (int rep = 0; rep < REPS(0); ++rep) {
                unsigned* ctr = (unsigned*)(F.ws + WS_CTL) + CW_QUEUE + 64 * l + 16 + 256 * rep; volatile unsigned* slot = (volatile unsigned*)(F.lds + LDSCTL_OFF + 512);
                for (;;) { if (F.tid == 0) *slot = atomicAdd(ctr, 1u); __syncthreads(); const unsigned u = (unsigned)__builtin_amdgcn_readfirstlane((int)*slot); __syncthreads(); if (u >= (unsigned)(T / 32)) break;
                    dsa_item(F, A, l, (int)(u & 1u) * 512 + 511 - (int)(u >> 1)); } }
            for (int rep = 0; rep < REPS(1); ++rep) for (int it = blockIdx.x; it < 1024; it += F.G) lru_item2(F, A, l, it, false);
            for (int rep = 0; rep < REPS(2); ++rep) for (int it = blockIdx.x; it < 3072; it += F.G) gla_item2(F, A, l, it, false);
        } SEAM(pb + 1);
        if (IN(pb + 2)) { LAUNDER();
            if (blockIdx.x < 96) gla_scan(F, blockIdx.x * NTHR + F.tid);
            for (int row = gw; row < 512; row += NGW) lru_scan_row(F, row);
#ifndef NO_ATTN
            for (int rep = 0; rep < REPS(6); ++rep) dsa_attn_phase(F, A, l, rep);
#endif
        } SEAM(pb + 2);
        if (IN(pb + 3)) { LAUNDER();
            for (int rep = 0; rep < REPS(1); ++rep) for (int it = blockIdx.x; it < 1024; it += F.G) lru_item2(F, A, l, it, true);
            for (int rep = 0; rep < REPS(2); ++rep) for (int it = blockIdx.x; it < 3072; it += F.G) gla_item2(F, A, l, it, true);
            __syncthreads();
        } SEAM(pb + 3);
        if (IN(pb + 4)) { LAUNDER();
            pg8::Gemm g{Y, w_ptr(F, l, WO_OUT), T, D, D}; pg8::StaticOrder S; S.init(T, D, F.G, (int)blockIdx.x);
            pg8::EpiRes E{l == 0 ? A.in[I_X] : F.out, V1, DN_ALPHA};
            for (int rep = 0; rep < REPS(3); ++rep) {
            pg8::gemm_phase<pg8::EpiRes, pg8::StaticOrder, true, true>(lds3 + RING_OFF, g, S, E, F.wave); }
        } SEAM(pb + 4);
        if (IN(pb + 5)) { LAUNDER(); for (int rep = 0; rep < REPS(4); ++rep) ln_phase(F, V1, A.in[I_LN1G] + l * D, A.in[I_LN1B] + l * D, F.out, XB); } SEAM(pb + 5);
        if (IN(pb + 6)) { LAUNDER();
            pg8::Gemm g{XB, w_ptr(F, l, WO_GU), T, NGU, D}; pg8::StaticOrder S; S.init(T, NGU, F.G, (int)blockIdx.x);
            pg8::EpiFfnUp E{H};
            for (int rep = 0; rep < REPS(3); ++rep) {
            pg8::gemm_phase<pg8::EpiFfnUp, pg8::StaticOrder, true, true>(lds3 + RING_OFF, g, S, E, F.wave); }
        } SEAM(pb + 6);
        if (IN(pb + 7)) { LAUNDER();
            pg8::Gemm g{H, w_ptr(F, l, WO_D), T, D, DFF}; pg8::StaticOrder S; S.init(T, D, F.G, (int)blockIdx.x);
            pg8::EpiRes E{F.out, V2, DN_ALPHA};
            for (int rep = 0; rep < REPS(3); ++rep) {
            pg8::gemm_phase<pg8::EpiRes, pg8::StaticOrder, true, true>(lds3 + RING_OFF, g, S, E, F.wave); }
        } SEAM(pb + 7);
        if (IN(pb + 8)) { LAUNDER(); for (int rep = 0; rep < REPS(4); ++rep) ln_phase(F, V2, A.in[I_LN2G] + l * D, A.in[I_LN2B] + l * D, F.out, XB); } SEAM(pb + 8);
    }
#undef IN
#undef SEAM
#undef gw
#undef NGW
#undef XB
#undef PROJ
#undef AUX
#undef Y
#undef H
#undef V1
#undef V2
}

extern "C" void kernel_launch(void* const* d_in, const int* in_sizes, int n_in, void* d_out, int out_size, void* d_ws, size_t ws_size, hipStream_t stream) {
    static int grid = 0;
    if (grid == 0) {
        if (n_in != N_INPUTS || in_sizes[0] != T * D || out_size != T * D || ws_size < WS_END) { fprintf(stderr, "kernel_launch: unexpected shapes (n_in %d, in0 %d, out %d, ws %zu, need %zu)\n", n_in, n_in > 0 ? in_sizes[0] : -1, out_size, ws_size, (size_t)WS_END); grid = -1; return; }
        int dev = 0, cus = 0, per_cu = 0;
        if (hipGetDevice(&dev) != hipSuccess || hipDeviceGetAttribute(&cus, hipDeviceAttributeMultiprocessorCount, dev) != hipSuccess) { grid = -1; return; }
        if (hipFuncSetAttribute((const void*)fwd, hipFuncAttributeMaxDynamicSharedMemorySize, LDS_BYTES) != hipSuccess) { fprintf(stderr, "kernel_launch: hipFuncSetAttribute failed\n"); grid = -1; return; }
        if (hipOccupancyMaxActiveBlocksPerMultiprocessor(&per_cu, (const void*)fwd, NTHR, LDS_BYTES) != hipSuccess || per_cu < 1) fprintf(stderr, "kernel_launch: occupancy query reports %d per CU\n", per_cu);
        (void)hipGetLastError();
        grid = cus;
        if (grid != 256) fprintf(stderr, "kernel_launch: %d CUs (expected 256)\n", grid);
    }
    if (grid < 0) return;
    (void)hipMemsetAsync((char*)d_ws + WS_CTL, 0, CTL_ZERO_BYTES, stream);
    Args a{};
    for (int i = 0; i < N_INPUTS; ++i) a.in[i] = (const float*)d_in[i];
    a.out = (float*)d_out; a.ws = (unsigned char*)d_ws;
#if MK_N_LAUNCHES == 1
    a.ph_lo = 0; a.ph_hi = N_PHASES;
    hipLaunchKernelGGL(fwd, dim3(grid), dim3(NTHR), LDS_BYTES, stream, a);
#else
    for (int ph = 0; ph < N_PHASES; ++ph) { a.ph_lo = ph; a.ph_hi = ph + 1; hipLaunchKernelGGL(fwd, dim3(grid), dim3(NTHR), LDS_BYTES, stream, a); }
#endif
}
```
